# Optimizing an MI355X kernel written in HIP

```python
import jax, jax.numpy as jnp
from jax import lax
import numpy as np

D_MODEL = 1024
BATCH = 8
SEQ = 2048
DEPTH = 1
DEC_BATCH = 128
DEC_SEQ = 1
PAST_LEN = 16384
PAGE_SIZE = 128

MLSTM_HEADS = 4
MLSTM_DK = D_MODEL // 8
MLSTM_DV = D_MODEL // 8
D_A = MLSTM_HEADS * MLSTM_DV
QK_A = MLSTM_HEADS * MLSTM_DK
MLSTM_CHUNK = 128
POOL_WINDOWS = (2, 4, 8, 16)
N_POOL_GROUPS = 4
D_B = D_MODEL // 2
POOL_GROUP = D_B // N_POOL_GROUPS
POOL_BUF = max(POOL_WINDOWS) - 1
PEER_HEADS = 8
PEER_DKEY = D_MODEL // 4
PEER_HALF = PEER_DKEY // 2
PEER_N_KEYS = 128
PEER_N_EXPERTS = PEER_N_KEYS ** 2
PEER_TOPK = 16
PEER_TOKEN_BLOCK = 128
OFF_Q = 0
OFF_K = OFF_Q + QK_A
OFF_V = OFF_K + QK_A
OFF_O = OFF_V + D_A
OFF_I = OFF_O + D_A
OFF_F = OFF_I + MLSTM_HEADS
OFF_U = OFF_F + MLSTM_HEADS
OFF_GA = OFF_U + D_B
OFF_GB = OFF_GA + D_MODEL
N_IN = OFF_GB + D_MODEL
DEEPNORM_ALPHA = (2 * DEPTH) ** 0.25
DEEPNORM_BETA = (8 * DEPTH) ** -0.25
LN_EPS = 1e-5

kernel_name = 'hybrid_mlstm_pool_peer_step'


def layer_norm(x):
    xf = x.astype(jnp.float32)
    mu = jnp.mean(xf, axis=-1, keepdims=True)
    var = jnp.mean(jnp.square(xf - mu), axis=-1, keepdims=True)
    return (xf - mu) * lax.rsqrt(var + LN_EPS)


def mlstm_chunk(carry, inp):
    C, n, m = carry
    q, k, v, ig, lf = inp
    T = q.shape[2]
    b = jnp.cumsum(lf, axis=-1)
    causal = jnp.tril(jnp.ones((T, T), dtype=bool))
    log_d = b[..., :, None] - b[..., None, :] + ig[..., None, :]
    log_d = jnp.where(causal, log_d, -jnp.inf)
    log_g = b + m[..., None]
    m_t = jnp.maximum(log_g, jnp.max(log_d, axis=-1))
    w = jnp.exp(log_d - m_t[..., None]) * jnp.einsum('bhtd,bhsd->bhts', q, k)
    w_state = jnp.exp(log_g - m_t)
    num = jnp.einsum('bhts,bhsv->bhtv', w, v) + w_state[..., None] * jnp.einsum('bhtd,bhdv->bhtv', q, C)
    den = jnp.sum(w, axis=-1) + w_state * jnp.einsum('bhtd,bhd->bht', q, n)
    h = num / jnp.maximum(jnp.abs(den), jnp.exp(-m_t))[..., None]
    m_new = m_t[..., -1]
    decay_s = jnp.exp(b[..., -1:] - b + ig - m_new[..., None])
    decay_c = jnp.exp(b[..., -1] + m - m_new)
    C_new = decay_c[..., None, None] * C + jnp.einsum('bhs,bhsd,bhsv->bhdv', decay_s, k, v)
    n_new = decay_c[..., None] * n + jnp.einsum('bhs,bhsd->bhd', decay_s, k)
    return (C_new, n_new, m_new), h


def mlstm_scan(q, k, v, ig, lf, state):
    T = q.shape[2]
    L = MLSTM_CHUNK if T % MLSTM_CHUNK == 0 else T
    nc = T // L

    def split(a):
        a = a.astype(jnp.float32)
        a = a.reshape(a.shape[:2] + (nc, L) + a.shape[3:])
        return jnp.moveaxis(a, 2, 0)

    state = (state[0].astype(jnp.float32), state[1].astype(jnp.float32), state[2].astype(jnp.float32))
    state, h = lax.scan(mlstm_chunk, state, (split(q), split(k), split(v), split(ig), split(lf)))
    h = jnp.moveaxis(h, 0, 2).reshape(q.shape[:3] + (v.shape[-1],))
    return h, state


def multiscale_pool(u_ext, pos0, T):
    Bn = u_ext.shape[0]
    uf = u_ext.astype(jnp.float32).reshape(Bn, POOL_BUF + T, N_POOL_GROUPS, POOL_GROUP)
    cs = jnp.pad(jnp.cumsum(uf, axis=1), ((0, 0), (1, 0), (0, 0), (0, 0)))
    pos = pos0 + jnp.arange(T)
    end = POOL_BUF + 1
    outs = []
    for g, w in enumerate(POOL_WINDOWS):
        win_sum = cs[:, end:end + T, g] - cs[:, end - w:end - w + T, g]
        cnt = jnp.minimum(w, pos + 1).astype(jnp.float32)
        outs.append(win_sum / cnt[None, :, None] - uf[:, POOL_BUF:, g])
    return jnp.stack(outs, axis=2).reshape(Bn, T, D_B)


def token_mixer(h, C0, n0, m0, pool_prefix, pos0, w_in, b_in, b_fgate, gn_gain, w_pool, pool_scale,
                w_branch_a, w_branch_b, w_out):
    Bn, T, _ = h.shape
    z = h @ w_in + b_in

    def heads(a, d):
        return a.reshape(Bn, T, MLSTM_HEADS, d).transpose(0, 2, 1, 3)

    q = heads(z[..., OFF_Q:OFF_K], MLSTM_DK)
    k = heads(z[..., OFF_K:OFF_V], MLSTM_DK) * (MLSTM_DK ** -0.5)
    v = heads(z[..., OFF_V:OFF_O], MLSTM_DV)
    o = jax.nn.sigmoid(z[..., OFF_O:OFF_I])
    ig = z[..., OFF_I:OFF_F].transpose(0, 2, 1)
    lf = jax.nn.log_sigmoid(z[..., OFF_F:OFF_U] + b_fgate).transpose(0, 2, 1)
    hA, mstate = mlstm_scan(q, k, v, ig, lf, (C0, n0, m0))
    hA = layer_norm(hA) * gn_gain.reshape(MLSTM_HEADS, 1, MLSTM_DV)
    hA = hA.transpose(0, 2, 1, 3).reshape(Bn, T, D_A) * o
    u = z[..., OFF_U:OFF_GA]
    u_ext = jnp.concatenate([pool_prefix.astype(u.dtype), u], axis=1)
    pooled = multiscale_pool(u_ext, pos0, T)
    pB = jnp.einsum('btgc,gcd->btgd', pooled.reshape(Bn, T, N_POOL_GROUPS, POOL_GROUP), w_pool)
    pB = pB.reshape(Bn, T, D_B) * pool_scale
    gA = jax.nn.sigmoid(z[..., OFF_GA:OFF_GB])
    gB = jax.nn.sigmoid(z[..., OFF_GB:N_IN])
    merged = gA * (hA @ w_branch_a) + gB * (pB @ w_branch_b)
    return merged @ w_out, mstate, u_ext[:, -POOL_BUF:]


def peer_ffn(h, w_peer_q, peer_subkeys, peer_u, peer_v):
    Bn, T, D = h.shape
    x = h.reshape(Bn * T, D)
    N = x.shape[0]
    q = (x @ w_peer_q).astype(jnp.float32).reshape(N, PEER_HEADS, 2, PEER_HALF)
    s = jnp.einsum('nhpd,pkd->nhpk', q, peer_subkeys.astype(jnp.float32))
    sv, si = lax.top_k(s, PEER_TOPK)
    cand = (sv[:, :, 0, :, None] + sv[:, :, 1, None, :]).reshape(N, PEER_HEADS, PEER_TOPK * PEER_TOPK)
    cand_id = (si[:, :, 0, :, None] * PEER_N_KEYS + si[:, :, 1, None, :]).reshape(N, PEER_HEADS, PEER_TOPK * PEER_TOPK)
    top_s, top_pos = lax.top_k(cand, PEER_TOPK)
    ids = jnp.take_along_axis(cand_id, top_pos, axis=-1).reshape(N, PEER_HEADS * PEER_TOPK)
    gates = jax.nn.softmax(top_s, axis=-1).reshape(N, PEER_HEADS * PEER_TOPK)
    nb = -(-N // PEER_TOKEN_BLOCK)
    pad = nb * PEER_TOKEN_BLOCK - N
    xb = jnp.pad(x, ((0, pad), (0, 0))).reshape(nb, PEER_TOKEN_BLOCK, D)
    idb = jnp.pad(ids, ((0, pad), (0, 0))).reshape(nb, PEER_TOKEN_BLOCK, -1)
    gb = jnp.pad(gates, ((0, pad), (0, 0))).reshape(nb, PEER_TOKEN_BLOCK, -1)

    def block(args):
        xs, ids_b, g_b = args
        act = jax.nn.gelu(jnp.einsum('ned,nd->ne', peer_u[ids_b], xs), approximate=False)
        return jnp.einsum('ne,ned->nd', g_b * act, peer_v[ids_b])

    y = lax.map(block, (xb, idb, gb)).reshape(nb * PEER_TOKEN_BLOCK, D)[:N]
    return y.reshape(Bn, T, D)


def decoder_layer(x, c, C0, n0, m0, pool_prefix, pos0, w_mod, b_mod, w_in, b_in, b_fgate, gn_gain, w_pool,
                  pool_scale, w_branch_a, w_branch_b, w_out, ln1_g, ln1_b, w_peer_q, peer_subkeys, peer_u,
                  peer_v, ln2_g, ln2_b):
    mod = (jax.nn.silu(c) @ w_mod + b_mod).astype(jnp.float32)
    sh1, sc1, g1, sh2, sc2, g2 = jnp.split(mod, 6, axis=-1)
    h1 = layer_norm(x) * (1.0 + sc1[:, None]) + sh1[:, None]
    t_out, mstate, pool_state = token_mixer(h1, C0, n0, m0, pool_prefix, pos0, w_in, b_in, b_fgate, gn_gain,
                                            w_pool, pool_scale, w_branch_a, w_branch_b, w_out)
    x1 = layer_norm(DEEPNORM_ALPHA * x.astype(jnp.float32) + g1[:, None] * t_out) * ln1_g + ln1_b
    h2 = layer_norm(x1) * (1.0 + sc2[:, None]) + sh2[:, None]
    f_out = peer_ffn(h2, w_peer_q, peer_subkeys, peer_u, peer_v)
    x2 = layer_norm(DEEPNORM_ALPHA * x1 + g2[:, None] * f_out) * ln2_g + ln2_b
    return x2, mstate, pool_state


def setup_inputs(seed: int = 0) -> dict:
    key = jax.random.key(seed)
    ks = jax.random.split(key, 32)
    f32 = jnp.float32

    def nrm(k, shape, s):
        return jax.random.normal(k, shape, f32) * s

    L = DEPTH
    return {
        'x_prompt': nrm(ks[0], (BATCH, SEQ, D_MODEL), 1.0),
        'x_sample': nrm(ks[1], (DEC_BATCH, DEC_SEQ, D_MODEL), 1.0),
        'c_prompt': nrm(ks[2], (BATCH, D_MODEL), 1.0),
        'c_sample': nrm(ks[3], (DEC_BATCH, D_MODEL), 1.0),
        'state_mlstm_C': nrm(ks[4], (L, DEC_BATCH, MLSTM_HEADS, MLSTM_DK, MLSTM_DV), MLSTM_DK ** -0.5),
        'state_mlstm_n': nrm(ks[5], (L, DEC_BATCH, MLSTM_HEADS, MLSTM_DK), MLSTM_DK ** -0.5),
        'state_mlstm_m': nrm(ks[6], (L, DEC_BATCH, MLSTM_HEADS), 1.0),
        'state_pool': nrm(ks[7], (L, DEC_BATCH, POOL_BUF, D_B), 1.0),
        'w_mod': nrm(ks[8], (L, D_MODEL, 6 * D_MODEL), 0.5 * D_MODEL ** -0.5),
        'b_mod': nrm(ks[9], (L, 6 * D_MODEL), 0.02),
        'w_in': nrm(ks[10], (L, D_MODEL, N_IN), D_MODEL ** -0.5),
        'b_in': nrm(ks[11], (L, N_IN), 0.02),
        'b_fgate': jnp.linspace(3.0, 6.0, MLSTM_HEADS, dtype=f32)[None, :] + nrm(ks[12], (L, MLSTM_HEADS), 0.1),
        'gn_gain': 1.0 + nrm(ks[13], (L, D_A), 0.05),
        'w_pool': nrm(ks[14], (L, N_POOL_GROUPS, POOL_GROUP, POOL_GROUP), POOL_GROUP ** -0.5),
        'pool_scale': 1.0 + nrm(ks[15], (L, D_B), 0.1),
        'w_branch_a': nrm(ks[16], (L, D_A, D_MODEL), D_A ** -0.5),
        'w_branch_b': nrm(ks[17], (L, D_B, D_MODEL), D_B ** -0.5),
        'w_out': nrm(ks[18], (L, D_MODEL, D_MODEL), DEEPNORM_BETA * D_MODEL ** -0.5),
        'ln1_g': 1.0 + nrm(ks[19], (L, D_MODEL), 0.05),
        'ln1_b': nrm(ks[20], (L, D_MODEL), 0.02),
        'w_peer_q': nrm(ks[21], (L, D_MODEL, PEER_HEADS * PEER_DKEY), D_MODEL ** -0.5),
        'peer_subkeys': nrm(ks[22], (L, 2, PEER_N_KEYS, PEER_HALF), PEER_HALF ** -0.5),
        'peer_u': nrm(ks[23], (L, PEER_N_EXPERTS, D_MODEL), D_MODEL ** -0.5),
        'peer_v': nrm(ks[24], (L, PEER_N_EXPERTS, D_MODEL), DEEPNORM_BETA * PEER_HEADS ** -0.5),
        'ln2_g': 1.0 + nrm(ks[25], (L, D_MODEL), 0.05),
        'ln2_b': nrm(ks[26], (L, D_MODEL), 0.02),
    }


def reference(x_prompt, x_sample, c_prompt, c_sample, state_mlstm_C, state_mlstm_n, state_mlstm_m, state_pool,
              w_mod, b_mod, w_in, b_in, b_fgate, gn_gain, w_pool, pool_scale, w_branch_a, w_branch_b, w_out,
              ln1_g, ln1_b, w_peer_q, peer_subkeys, peer_u, peer_v, ln2_g, ln2_b):
    bp = x_prompt.shape[0]
    yp = x_prompt
    ys = x_sample
    Cp_l, np_l, mp_l, pp_l, Cs_l, ns_l, ms_l, ps_l = [], [], [], [], [], [], [], []
    for l in range(DEPTH):
        lw = (w_mod[l], b_mod[l], w_in[l], b_in[l], b_fgate[l], gn_gain[l], w_pool[l], pool_scale[l],
              w_branch_a[l], w_branch_b[l], w_out[l], ln1_g[l], ln1_b[l], w_peer_q[l], peer_subkeys[l],
              peer_u[l], peer_v[l], ln2_g[l], ln2_b[l])
        C0 = jnp.zeros((bp, MLSTM_HEADS, MLSTM_DK, MLSTM_DV), jnp.float32)
        n0 = jnp.zeros((bp, MLSTM_HEADS, MLSTM_DK), jnp.float32)
        m0 = jnp.zeros((bp, MLSTM_HEADS), jnp.float32)
        pool0 = jnp.zeros((bp, POOL_BUF, D_B), jnp.float32)
        yp, (Cp, npp, mp), pp = decoder_layer(yp, c_prompt, C0, n0, m0, pool0, 0, *lw)
        ys, (Cs, ns, ms), ps = decoder_layer(ys, c_sample, state_mlstm_C[l], state_mlstm_n[l], state_mlstm_m[l],
                                             state_pool[l], PAST_LEN, *lw)
        Cp_l.append(Cp); np_l.append(npp); mp_l.append(mp); pp_l.append(pp)
        Cs_l.append(Cs); ns_l.append(ns); ms_l.append(ms); ps_l.append(ps)
    y_prompt = yp.astype(x_prompt.dtype)
    y_sample = ys.astype(x_sample.dtype)
    C_prompt = jnp.stack(Cp_l)
    n_prompt = jnp.stack(np_l)
    m_prompt = jnp.stack(mp_l)
    pool_prompt = jnp.stack(pp_l)
    C_sample = jnp.stack(Cs_l)
    n_sample = jnp.stack(ns_l)
    m_sample = jnp.stack(ms_l)
    pool_sample = jnp.stack(ps_l)
    return (y_prompt, y_sample, C_prompt, n_prompt, m_prompt, pool_prompt, C_sample, n_sample, m_sample, pool_sample)
```

```cpp
#include <hip/hip_runtime.h>
#include <hip/hip_cooperative_groups.h>
#include <cstdio>
namespace cg = cooperative_groups;

typedef unsigned short bf16_t;
typedef __attribute__((ext_vector_type(8))) short bf16x8;
typedef __attribute__((ext_vector_type(16))) float f32x16;
typedef __attribute__((ext_vector_type(4))) float f32x4;
typedef __attribute__((ext_vector_type(2))) __bf16 bf16x2_t;

#define NT 16512
#define NP 16384
#define DM 1024
#define NIN 4616
#define ALPHA 1.189207115002721f
#define LN_EPS 1e-5f

constexpr size_t OFF_WIN   = 0;
constexpr size_t OFF_WA    = OFF_WIN + 9453568;
constexpr size_t OFF_WB    = OFF_WA + 1048576;
constexpr size_t OFF_WOUT  = OFF_WB + 1048576;
constexpr size_t OFF_WPQ   = OFF_WOUT + 2097152;
constexpr size_t OFF_WPOOL = OFF_WPQ + 4194304;
constexpr size_t OFF_SUBK  = OFF_WPOOL + 131072;
constexpr size_t OFF_PU    = OFF_SUBK + 65536;
constexpr size_t OFF_PV    = OFF_PU + 33554432;
constexpr size_t OFF_MOD   = OFF_PV + 33554432;
constexpr size_t OFF_H     = OFF_MOD + 3342336;
constexpr size_t OFF_Q     = OFF_H + 33816576;
constexpr size_t OFF_K     = OFF_Q + 16908288;
constexpr size_t OFF_V     = OFF_K + 16908288;
constexpr size_t OFF_O     = OFF_V + 16908288;
constexpr size_t OFF_PQ    = OFF_Q;
constexpr size_t OFF_KT    = OFF_O + 16908288;
constexpr size_t OFF_VT    = OFF_KT + 16777216;
constexpr size_t OFF_IDS   = OFF_KT;
constexpr size_t OFF_GATES = OFF_KT + 8454144;
constexpr size_t OFF_IG    = OFF_VT + 16777216;
constexpr size_t OFF_LF    = OFF_IG + 264192;
constexpr size_t OFF_U     = OFF_LF + 264192;
constexpr size_t OFF_CT    = OFF_U;
constexpr size_t OFF_MERGED= OFF_U;
constexpr size_t OFF_CHB   = OFF_U + 33816576;
constexpr size_t OFF_MPREV = OFF_CHB + 65536;
constexpr size_t OFF_NLOC  = OFF_MPREV + 65536;
constexpr size_t OFF_NPREV = OFF_NLOC + 262144;
constexpr size_t OFF_BAR   = OFF_NPREV + 262144;
constexpr size_t OFF_CB    = OFF_BAR + 16384;
constexpr size_t WS_TOTAL  = OFF_CB + 40960;
#define CB_(p) ((const float*)((p).ws + OFF_CB))
#define P_BIN(p) (CB_(p) + 0)
#define P_FG(p)  (CB_(p) + 4624)
#define P_GN(p)  (CB_(p) + 4632)
#define P_PS(p)  (CB_(p) + 5144)
#define P_L1G(p) (CB_(p) + 5656)
#define P_L1B(p) (CB_(p) + 6680)
#define P_L2G(p) (CB_(p) + 7704)
#define P_L2B(p) (CB_(p) + 8728)

constexpr size_t OUT_Y   = 0;
constexpr size_t OUT_CP  = 16908288;
constexpr size_t OUT_NP  = 17432576;
constexpr size_t OUT_MP  = 17436672;
constexpr size_t OUT_PP  = 17436704;
constexpr size_t OUT_CS  = 17498144;
constexpr size_t OUT_NS  = 25886752;
constexpr size_t OUT_MS  = 25952288;
constexpr size_t OUT_PS  = 25952800;
constexpr size_t OUT_SBUF = 0;
constexpr size_t OUT_PB   = 9000000;

#define LS 72
#define LW 136
#define SM_A 0
#define SM_B 18432
#define SM_W 36864
#define SM_MISC 71680
#define SM_TOTAL 75776

struct Params {
  const float *x_prompt, *x_sample, *c_prompt, *c_sample, *st_C, *st_n, *st_m, *st_pool;
  const float *w_mod, *b_mod, *w_in, *b_in, *b_fgate, *gn_gain, *w_pool, *pool_scale, *w_a, *w_b, *w_out;
  const float *ln1_g, *ln1_b, *w_pq, *subkeys, *peer_u, *peer_v, *ln2_g, *ln2_b;
  float* out;
  unsigned char* ws;
};

__device__ __forceinline__ bf16_t f2bf(float f) {
  unsigned u = __float_as_uint(f);
  u += 0x7FFFu + ((u >> 16) & 1u);
  return (bf16_t)(u >> 16);
}
__device__ __forceinline__ float bf2f(bf16_t h) { return __uint_as_float(((unsigned)h) << 16); }
__device__ __forceinline__ unsigned pack2(float a, float b) { return (unsigned)f2bf(a) | ((unsigned)f2bf(b) << 16); }
__device__ __forceinline__ float bflo(unsigned u) { return __uint_as_float(u << 16); }
__device__ __forceinline__ float bfhi(unsigned u) { return __uint_as_float(u & 0xFFFF0000u); }
__device__ __forceinline__ float sigmoidf_(float x) { return 1.f / (1.f + __expf(-x)); }
__device__ __forceinline__ float logsigmoidf_(float x) { return fminf(x, 0.f) - log1pf(__expf(-fabsf(x))); }
__device__ __forceinline__ float wave_sum(float v) {
#pragma unroll
  for (int o = 32; o > 0; o >>= 1) v += __shfl_xor(v, o);
  return v;
}
__device__ __forceinline__ float dot2bf(unsigned a, unsigned b, float acc) {
  return __builtin_amdgcn_fdot2_f32_bf16(__builtin_bit_cast(bf16x2_t, a), __builtin_bit_cast(bf16x2_t, b), acc, false);
}
__device__ __forceinline__ int mod_row(int row) { return row < NP ? (row >> 11) : (8 + row - NP); }
__device__ __forceinline__ const float* x_row(const Params& p, int row) {
  return row < NP ? p.x_prompt + (size_t)row * DM : p.x_sample + (size_t)(row - NP) * DM;
}

typedef __attribute__((ext_vector_type(4))) unsigned u32x4;
struct Stage4 { u32x4 v0, v1, v2, v3; };
__device__ __forceinline__ Stage4 g_load4(const bf16_t* __restrict__ A, int lda, int k0, int tid) {
  const int row = tid >> 3, kc = tid & 7;
  const bf16_t* b = A + (size_t)row * lda + k0 + kc * 8;
  Stage4 r;
  r.v0 = *(const u32x4*)(b);
  r.v1 = *(const u32x4*)(b + (size_t)32 * lda);
  r.v2 = *(const u32x4*)(b + (size_t)64 * lda);
  r.v3 = *(const u32x4*)(b + (size_t)96 * lda);
  return r;
}
__device__ __forceinline__ void s_store4(bf16_t* s, const Stage4& r, int tid) {
  const int row = tid >> 3, kc = tid & 7;
  bf16_t* b = s + row * LS + kc * 8;
  *(u32x4*)(b) = r.v0;
  *(u32x4*)(b + 32 * LS) = r.v1;
  *(u32x4*)(b + 64 * LS) = r.v2;
  *(u32x4*)(b + 96 * LS) = r.v3;
}
__device__ __forceinline__ u32x4 scale8(u32x4 v, const float* f) {
  u32x4 o;
  o.x = pack2(bflo(v.x) * f[0], bfhi(v.x) * f[1]);
  o.y = pack2(bflo(v.y) * f[2], bfhi(v.y) * f[3]);
  o.z = pack2(bflo(v.z) * f[4], bfhi(v.z) * f[5]);
  o.w = pack2(bflo(v.w) * f[6], bfhi(v.w) * f[7]);
  return o;
}
__device__ __forceinline__ void s_store4_scaled(bf16_t* s, const Stage4& r, int tid, const float* ksc) {
  const int row = tid >> 3, kc = tid & 7;
  bf16_t* b = s + row * LS + kc * 8;
  const float* f = ksc + kc * 8;
  *(u32x4*)(b) = scale8(r.v0, f);
  *(u32x4*)(b + 32 * LS) = scale8(r.v1, f);
  *(u32x4*)(b + 64 * LS) = scale8(r.v2, f);
  *(u32x4*)(b + 96 * LS) = scale8(r.v3, f);
}
__device__ __forceinline__ void mma_ktile(const bf16_t* As, int a_stride, const bf16_t* Bs, int b_stride, int nk16,
                                          f32x16 (&acc)[2][2], int wm, int wn, int lane) {
  const int r = lane & 31, h = lane >> 5;
  const bf16_t* ap = As + (wm * 64 + r) * a_stride + h * 8;
  const bf16_t* bp = Bs + (wn * 64 + r) * b_stride + h * 8;
#pragma unroll
  for (int ks = 0; ks < nk16; ++ks) {
    bf16x8 a0 = *(const bf16x8*)(ap + ks * 16);
    bf16x8 a1 = *(const bf16x8*)(ap + 32 * a_stride + ks * 16);
    bf16x8 b0 = *(const bf16x8*)(bp + ks * 16);
    bf16x8 b1 = *(const bf16x8*)(bp + 32 * b_stride + ks * 16);
    acc[0][0] = __builtin_amdgcn_mfma_f32_32x32x16_bf16(a0, b0, acc[0][0], 0, 0, 0);
    acc[0][1] = __builtin_amdgcn_mfma_f32_32x32x16_bf16(a0, b1, acc[0][1], 0, 0, 0);
    acc[1][0] = __builtin_amdgcn_mfma_f32_32x32x16_bf16(a1, b0, acc[1][0], 0, 0, 0);
    acc[1][1] = __builtin_amdgcn_mfma_f32_32x32x16_bf16(a1, b1, acc[1][1], 0, 0, 0);
  }
}
template <bool SCALE_A>
__device__ __forceinline__ void gemm_gg(const bf16_t* __restrict__ A, int lda, const bf16_t* __restrict__ Bt, int ldb, int K,
                                        unsigned char* smem, f32x16 (&acc)[2][2], const float* ksc) {
  const int tid = threadIdx.x, lane = tid & 63, w = tid >> 6, wm = w >> 1, wn = w & 1;
  bf16_t* sA = (bf16_t*)(smem + SM_A);
  bf16_t* sB = (bf16_t*)(smem + SM_B);
  Stage4 ra = g_load4(A, lda, 0, tid);
  Stage4 rb = g_load4(Bt, ldb, 0, tid);
  for (int k0 = 0; k0 < K; k0 += 64) {
    __syncthreads();
    if (SCALE_A) s_store4_scaled(sA, ra, tid, ksc + k0); else s_store4(sA, ra, tid);
    s_store4(sB, rb, tid);
    __syncthreads();
    if (k0 + 64 < K) { ra = g_load4(A, lda, k0 + 64, tid); rb = g_load4(Bt, ldb, k0 + 64, tid); }
    mma_ktile(sA, LS, sB, LS, 4, acc, wm, wn, lane);
  }
}
#define SM_B128 34816
struct Stage8 { u32x4 v0, v1, v2, v3, v4, v5, v6, v7; };
__device__ __forceinline__ Stage8 g_load8(const bf16_t* __restrict__ A, int lda, int k0, int tid) {
  const int row = tid >> 4, kc = tid & 15;
  const bf16_t* b = A + (size_t)row * lda + k0 + kc * 8;
  Stage8 r;
  r.v0 = *(const u32x4*)(b);
  r.v1 = *(const u32x4*)(b + (size_t)16 * lda);
  r.v2 = *(const u32x4*)(b + (size_t)32 * lda);
  r.v3 = *(const u32x4*)(b + (size_t)48 * lda);
  r.v4 = *(const u32x4*)(b + (size_t)64 * lda);
  r.v5 = *(const u32x4*)(b + (size_t)80 * lda);
  r.v6 = *(const u32x4*)(b + (size_t)96 * lda);
  r.v7 = *(const u32x4*)(b + (size_t)112 * lda);
  return r;
}
__device__ __forceinline__ void s_store8(bf16_t* s, const Stage8& r, int tid) {
  const int row = tid >> 4, kc = tid & 15;
  bf16_t* b = s + row * LW + kc * 8;
  *(u32x4*)(b) = r.v0;
  *(u32x4*)(b + 16 * LW) = r.v1;
  *(u32x4*)(b + 32 * LW) = r.v2;
  *(u32x4*)(b + 48 * LW) = r.v3;
  *(u32x4*)(b + 64 * LW) = r.v4;
  *(u32x4*)(b + 80 * LW) = r.v5;
  *(u32x4*)(b + 96 * LW) = r.v6;
  *(u32x4*)(b + 112 * LW) = r.v7;
}
__device__ __forceinline__ void gemm_gg128(const bf16_t* __restrict__ A, int lda, const bf16_t* __restrict__ Bt, int ldb, int K,
                                           unsigned char* smem, f32x16 (&acc)[2][2]) {
  const int tid = threadIdx.x, lane = tid & 63, w = tid >> 6, wm = w >> 1, wn = w & 1;
  bf16_t* sA = (bf16_t*)(smem);
  bf16_t* sB = (bf16_t*)(smem + SM_B128);
  Stage8 ra = g_load8(A, lda, 0, tid);
  Stage8 rb = g_load8(Bt, ldb, 0, tid);
  for (int k0 = 0; k0 < K; k0 += 128) {
    __syncthreads();
    s_store8(sA, ra, tid);
    s_store8(sB, rb, tid);
    __syncthreads();
    if (k0 + 128 < K) { ra = g_load8(A, lda, k0 + 128, tid); rb = g_load8(Bt, ldb, k0 + 128, tid); }
    mma_ktile(sA, LW, sB, LW, 8, acc, wm, wn, lane);
  }
}
__device__ __forceinline__ void gemm_sg(const bf16_t* sW, const bf16_t* __restrict__ Bt, int ldb, int K,
                                        unsigned char* smem, f32x16 (&acc)[2][2]) {
  const int tid = threadIdx.x, lane = tid & 63, w = tid >> 6, wm = w >> 1, wn = w & 1;
  bf16_t* sB = (bf16_t*)(smem + SM_B);
  Stage4 rb = g_load4(Bt, ldb, 0, tid);
  for (int k0 = 0; k0 < K; k0 += 64) {
    __syncthreads();
    s_store4(sB, rb, tid);
    __syncthreads();
    if (k0 + 64 < K) rb = g_load4(Bt, ldb, k0 + 64, tid);
    mma_ktile(sW + k0, LW, sB, LS, 4, acc, wm, wn, lane);
  }
}
#define ZERO_ACC(acc) _Pragma("unroll") for (int _i = 0; _i < 2; ++_i) _Pragma("unroll") for (int _j = 0; _j < 2; ++_j) _Pragma("unroll") for (int _r = 0; _r < 16; ++_r) acc[_i][_j][_r] = 0.f;

#define EPI_QUADS(acc, ...)                                                       \
  _Pragma("unroll") for (int mi = 0; mi < 2; ++mi)                                \
  _Pragma("unroll") for (int ni = 0; ni < 2; ++ni)                                \
  _Pragma("unroll") for (int g = 0; g < 4; ++g) {                                 \
    const int lrow0 = wm * 64 + mi * 32 + 8 * g + 4 * (lane >> 5);                \
    const int lcol = wn * 64 + ni * 32 + (lane & 31);                             \
    const float v0 = acc[mi][ni][4 * g], v1 = acc[mi][ni][4 * g + 1];             \
    const float v2 = acc[mi][ni][4 * g + 2], v3 = acc[mi][ni][4 * g + 3];         \
    (void)v0; (void)v1; (void)v2; (void)v3; (void)lrow0; (void)lcol;              \
    __VA_ARGS__ }

__device__ __forceinline__ void skinny16x32(const bf16_t* __restrict__ A, int lda, const bf16_t* __restrict__ Bt, int ldb, int K,
                                            f32x4& c0, f32x4& c1, int lane) {
  const int r = lane & 15, q = lane >> 4;
  const bf16_t* ap = A + (size_t)r * lda + q * 8;
  const bf16_t* bp0 = Bt + (size_t)r * ldb + q * 8;
  const bf16_t* bp1 = Bt + (size_t)(16 + r) * ldb + q * 8;
#pragma unroll 8
  for (int k0 = 0; k0 < K; k0 += 32) {
    const bf16x8 a = *(const bf16x8*)(ap + k0);
    const bf16x8 b0 = *(const bf16x8*)(bp0 + k0);
    const bf16x8 b1 = *(const bf16x8*)(bp1 + k0);
    c0 = __builtin_amdgcn_mfma_f32_16x16x32_bf16(a, b0, c0, 0, 0, 0);
    c1 = __builtin_amdgcn_mfma_f32_16x16x32_bf16(a, b1, c1, 0, 0, 0);
  }
}

template <int NACC>
__device__ __forceinline__ void wave4_reduce(f32x4 (&a)[NACC], unsigned char* smem, int w, int lane) {
  float* red = (float*)smem;
  __syncthreads();
#pragma unroll
  for (int i = 0; i < NACC; ++i)
#pragma unroll
    for (int j = 0; j < 4; ++j) red[((w * NACC + i) * 4 + j) * 64 + lane] = a[i][j];
  __syncthreads();
  if (w == 0) {
#pragma unroll
    for (int i = 0; i < NACC; ++i)
#pragma unroll
      for (int j = 0; j < 4; ++j)
        a[i][j] = red[((0 * NACC + i) * 4 + j) * 64 + lane] + red[((1 * NACC + i) * 4 + j) * 64 + lane] +
                  red[((2 * NACC + i) * 4 + j) * 64 + lane] + red[((3 * NACC + i) * 4 + j) * 64 + lane];
  }
}

__device__ __forceinline__ void xcd_tile(int q, int NN, int& mt, int& nt) {
  const int x = blockIdx.x & 7, npan = NN >> 3, p = q >> 6, wi = q & 63;
  mt = x * 16 + (p / npan) * 8 + (wi >> 3);
  nt = (p % npan) * 8 + (wi & 7);
}

#define TID_VARS const int tid = threadIdx.x, lane = tid & 63, w = tid >> 6, wm = w >> 1, wn = w & 1; (void)lane; (void)wm; (void)wn;

template <bool REMAP>
__device__ __forceinline__ void transpose_tile(const float* __restrict__ src, int K, int N, bf16_t* __restrict__ dst,
                                               int kt, int nt, unsigned char* smem) {
  float* sm = (float*)smem;
  const int tid = threadIdx.x; const int k0 = kt * 64, n0 = nt * 64;
  __syncthreads();
#pragma unroll
  for (int ib = 0; ib < 16; ib += 8) {
    float tv[8];
#pragma unroll
    for (int i = 0; i < 8; ++i) {
      int idx = tid + 256 * (ib + i); int r = idx >> 6, c = idx & 63; int n = n0 + c;
      tv[i] = (n < N) ? src[(size_t)(k0 + r) * N + n] : 0.f;
    }
#pragma unroll
    for (int i = 0; i < 8; ++i) {
      int idx = tid + 256 * (ib + i); int r = idx >> 6, c = idx & 63;
      sm[r * 65 + c] = tv[i];
    }
  }
  __syncthreads();
#pragma unroll 4
  for (int i = 0; i < 8; ++i) {
    int idx = tid + 256 * i; int r = idx >> 5, cp = idx & 31; int n = n0 + r;
    int nd = n;
    if (REMAP) { if (n >= 2048 && n < 2056) nd = n + 512; else if (n >= 2056 && n < 2568) nd = n - 8; }
    if (n < N) *(unsigned*)(dst + (size_t)nd * K + k0 + 2 * cp) = pack2(sm[(2 * cp) * 65 + r], sm[(2 * cp + 1) * 65 + r]);
  }
}
__device__ __forceinline__ void convert_chunk(const float* __restrict__ src, bf16_t* __restrict__ dst, size_t base) {
  const int tid = threadIdx.x;
#pragma unroll
  for (int i = 0; i < 8; ++i) {
    size_t e = base + (size_t)(tid + 256 * i) * 8;
    float4 a = *(const float4*)(src + e), b = *(const float4*)(src + e + 4);
    uint4 o; o.x = pack2(a.x, a.y); o.y = pack2(a.z, a.w); o.z = pack2(b.x, b.y); o.w = pack2(b.z, b.w);
    *(uint4*)(dst + e) = o;
  }
}
typedef __attribute__((ext_vector_type(2))) float f32x2_t;
__device__ __forceinline__ unsigned pack4_fp8(float a, float b, float c, float d) {
  int r = __builtin_amdgcn_cvt_pk_fp8_f32(a, b, 0, false);
  r = __builtin_amdgcn_cvt_pk_fp8_f32(c, d, r, true);
  return (unsigned)r;
}
__device__ __forceinline__ void convert_chunk_fp8(const float* __restrict__ src, unsigned char* __restrict__ dst, size_t base, float scale) {
  const int tid = threadIdx.x;
#pragma unroll
  for (int i = 0; i < 4; ++i) {
    size_t e = base + (size_t)(tid + 256 * i) * 16;
    float4 a = *(const float4*)(src + e), b = *(const float4*)(src + e + 4), c = *(const float4*)(src + e + 8), d = *(const float4*)(src + e + 12);
    uint4 o;
    o.x = pack4_fp8(a.x * scale, a.y * scale, a.z * scale, a.w * scale);
    o.y = pack4_fp8(b.x * scale, b.y * scale, b.z * scale, b.w * scale);
    o.z = pack4_fp8(c.x * scale, c.y * scale, c.z * scale, c.w * scale);
    o.w = pack4_fp8(d.x * scale, d.y * scale, d.z * scale, d.w * scale);
    *(uint4*)(dst + e) = o;
  }
}
__device__ __forceinline__ void mod_slab(const Params& p, int item, unsigned char* smem) {
  const int tid = threadIdx.x, lane = tid & 63, w = tid >> 6;
  const int n0 = item * 16, nl = lane & 15, kq = lane >> 4;
  f32x4 acc[9];
#pragma unroll
  for (int i = 0; i < 9; ++i) acc[i] = (f32x4){0.f, 0.f, 0.f, 0.f};
  for (int ks = 0; ks < 8; ++ks) {
    const int kb = w * 256 + ks * 32 + kq * 8;
    bf16x8 b;
#pragma unroll
    for (int j = 0; j < 8; ++j) b[j] = (short)f2bf(p.w_mod[(size_t)(kb + j) * 6144 + n0 + nl]);
#pragma unroll
    for (int mi = 0; mi < 9; ++mi) {
      int row = mi * 16 + nl; if (row > 135) row = 135;
      const float* cp = (row < 8) ? p.c_prompt + row * 1024 : p.c_sample + (row - 8) * 1024;
      float4 x0 = *(const float4*)(cp + kb), x1 = *(const float4*)(cp + kb + 4);
      bf16x8 a;
      a[0] = (short)f2bf(x0.x * sigmoidf_(x0.x)); a[1] = (short)f2bf(x0.y * sigmoidf_(x0.y));
      a[2] = (short)f2bf(x0.z * sigmoidf_(x0.z)); a[3] = (short)f2bf(x0.w * sigmoidf_(x0.w));
      a[4] = (short)f2bf(x1.x * sigmoidf_(x1.x)); a[5] = (short)f2bf(x1.y * sigmoidf_(x1.y));
      a[6] = (short)f2bf(x1.z * sigmoidf_(x1.z)); a[7] = (short)f2bf(x1.w * sigmoidf_(x1.w));
      acc[mi] = __builtin_amdgcn_mfma_f32_16x16x32_bf16(a, b, acc[mi], 0, 0, 0);
    }
  }
  float* red = (float*)smem;
  __syncthreads();
#pragma unroll
  for (int mi = 0; mi < 9; ++mi)
#pragma unroll
    for (int r = 0; r < 4; ++r) red[(w * 36 + mi * 4 + r) * 64 + lane] = acc[mi][r];
  __syncthreads();
  float* MOD = (float*)(p.ws + OFF_MOD);
  for (int i = 0; i < 9; ++i) {
    int idx = tid + 256 * i; int e = idx >> 6, l = idx & 63;
    float s = red[(0 * 36 + e) * 64 + l] + red[(1 * 36 + e) * 64 + l] + red[(2 * 36 + e) * 64 + l] + red[(3 * 36 + e) * 64 + l];
    int mi = e >> 2, r = e & 3; int row = mi * 16 + (l >> 4) * 4 + r; int col = n0 + (l & 15);
    if (row < 136) MOD[(size_t)row * 6144 + col] = s + p.b_mod[col];
  }
}
__device__ __forceinline__ void phase_A(const Params& p, unsigned char* smem) {
  const int n_items = 384 + 1168 + 128 + 128 + 256 + 512 + 16 + 1024 + 1024 + 2 + 128 + 1;
  for (int it = blockIdx.x; it < n_items; it += gridDim.x) {
    int i = it;
    if (i == n_items - 1) {
      float* cb = (float*)(p.ws + OFF_CB);
      const int tid = threadIdx.x;
      for (int k = tid; k < 4616; k += 256) cb[k] = p.b_in[k];
      if (tid < 4) cb[4624 + tid] = p.b_fgate[tid];
      for (int k = tid; k < 512; k += 256) { cb[4632 + k] = p.gn_gain[k]; cb[5144 + k] = p.pool_scale[k]; }
      for (int k = tid; k < 1024; k += 256) { cb[5656 + k] = p.ln1_g[k]; cb[6680 + k] = p.ln1_b[k]; cb[7704 + k] = p.ln2_g[k]; cb[8728 + k] = p.ln2_b[k]; }
      continue;
    }
    if (i < 384) { mod_slab(p, i, smem); continue; } i -= 384;
    if (i < 1168) { transpose_tile<true>(p.w_in, 1024, NIN, (bf16_t*)(p.ws + OFF_WIN), i / 73, i % 73, smem); continue; } i -= 1168;
    if (i < 128) { transpose_tile<false>(p.w_a, 512, 1024, (bf16_t*)(p.ws + OFF_WA), i / 16, i % 16, smem); continue; } i -= 128;
    if (i < 128) { transpose_tile<false>(p.w_b, 512, 1024, (bf16_t*)(p.ws + OFF_WB), i / 16, i % 16, smem); continue; } i -= 128;
    if (i < 256) { transpose_tile<false>(p.w_out, 1024, 1024, (bf16_t*)(p.ws + OFF_WOUT), i / 16, i % 16, smem); continue; } i -= 256;
    if (i < 512) { transpose_tile<false>(p.w_pq, 1024, 2048, (bf16_t*)(p.ws + OFF_WPQ), i / 32, i % 32, smem); continue; } i -= 512;
    if (i < 16) { int g = i >> 2, r = i & 3;
      transpose_tile<false>(p.w_pool + g * 16384, 128, 128, (bf16_t*)(p.ws + OFF_WPOOL) + g * 16384, r >> 1, r & 1, smem); continue; } i -= 16;
    if (i < 1024) { convert_chunk_fp8(p.peer_u, p.ws + OFF_PU, (size_t)i * 16384, 512.f); continue; } i -= 1024;
    if (i < 1024) { convert_chunk_fp8(p.peer_v, p.ws + OFF_PV, (size_t)i * 16384, 64.f); continue; } i -= 1024;
    if (i < 2) { convert_chunk(p.subkeys, (bf16_t*)(p.ws + OFF_SUBK), (size_t)i * 16384); continue; } i -= 2;
    {
      const float4* src = (const float4*)(p.st_pool + (size_t)i * 7680 + 512);
      float4* dst = (float4*)(p.out + OUT_PS + (size_t)i * 7680);
#pragma unroll
      for (int k = 0; k < 7; ++k) dst[threadIdx.x + 256 * k] = src[threadIdx.x + 256 * k];
    }
  }
}

__device__ __forceinline__ void phase_B(const Params& p) {
  const int tid = threadIdx.x, lane = tid & 63, w = tid >> 6;
  const float* MOD = (const float*)(p.ws + OFF_MOD);
  bf16_t* H = (bf16_t*)(p.ws + OFF_H);
  const int rstep = gridDim.x * 4;
  float4 nx[4];
  {
    const int row = blockIdx.x * 4 + w;
    if (row < NT) { const float* xr = x_row(p, row);
#pragma unroll
      for (int i = 0; i < 4; ++i) nx[i] = *(const float4*)(xr + i * 256 + lane * 4); }
  }
  for (int row = blockIdx.x * 4 + w; row < NT; row += rstep) {
    float4 v[4];
#pragma unroll
    for (int i = 0; i < 4; ++i) v[i] = nx[i];
    if (row + rstep < NT) { const float* xn = x_row(p, row + rstep);
#pragma unroll
      for (int i = 0; i < 4; ++i) nx[i] = *(const float4*)(xn + i * 256 + lane * 4); }
    float s = 0.f;
#pragma unroll
    for (int i = 0; i < 4; ++i) s += v[i].x + v[i].y + v[i].z + v[i].w;
    float mu = wave_sum(s) * (1.f / 1024.f);
    float q = 0.f;
#pragma unroll
    for (int i = 0; i < 4; ++i) { float a = v[i].x - mu, b = v[i].y - mu, c = v[i].z - mu, d = v[i].w - mu; q += a * a + b * b + c * c + d * d; }
    float rstd = rsqrtf(wave_sum(q) * (1.f / 1024.f) + LN_EPS);
    const float* mr = MOD + (size_t)mod_row(row) * 6144;
#pragma unroll
    for (int i = 0; i < 4; ++i) {
      int c = i * 256 + lane * 4;
      float4 sh = *(const float4*)(mr + c), sc = *(const float4*)(mr + 1024 + c);
      uint2 o;
      o.x = pack2((v[i].x - mu) * rstd * (1.f + sc.x) + sh.x, (v[i].y - mu) * rstd * (1.f + sc.y) + sh.y);
      o.y = pack2((v[i].z - mu) * rstd * (1.f + sc.z) + sh.z, (v[i].w - mu) * rstd * (1.f + sc.w) + sh.w);
      *(uint2*)(H + (size_t)row * 1024 + c) = o;
    }
  }
}

__device__ __forceinline__ void phase_C(const Params& p, unsigned char* smem) {
  TID_VARS
  const bf16_t* H = (const bf16_t*)(p.ws + OFF_H);
  const bf16_t* WT = (const bf16_t*)(p.ws + OFF_WIN);
  bf16_t* Q = (bf16_t*)(p.ws + OFF_Q); bf16_t* Kb = (bf16_t*)(p.ws + OFF_K); bf16_t* V = (bf16_t*)(p.ws + OFF_V);
  bf16_t* O = (bf16_t*)(p.ws + OFF_O); bf16_t* KT = (bf16_t*)(p.ws + OFF_KT); bf16_t* VT = (bf16_t*)(p.ws + OFF_VT);
  float* IG = (float*)(p.ws + OFF_IG); float* LF = (float*)(p.ws + OFF_LF); float* U = (float*)(p.ws + OFF_U);
  const int n_items = 129 * 21;
  for (int it = blockIdx.x; it < n_items; it += gridDim.x) {
    const int mt = it / 21, nt = it % 21;
    f32x16 acc[2][2]; ZERO_ACC(acc)
    gemm_gg128(H + (size_t)mt * 128 * 1024, 1024, WT + (size_t)nt * 128 * 1024, 1024, 1024, smem, acc);
    const int row_base = mt * 128, col_base = nt * 128;
    if (nt < 16) {
      const int sect = nt >> 2;
      const int hh = nt & 3;
      EPI_QUADS(acc, {
        const int col = col_base + lcol; const float bias = P_BIN(p)[col];
        const int c512 = col & 511; const int row0 = row_base + lrow0;
        float a0 = v0 + bias, a1 = v1 + bias, a2 = v2 + bias, a3 = v3 + bias;
        if (sect == 0) {
          Q[(size_t)(row0) * 512 + c512] = f2bf(a0); Q[(size_t)(row0 + 1) * 512 + c512] = f2bf(a1);
          Q[(size_t)(row0 + 2) * 512 + c512] = f2bf(a2); Q[(size_t)(row0 + 3) * 512 + c512] = f2bf(a3);
        } else if (sect == 1) {
          const float sc = 0.08838834764831845f;
          a0 *= sc; a1 *= sc; a2 *= sc; a3 *= sc;
          Kb[(size_t)(row0) * 512 + c512] = f2bf(a0); Kb[(size_t)(row0 + 1) * 512 + c512] = f2bf(a1);
          Kb[(size_t)(row0 + 2) * 512 + c512] = f2bf(a2); Kb[(size_t)(row0 + 3) * 512 + c512] = f2bf(a3);
          if (mt < 128) {
            const int b = mt >> 4, t = (mt & 15) * 128 + lrow0;
            uint2 o; o.x = pack2(a0, a1); o.y = pack2(a2, a3);
            *(uint2*)(KT + ((size_t)((b * 4 + hh) * 128 + (c512 & 127))) * 2048 + t) = o;
          }
        } else if (sect == 2) {
          V[(size_t)(row0) * 512 + c512] = f2bf(a0); V[(size_t)(row0 + 1) * 512 + c512] = f2bf(a1);
          V[(size_t)(row0 + 2) * 512 + c512] = f2bf(a2); V[(size_t)(row0 + 3) * 512 + c512] = f2bf(a3);
          if (mt < 128) {
            const int b = mt >> 4, t = (mt & 15) * 128 + lrow0;
            uint2 o; o.x = pack2(a0, a1); o.y = pack2(a2, a3);
            *(uint2*)(VT + ((size_t)((b * 4 + hh) * 128 + (c512 & 127))) * 2048 + t) = o;
          }
        } else {
          O[(size_t)(row0) * 512 + c512] = f2bf(sigmoidf_(a0)); O[(size_t)(row0 + 1) * 512 + c512] = f2bf(sigmoidf_(a1));
          O[(size_t)(row0 + 2) * 512 + c512] = f2bf(sigmoidf_(a2)); O[(size_t)(row0 + 3) * 512 + c512] = f2bf(sigmoidf_(a3));
        }
      })
    } else if (nt < 20) {
      EPI_QUADS(acc, {
        const int uc = (nt - 16) * 128 + lcol; const int row0 = row_base + lrow0;
        const float bias = P_BIN(p)[2056 + uc];
        U[(size_t)(row0) * 512 + uc] = v0 + bias; U[(size_t)(row0 + 1) * 512 + uc] = v1 + bias;
        U[(size_t)(row0 + 2) * 512 + uc] = v2 + bias; U[(size_t)(row0 + 3) * 512 + uc] = v3 + bias;
      })
    } else {
      EPI_QUADS(acc, {
        const int row0 = row_base + lrow0;
        if (lcol < 4) {
          const float bias = P_BIN(p)[2048 + lcol];
          IG[(size_t)(row0) * 4 + lcol] = v0 + bias; IG[(size_t)(row0 + 1) * 4 + lcol] = v1 + bias;
          IG[(size_t)(row0 + 2) * 4 + lcol] = v2 + bias; IG[(size_t)(row0 + 3) * 4 + lcol] = v3 + bias;
        } else if (lcol < 8) {
          const int hh = lcol - 4; const float bias = P_BIN(p)[2052 + hh] + P_FG(p)[hh];
          LF[(size_t)(row0) * 4 + hh] = logsigmoidf_(v0 + bias); LF[(size_t)(row0 + 1) * 4 + hh] = logsigmoidf_(v1 + bias);
          LF[(size_t)(row0 + 2) * 4 + hh] = logsigmoidf_(v2 + bias); LF[(size_t)(row0 + 3) * 4 + hh] = logsigmoidf_(v3 + bias);
        }
      })
    }
  }
}

__device__ __forceinline__ void d1_prompt_chunk(const Params& p, int item, unsigned char* smem) {
  TID_VARS
  const int bh = item >> 4, c = item & 15, b = bh >> 2, h = bh & 3;
  const int r0 = b * 2048 + c * 128;
  float* misc = (float*)(smem + SM_MISC);
  float* s_lf = misc, *s_ig = misc + 128, *s_b = misc + 256, *s_g = misc + 384, *s_d = misc + 512;
  const float* IG = (const float*)(p.ws + OFF_IG); const float* LF = (const float*)(p.ws + OFF_LF);
  __syncthreads();
  if (tid < 128) { s_lf[tid] = LF[(size_t)(r0 + tid) * 4 + h]; s_ig[tid] = IG[(size_t)(r0 + tid) * 4 + h]; }
  __syncthreads();
  if (tid < 128) { float a = 0.f; for (int j = 0; j <= tid; ++j) a += s_lf[j]; s_b[tid] = a; }
  __syncthreads();
  const float Btot = s_b[127];
  if (tid < 128) s_g[tid] = Btot - s_b[tid] + s_ig[tid];
  __syncthreads();
  float amax = -3.0e38f;
  for (int j = 0; j < 128; ++j) amax = fmaxf(amax, s_g[j]);
  if (tid < 128) s_d[tid] = __expf(s_g[tid] - amax);
  if (tid == 0) { ((float*)(p.ws + OFF_CHB))[item * 32] = Btot; ((float*)(p.ws + OFF_CHB))[item * 32 + 1] = amax; }
  __syncthreads();
  const bf16_t* KT = (const bf16_t*)(p.ws + OFF_KT) + (size_t)bh * 128 * 2048 + c * 128;
  const bf16_t* VT = (const bf16_t*)(p.ws + OFF_VT) + (size_t)bh * 128 * 2048 + c * 128;
  if (tid < 128) {
    const uint4* kr = (const uint4*)(KT + (size_t)tid * 2048);
    float a = 0.f;
#pragma unroll 4
    for (int j = 0; j < 16; ++j) {
      uint4 v = kr[j]; const float* d = s_d + j * 8;
      a += bflo(v.x) * d[0] + bfhi(v.x) * d[1] + bflo(v.y) * d[2] + bfhi(v.y) * d[3] + bflo(v.z) * d[4] + bfhi(v.z) * d[5] + bflo(v.w) * d[6] + bfhi(v.w) * d[7];
    }
    ((float*)(p.ws + OFF_NLOC))[(size_t)item * 128 + tid] = a;
  }
  f32x16 acc[2][2]; ZERO_ACC(acc)
  gemm_gg<true>(VT, 2048, KT, 2048, 128, smem, acc, s_d);
  float* SB = p.out + OUT_SBUF + (size_t)item * 16384;
  EPI_QUADS(acc, {
    SB[(size_t)(lrow0) * 128 + lcol] = v0; SB[(size_t)(lrow0 + 1) * 128 + lcol] = v1;
    SB[(size_t)(lrow0 + 2) * 128 + lcol] = v2; SB[(size_t)(lrow0 + 3) * 128 + lcol] = v3;
  })
}
__device__ __forceinline__ void d1_sample_step(const Params& p, int item, unsigned char* smem) {
  const int tid = threadIdx.x;
  const int s = item >> 2, h = item & 3, row = NP + s;
  float* misc = (float*)(smem + SM_MISC);
  float* s_q = misc, *s_k = misc + 128, *s_red = misc + 256, *s_num = misc + 512  , *s_h = misc + 768  ;
  bf16_t* Q = (bf16_t*)(p.ws + OFF_Q); const bf16_t* Kb = (const bf16_t*)(p.ws + OFF_K); const bf16_t* V = (const bf16_t*)(p.ws + OFF_V);
  const bf16_t* O = (const bf16_t*)(p.ws + OFF_O);
  __syncthreads();
  if (tid < 128) { s_q[tid] = bf2f(Q[(size_t)row * 512 + h * 128 + tid]); s_k[tid] = bf2f(Kb[(size_t)row * 512 + h * 128 + tid]); }
  else {
    const int c = tid - 128, g = h, wlen = 2 << g;
    const float ut = ((const float*)(p.ws + OFF_U))[(size_t)row * 512 + g * 128 + c];
    const float* __restrict__ pre = p.st_pool + (size_t)s * 15 * 512 + g * 128 + c;
    float sum = ut;
    for (int q = 1; q < wlen; ++q) sum += pre[(size_t)(15 - q) * 512];
    s_red[c] = sum / (float)wlen - ut;
    p.out[OUT_PS + ((size_t)s * 15 + 14) * 512 + g * 128 + c] = ut;
  }
  __syncthreads();
  {
    const int d = tid & 127, ch = tid >> 7, g = h;
    const float* __restrict__ wp = p.w_pool + (size_t)g * 16384 + (size_t)(ch * 64) * 128 + d;
    float a = 0.f;
#pragma unroll
    for (int cb = 0; cb < 64; cb += 16) {
      float wv[16];
#pragma unroll
      for (int j = 0; j < 16; ++j) wv[j] = wp[(size_t)(cb + j) * 128];
#pragma unroll
      for (int j = 0; j < 16; ++j) a += s_red[ch * 64 + cb + j] * wv[j];
    }
    s_num[tid] = a;
    __syncthreads();
    if (tid < 128) ((bf16_t*)(p.out + OUT_PB))[(size_t)row * 512 + g * 128 + tid] = f2bf((s_num[tid] + s_num[tid + 128]) * P_PS(p)[g * 128 + tid]);
    __syncthreads();
  }
  const float ig = ((const float*)(p.ws + OFF_IG))[(size_t)row * 4 + h];
  const float lf = ((const float*)(p.ws + OFF_LF))[(size_t)row * 4 + h];
  const float m0 = p.st_m[s * 4 + h];
  const float* n0 = p.st_n + (size_t)(s * 4 + h) * 128;
  float qk = 0.f, qn = 0.f;
#pragma unroll 4
  for (int j = 0; j < 128; ++j) { qk += s_q[j] * s_k[j]; qn += s_q[j] * n0[j]; }
  const float log_g = lf + m0;
  const float mt = fmaxf(log_g, ig);
  const float wq = __expf(ig - mt) * qk;
  const float wst = __expf(log_g - mt);
  const float dcs = __expf(ig - mt);
  const float dcc = __expf(lf + m0 - mt);
  const int dv = tid & 127, half = tid >> 7;
  const float vv = bf2f(V[(size_t)row * 512 + h * 128 + dv]);
  const float* __restrict__ C0 = p.st_C + (size_t)(s * 4 + h) * 16384;
  float* __restrict__ Cn = p.out + OUT_CS + (size_t)(s * 4 + h) * 16384;
  float part = 0.f;
#pragma unroll
  for (int jb = 0; jb < 64; jb += 16) {
    float c0v[16];
#pragma unroll
    for (int j = 0; j < 16; ++j) c0v[j] = C0[(half * 64 + jb + j) * 128 + dv];
#pragma unroll
    for (int j = 0; j < 16; ++j) {
      const int dk = half * 64 + jb + j;
      part += s_q[dk] * c0v[j];
      Cn[dk * 128 + dv] = dcc * c0v[j] + dcs * s_k[dk] * vv;
    }
  }
  s_num[tid] = part;
  if (tid < 128) p.out[OUT_NS + (size_t)(s * 4 + h) * 128 + tid] = dcc * n0[tid] + dcs * s_k[tid];
  if (tid == 0) p.out[OUT_MS + s * 4 + h] = mt;
  __syncthreads();
  if (tid < 128) {
    float num = wq * vv + wst * (s_num[tid] + s_num[tid + 128]);
    float den = wq + wst * qn;
    float hv = num / fmaxf(fabsf(den), __expf(-mt));
    s_h[tid] = hv;
  }
  __syncthreads();
  if (tid < 128) {
    float mu = 0.f;
#pragma unroll 4
    for (int j = 0; j < 128; ++j) mu += s_h[j];
    mu *= (1.f / 128.f);
    float var = 0.f;
#pragma unroll 4
    for (int j = 0; j < 128; ++j) { float d = s_h[j] - mu; var += d * d; }
    var *= (1.f / 128.f);
    float y = (s_h[tid] - mu) * rsqrtf(var + LN_EPS) * P_GN(p)[h * 128 + tid] * bf2f(O[(size_t)row * 512 + h * 128 + tid]);
    Q[(size_t)row * 512 + h * 128 + tid] = f2bf(y);
  }
}
template <int WLEN>
__device__ __forceinline__ void pool_rows(const Params& p, const float* __restrict__ U, int mt, int g, unsigned* sW32, int tid) {
  const int cp = tid & 63, qtr = tid >> 6;
  if (mt < 128) {
    const int b = mt >> 4, t0 = (mt & 15) * 128 + qtr * 32;
    const float* Ub = U + (size_t)b * 2048 * 512 + g * 128 + cp * 2;
    float2 u[31 + WLEN];
#pragma unroll
    for (int k = 0; k < 31 + WLEN; ++k) {
      const int t = t0 - (WLEN - 1) + k;
      u[k] = (t >= 0) ? *(const float2*)(Ub + (size_t)t * 512) : make_float2(0.f, 0.f);
    }
    float s0 = 0.f, s1 = 0.f;
#pragma unroll
    for (int k = 0; k < WLEN - 1; ++k) { s0 += u[k].x; s1 += u[k].y; }
#pragma unroll
    for (int j = 0; j < 32; ++j) {
      const float2 ut = u[WLEN - 1 + j];
      const int t = t0 + j;
      s0 += ut.x; s1 += ut.y;
      const float rc = 1.f / (float)min(WLEN, t + 1);
      sW32[(qtr * 32 + j) * (LW / 2) + cp] = pack2(s0 * rc - ut.x, s1 * rc - ut.y);
      s0 -= u[j].x; s1 -= u[j].y;
      if (t >= 2033) *(float2*)(p.out + OUT_PP + ((size_t)b * 15 + (t - 2033)) * 512 + g * 128 + cp * 2) = ut;
    }
  } else {
    const float rc = 1.f / (float)WLEN;
#pragma unroll 2
    for (int j = 0; j < 32; ++j) {
      const int sidx = qtr * 32 + j;
      const float2 ut = *(const float2*)(U + (size_t)(NP + sidx) * 512 + g * 128 + cp * 2);
      const float* __restrict__ pre = p.st_pool + (size_t)sidx * 15 * 512 + g * 128 + cp * 2;
      float2 pr[WLEN - 1];
#pragma unroll
      for (int q = 1; q < WLEN; ++q) pr[q - 1] = *(const float2*)(pre + (size_t)(15 - q) * 512);
      float s0 = ut.x, s1 = ut.y;
#pragma unroll
      for (int q = 0; q < WLEN - 1; ++q) { s0 += pr[q].x; s1 += pr[q].y; }
      sW32[sidx * (LW / 2) + cp] = pack2(s0 * rc - ut.x, s1 * rc - ut.y);
      *(float2*)(p.out + OUT_PS + ((size_t)sidx * 15 + 14) * 512 + g * 128 + cp * 2) = ut;
    }
  }
}
__device__ __forceinline__ void d1_pool(const Params& p, int item, unsigned char* smem) {
  TID_VARS
  const int mt = item >> 2, g = item & 3;
  const float* U = (const float*)(p.ws + OFF_U);
  bf16_t* sW = (bf16_t*)(smem + SM_W);
  __syncthreads();
  if (g == 0) pool_rows<2>(p, U, mt, g, (unsigned*)sW, tid);
  else if (g == 1) pool_rows<4>(p, U, mt, g, (unsigned*)sW, tid);
  else if (g == 2) pool_rows<8>(p, U, mt, g, (unsigned*)sW, tid);
  else pool_rows<16>(p, U, mt, g, (unsigned*)sW, tid);
  f32x16 acc[2][2]; ZERO_ACC(acc)
  gemm_sg(sW, (const bf16_t*)(p.ws + OFF_WPOOL) + g * 16384, 128, 128, smem, acc);
  bf16_t* PB = (bf16_t*)(p.out + OUT_PB);
  const int row_base = mt * 128;
  const int grp_col0 = g * 128;
  EPI_QUADS(acc, {
    const int col = grp_col0 + lcol; const float sc = P_PS(p)[col]; const int row0 = row_base + lrow0;
    PB[(size_t)(row0) * 512 + col] = f2bf(v0 * sc); PB[(size_t)(row0 + 1) * 512 + col] = f2bf(v1 * sc);
    PB[(size_t)(row0 + 2) * 512 + col] = f2bf(v2 * sc); PB[(size_t)(row0 + 3) * 512 + col] = f2bf(v3 * sc);
  })
}
__device__ __forceinline__ void phase_D1(const Params& p, unsigned char* smem) {
  for (int it = blockIdx.x; it < 512; it += gridDim.x) d1_prompt_chunk(p, it, smem);
  for (int it = blockIdx.x; it < 512; it += gridDim.x) d1_sample_step(p, it, smem);
  for (int it = blockIdx.x; it < 512; it += gridDim.x) d1_pool(p, it, smem);
}

__device__ __forceinline__ void phase_D2(const Params& p) {
  const int tid = threadIdx.x;
  const float* CHB = (const float*)(p.ws + OFF_CHB);
  const int n_items = 32 * 64 + 32;
  for (int it = blockIdx.x; it < n_items; it += gridDim.x) {
    if (it < 2048) {
      const int bh = it >> 6, e = (it & 63) * 256 + tid;
      const float* __restrict__ SB = p.out + OUT_SBUF + (size_t)bh * 16 * 16384 + e;
      bf16_t* __restrict__ CT = (bf16_t*)(p.ws + OFF_CT) + (size_t)bh * 16 * 16384 + e;
      float dcv[16], dsv[16], sb[16];
#pragma unroll
      for (int c = 0; c < 16; ++c) sb[c] = SB[(size_t)c * 16384];
      {
        float Bv[16], av[16];
#pragma unroll
        for (int c = 0; c < 16; ++c) { Bv[c] = CHB[(bh * 16 + c) * 32]; av[c] = CHB[(bh * 16 + c) * 32 + 1]; }
        float m = 0.f;
#pragma unroll
        for (int c = 0; c < 16; ++c) { float mn = fmaxf(Bv[c] + m, av[c]); dcv[c] = __expf(Bv[c] + m - mn); dsv[c] = __expf(av[c] - mn); m = mn; }
      }
      float C = 0.f;
#pragma unroll
      for (int c = 0; c < 16; ++c) { CT[(size_t)c * 16384] = f2bf(C); C = dcv[c] * C + dsv[c] * sb[c]; }
      const int dv = e >> 7, dk = e & 127;
      p.out[OUT_CP + (size_t)bh * 16384 + dk * 128 + dv] = C;
    } else {
      const int bh = it - 2048;
      if (tid < 128) {
        const float* NL = (const float*)(p.ws + OFF_NLOC) + (size_t)bh * 16 * 128 + tid;
        float* NPV = (float*)(p.ws + OFF_NPREV) + (size_t)bh * 16 * 128 + tid;
        float* MPV = (float*)(p.ws + OFF_MPREV) + bh * 16 * 32;
        float m = 0.f, n = 0.f;
        for (int c = 0; c < 16; ++c) {
          NPV[c * 128] = n;
          if (tid == 0) MPV[c * 32] = m;
          float B = CHB[(bh * 16 + c) * 32], a = CHB[(bh * 16 + c) * 32 + 1];
          float mn = fmaxf(B + m, a);
          n = __expf(B + m - mn) * n + __expf(a - mn) * NL[c * 128];
          m = mn;
        }
        p.out[OUT_NP + bh * 128 + tid] = n;
        if (tid == 0) p.out[OUT_MP + bh] = m;
      }
    }
  }
}

__device__ __forceinline__ void phase_D3(const Params& p, unsigned char* smem) {
  TID_VARS
  float* misc = (float*)(smem + SM_MISC);
  float* s_lf = misc, *s_ig = misc + 128, *s_b = misc + 256, *s_colf = misc + 384, *s_rowf = misc + 512, *s_wst = misc + 640, *s_inv = misc + 768;
  bf16_t* sW = (bf16_t*)(smem + SM_W);
  float* sH = (float*)smem;
  bf16_t* Q = (bf16_t*)(p.ws + OFF_Q); const bf16_t* Kb = (const bf16_t*)(p.ws + OFF_K); const bf16_t* O = (const bf16_t*)(p.ws + OFF_O);
  const float* IG = (const float*)(p.ws + OFF_IG); const float* LF = (const float*)(p.ws + OFF_LF);
  for (int item = blockIdx.x; item < 512; item += gridDim.x) {
    const int bh = item >> 4, c = item & 15, b = bh >> 2, h = bh & 3;
    const int r0 = b * 2048 + c * 128;
    const float m_prev = ((const float*)(p.ws + OFF_MPREV))[item * 32];
    __syncthreads();
    if (tid < 128) { s_lf[tid] = LF[(size_t)(r0 + tid) * 4 + h]; s_ig[tid] = IG[(size_t)(r0 + tid) * 4 + h];
                     misc[896 + tid] = ((const float*)(p.ws + OFF_NPREV))[(size_t)item * 128 + tid]; }
    __syncthreads();
    if (tid < 128) { float a = 0.f;
#pragma unroll 2
      for (int j = 0; j <= tid; ++j) a += s_lf[j];
      s_b[tid] = a; s_colf[tid] = s_ig[tid] - a; }
    __syncthreads();
    if (tid < 128) {
      float pm = -3.0e38f;
#pragma unroll 2
      for (int j = 0; j <= tid; ++j) pm = fmaxf(pm, s_colf[j]);
      float bt = s_b[tid];
      float mt = bt + fmaxf(m_prev, pm);
      s_rowf[tid] = bt - mt;
      s_wst[tid] = __expf(bt + m_prev - mt);
      s_inv[tid] = mt;
    }
    const bf16_t* Qp = Q + (size_t)r0 * 512 + h * 128;
    const bf16_t* Kp = Kb + (size_t)r0 * 512 + h * 128;
    f32x16 acc[2][2]; ZERO_ACC(acc)
    gemm_gg<false>(Qp, 512, Kp, 512, 128, smem, acc, nullptr);
    EPI_QUADS(acc, {
      const float cf = s_colf[lcol];
      float w0 = (lcol <= lrow0) ? __expf(s_rowf[lrow0] + cf) * v0 : 0.f;
      float w1 = (lcol <= lrow0 + 1) ? __expf(s_rowf[lrow0 + 1] + cf) * v1 : 0.f;
      float w2 = (lcol <= lrow0 + 2) ? __expf(s_rowf[lrow0 + 2] + cf) * v2 : 0.f;
      float w3 = (lcol <= lrow0 + 3) ? __expf(s_rowf[lrow0 + 3] + cf) * v3 : 0.f;
      sW[(lrow0) * LW + lcol] = f2bf(w0); sW[(lrow0 + 1) * LW + lcol] = f2bf(w1);
      sW[(lrow0 + 2) * LW + lcol] = f2bf(w2); sW[(lrow0 + 3) * LW + lcol] = f2bf(w3);
    })
    __syncthreads();
    if (tid < 128) {
      float d1 = 0.f;
      const unsigned* wr = (const unsigned*)(sW + tid * LW);
#pragma unroll 4
      for (int j = 0; j < 64; ++j) { unsigned u = wr[j]; d1 += bflo(u) + bfhi(u); }
      const float* npv = misc + 896;
      const uint4* qr = (const uint4*)(Qp + (size_t)tid * 512);
      float qn = 0.f;
#pragma unroll 2
      for (int j = 0; j < 16; ++j) {
        const uint4 v = qr[j]; const float* n = npv + j * 8;
        qn += bflo(v.x) * n[0] + bfhi(v.x) * n[1] + bflo(v.y) * n[2] + bfhi(v.y) * n[3] + bflo(v.z) * n[4] + bfhi(v.z) * n[5] + bflo(v.w) * n[6] + bfhi(v.w) * n[7];
      }
      float den = d1 + s_wst[tid] * qn;
      float mt = s_inv[tid];
      s_inv[tid] = 1.f / fmaxf(fabsf(den), __expf(-mt));
    }
    ZERO_ACC(acc)
    gemm_gg<false>(Qp, 512, (const bf16_t*)(p.ws + OFF_CT) + (size_t)item * 16384, 128, 128, smem, acc, nullptr);
    EPI_QUADS(acc, {
      acc[mi][ni][4 * g] = v0 * s_wst[lrow0]; acc[mi][ni][4 * g + 1] = v1 * s_wst[lrow0 + 1];
      acc[mi][ni][4 * g + 2] = v2 * s_wst[lrow0 + 2]; acc[mi][ni][4 * g + 3] = v3 * s_wst[lrow0 + 3];
    })
    gemm_sg(sW, (const bf16_t*)(p.ws + OFF_VT) + (size_t)bh * 128 * 2048 + c * 128, 2048, 128, smem, acc);
    __syncthreads();
    EPI_QUADS(acc, {
      sH[(lrow0) * 129 + lcol] = v0 * s_inv[lrow0]; sH[(lrow0 + 1) * 129 + lcol] = v1 * s_inv[lrow0 + 1];
      sH[(lrow0 + 2) * 129 + lcol] = v2 * s_inv[lrow0 + 2]; sH[(lrow0 + 3) * 129 + lcol] = v3 * s_inv[lrow0 + 3];
    })
    __syncthreads();
    {
      const int t = tid >> 1, half = tid & 1;
      const float* hr = sH + t * 129 + half * 64;
      float s = 0.f;
#pragma unroll 4
      for (int j = 0; j < 64; ++j) s += hr[j];
      s += __shfl_xor(s, 1);
      const float mu = s * (1.f / 128.f);
      float q = 0.f;
#pragma unroll 4
      for (int j = 0; j < 64; ++j) { float d = hr[j] - mu; q += d * d; }
      q += __shfl_xor(q, 1);
      const float rstd = rsqrtf(q * (1.f / 128.f) + LN_EPS);
      const size_t gofs = (size_t)(r0 + t) * 512 + h * 128 + half * 64;
      const float* __restrict__ gn = P_GN(p) + h * 128 + half * 64;
      uint4 ov[8];
#pragma unroll
      for (int k = 0; k < 8; ++k) ov[k] = *(const uint4*)(O + gofs + 8 * k);
#pragma unroll
      for (int k = 0; k < 8; ++k) {
        const float* hk = hr + 8 * k; const float* gk = gn + 8 * k;
        uint4 o;
        o.x = pack2((hk[0] - mu) * rstd * gk[0] * bflo(ov[k].x), (hk[1] - mu) * rstd * gk[1] * bfhi(ov[k].x));
        o.y = pack2((hk[2] - mu) * rstd * gk[2] * bflo(ov[k].y), (hk[3] - mu) * rstd * gk[3] * bfhi(ov[k].y));
        o.z = pack2((hk[4] - mu) * rstd * gk[4] * bflo(ov[k].z), (hk[5] - mu) * rstd * gk[5] * bfhi(ov[k].z));
        o.w = pack2((hk[6] - mu) * rstd * gk[6] * bflo(ov[k].w), (hk[7] - mu) * rstd * gk[7] * bfhi(ov[k].w));
        *(uint4*)(Q + gofs + 8 * k) = o;
      }
    }
  }
}

__device__ __forceinline__ void phase_E(const Params& p, unsigned char* smem) {
  TID_VARS
  const bf16_t* H = (const bf16_t*)(p.ws + OFF_H);
  const bf16_t* WT = (const bf16_t*)(p.ws + OFF_WIN);
  const bf16_t* HA = (const bf16_t*)(p.ws + OFF_Q);
  const bf16_t* PB = (const bf16_t*)(p.out + OUT_PB);
  bf16_t* MG = (bf16_t*)(p.ws + OFF_MERGED);
  for (int pc = blockIdx.x; pc < 256; pc += gridDim.x) {
    const int row0 = NP + (pc & 7) * 16, col0 = (pc >> 3) * 32;
    const f32x4 z4 = {0.f, 0.f, 0.f, 0.f};
    f32x4 a8[8] = {z4, z4, z4, z4, z4, z4, z4, z4};
    skinny16x32(H + (size_t)row0 * 1024 + w * 256, 1024, WT + (size_t)(2568 + col0) * 1024 + w * 256, 1024, 256, a8[0], a8[1], lane);
    skinny16x32(HA + (size_t)row0 * 512 + w * 128, 512, (const bf16_t*)(p.ws + OFF_WA) + (size_t)col0 * 512 + w * 128, 512, 128, a8[2], a8[3], lane);
    skinny16x32(H + (size_t)row0 * 1024 + w * 256, 1024, WT + (size_t)(3592 + col0) * 1024 + w * 256, 1024, 256, a8[4], a8[5], lane);
    skinny16x32(PB + (size_t)row0 * 512 + w * 128, 512, (const bf16_t*)(p.ws + OFF_WB) + (size_t)col0 * 512 + w * 128, 512, 128, a8[6], a8[7], lane);
    wave4_reduce<8>(a8, smem, w, lane);
    if (w == 0) {
      const int c = col0 + (lane & 15), rr = row0 + (lane >> 4) * 4;
      const float ba0 = P_BIN(p)[2568 + c], ba1 = P_BIN(p)[2568 + c + 16], bb0 = P_BIN(p)[3592 + c], bb1 = P_BIN(p)[3592 + c + 16];
#pragma unroll
      for (int j = 0; j < 4; ++j) {
        MG[(size_t)(rr + j) * 1024 + c] = f2bf(sigmoidf_(a8[0][j] + ba0) * a8[2][j] + sigmoidf_(a8[4][j] + bb0) * a8[6][j]);
        MG[(size_t)(rr + j) * 1024 + c + 16] = f2bf(sigmoidf_(a8[1][j] + ba1) * a8[3][j] + sigmoidf_(a8[5][j] + bb1) * a8[7][j]);
      }
    }
  }
  for (int q = blockIdx.x >> 3; q < 16 * 8; q += (gridDim.x >> 3)) {
    int mt, nt; xcd_tile(q, 8, mt, nt);
    const int row_base = mt * 128, col_base = nt * 128;
    unsigned gpk[32];
    unsigned* mlds = (unsigned*)(smem + SM_W) + tid;
    f32x16 acc[2][2];
    ZERO_ACC(acc)
    gemm_gg<false>(H + (size_t)row_base * 1024, 1024, WT + (size_t)(2568 + col_base) * 1024, 1024, 1024, smem, acc, nullptr);
    EPI_QUADS(acc, {
      const float bias = P_BIN(p)[2568 + col_base + lcol];
      gpk[(mi * 2 + ni) * 8 + g * 2] = pack2(sigmoidf_(v0 + bias), sigmoidf_(v1 + bias));
      gpk[(mi * 2 + ni) * 8 + g * 2 + 1] = pack2(sigmoidf_(v2 + bias), sigmoidf_(v3 + bias));
    })
    ZERO_ACC(acc)
    gemm_gg<false>(HA + (size_t)row_base * 512, 512, (const bf16_t*)(p.ws + OFF_WA) + (size_t)col_base * 512, 512, 512, smem, acc, nullptr);
    EPI_QUADS(acc, {
      unsigned g0 = gpk[(mi * 2 + ni) * 8 + g * 2], g1 = gpk[(mi * 2 + ni) * 8 + g * 2 + 1];
      mlds[((mi * 2 + ni) * 8 + g * 2) * 256] = pack2(bflo(g0) * v0, bfhi(g0) * v1);
      mlds[((mi * 2 + ni) * 8 + g * 2 + 1) * 256] = pack2(bflo(g1) * v2, bfhi(g1) * v3);
    })
    ZERO_ACC(acc)
    gemm_gg<false>(H + (size_t)row_base * 1024, 1024, WT + (size_t)(3592 + col_base) * 1024, 1024, 1024, smem, acc, nullptr);
    EPI_QUADS(acc, {
      const float bias = P_BIN(p)[3592 + col_base + lcol];
      gpk[(mi * 2 + ni) * 8 + g * 2] = pack2(sigmoidf_(v0 + bias), sigmoidf_(v1 + bias));
      gpk[(mi * 2 + ni) * 8 + g * 2 + 1] = pack2(sigmoidf_(v2 + bias), sigmoidf_(v3 + bias));
    })
    ZERO_ACC(acc)
    gemm_gg<false>(PB + (size_t)row_base * 512, 512, (const bf16_t*)(p.ws + OFF_WB) + (size_t)col_base * 512, 512, 512, smem, acc, nullptr);
    EPI_QUADS(acc, {
      unsigned g0 = gpk[(mi * 2 + ni) * 8 + g * 2], g1 = gpk[(mi * 2 + ni) * 8 + g * 2 + 1];
      unsigned m0 = mlds[((mi * 2 + ni) * 8 + g * 2) * 256], m1 = mlds[((mi * 2 + ni) * 8 + g * 2 + 1) * 256];
      const int col = col_base + lcol; const int row0 = row_base + lrow0;
      MG[(size_t)(row0) * 1024 + col] = f2bf(bflo(m0) + bflo(g0) * v0);
      MG[(size_t)(row0 + 1) * 1024 + col] = f2bf(bfhi(m0) + bfhi(g0) * v1);
      MG[(size_t)(row0 + 2) * 1024 + col] = f2bf(bflo(m1) + bflo(g1) * v2);
      MG[(size_t)(row0 + 3) * 1024 + col] = f2bf(bfhi(m1) + bfhi(g1) * v3);
    })
  }
}

__device__ __forceinline__ void phase_F(const Params& p, unsigned char* smem) {
  TID_VARS
  const bf16_t* MG = (const bf16_t*)(p.ws + OFF_MERGED);
  const bf16_t* WO = (const bf16_t*)(p.ws + OFF_WOUT);
  const float* MOD = (const float*)(p.ws + OFF_MOD);
  float* Y = p.out + OUT_Y;
  for (int pc = blockIdx.x; pc < 256; pc += gridDim.x) {
    const int row0 = NP + (pc & 7) * 16, col0 = (pc >> 3) * 32;
    const f32x4 z4 = {0.f, 0.f, 0.f, 0.f};
    f32x4 a2[2] = {z4, z4};
    skinny16x32(MG + (size_t)row0 * 1024 + w * 256, 1024, WO + (size_t)col0 * 1024 + w * 256, 1024, 256, a2[0], a2[1], lane);
    wave4_reduce<2>(a2, smem, w, lane);
    if (w == 0) {
      const int c = col0 + (lane & 15), rr = row0 + (lane >> 4) * 4;
#pragma unroll
      for (int j = 0; j < 4; ++j) {
        const int row = rr + j;
        const float* mg = MOD + (size_t)mod_row(row) * 6144 + 2048;
        const float* xr = x_row(p, row);
        Y[(size_t)row * 1024 + c] = ALPHA * xr[c] + mg[c] * a2[0][j];
        Y[(size_t)row * 1024 + c + 16] = ALPHA * xr[c + 16] + mg[c + 16] * a2[1][j];
      }
    }
  }
  for (int q = blockIdx.x >> 3; q < 16 * 8; q += (gridDim.x >> 3)) {
    int mt, nt; xcd_tile(q, 8, mt, nt);
    const int row_base = mt * 128, col_base = nt * 128;
    f32x16 acc[2][2]; ZERO_ACC(acc)
    gemm_gg128(MG + (size_t)row_base * 1024, 1024, WO + (size_t)col_base * 1024, 1024, 1024, smem, acc);
    EPI_QUADS(acc, {
      const int col = col_base + lcol; const int row0 = row_base + lrow0;
      const float* mg = MOD + (size_t)mod_row(row0) * 6144 + 2048 + col;
      const float g1 = *mg;
      Y[(size_t)(row0) * 1024 + col] = ALPHA * x_row(p, row0)[col] + g1 * v0;
      Y[(size_t)(row0 + 1) * 1024 + col] = ALPHA * x_row(p, row0 + 1)[col] + (row0 < NP ? g1 : mg[6144]) * v1;
      Y[(size_t)(row0 + 2) * 1024 + col] = ALPHA * x_row(p, row0 + 2)[col] + (row0 < NP ? g1 : mg[2 * 6144]) * v2;
      Y[(size_t)(row0 + 3) * 1024 + col] = ALPHA * x_row(p, row0 + 3)[col] + (row0 < NP ? g1 : mg[3 * 6144]) * v3;
    })
  }
}

__device__ __forceinline__ void phase_G(const Params& p) {
  const int tid = threadIdx.x, lane = tid & 63, w = tid >> 6;
  const float* MOD = (const float*)(p.ws + OFF_MOD);
  bf16_t* H = (bf16_t*)(p.ws + OFF_H);
  float* Y = p.out + OUT_Y;
  const int rstep = gridDim.x * 4;
  float4 nx[4];
  {
    const int row = blockIdx.x * 4 + w;
    if (row < NT) {
#pragma unroll
      for (int i = 0; i < 4; ++i) nx[i] = *(const float4*)(Y + (size_t)row * 1024 + i * 256 + lane * 4); }
  }
  for (int row = blockIdx.x * 4 + w; row < NT; row += rstep) {
    float* yr = Y + (size_t)row * 1024;
    float v[16];
#pragma unroll
    for (int i = 0; i < 4; ++i) { float4 t = nx[i]; v[4 * i] = t.x; v[4 * i + 1] = t.y; v[4 * i + 2] = t.z; v[4 * i + 3] = t.w; }
    if (row + rstep < NT) {
#pragma unroll
      for (int i = 0; i < 4; ++i) nx[i] = *(const float4*)(Y + (size_t)(row + rstep) * 1024 + i * 256 + lane * 4); }
    float s = 0.f;
#pragma unroll
    for (int i = 0; i < 16; ++i) s += v[i];
    float mu = wave_sum(s) * (1.f / 1024.f);
    float q = 0.f;
#pragma unroll
    for (int i = 0; i < 16; ++i) { float d = v[i] - mu; q += d * d; }
    float rstd = rsqrtf(wave_sum(q) * (1.f / 1024.f) + LN_EPS);
    s = 0.f;
#pragma unroll
    for (int i = 0; i < 4; ++i) {
      int c = i * 256 + lane * 4;
      float4 gg = *(const float4*)(P_L1G(p) + c), bb = *(const float4*)(P_L1B(p) + c);
      v[4 * i] = (v[4 * i] - mu) * rstd * gg.x + bb.x; v[4 * i + 1] = (v[4 * i + 1] - mu) * rstd * gg.y + bb.y;
      v[4 * i + 2] = (v[4 * i + 2] - mu) * rstd * gg.z + bb.z; v[4 * i + 3] = (v[4 * i + 3] - mu) * rstd * gg.w + bb.w;
      *(float4*)(yr + c) = make_float4(v[4 * i], v[4 * i + 1], v[4 * i + 2], v[4 * i + 3]);
      s += v[4 * i] + v[4 * i + 1] + v[4 * i + 2] + v[4 * i + 3];
    }
    mu = wave_sum(s) * (1.f / 1024.f);
    q = 0.f;
#pragma unroll
    for (int i = 0; i < 16; ++i) { float d = v[i] - mu; q += d * d; }
    rstd = rsqrtf(wave_sum(q) * (1.f / 1024.f) + LN_EPS);
    const float* mr = MOD + (size_t)mod_row(row) * 6144;
#pragma unroll
    for (int i = 0; i < 4; ++i) {
      int c = i * 256 + lane * 4;
      float4 sh = *(const float4*)(mr + 3072 + c), sc = *(const float4*)(mr + 4096 + c);
      uint2 o;
      o.x = pack2((v[4 * i] - mu) * rstd * (1.f + sc.x) + sh.x, (v[4 * i + 1] - mu) * rstd * (1.f + sc.y) + sh.y);
      o.y = pack2((v[4 * i + 2] - mu) * rstd * (1.f + sc.z) + sh.z, (v[4 * i + 3] - mu) * rstd * (1.f + sc.w) + sh.w);
      *(uint2*)(H + (size_t)row * 1024 + c) = o;
    }
  }
}

__device__ __forceinline__ void phase_H(const Params& p, unsigned char* smem) {
  TID_VARS
  const bf16_t* H = (const bf16_t*)(p.ws + OFF_H);
  const bf16_t* WQ = (const bf16_t*)(p.ws + OFF_WPQ);
  bf16_t* PQ = (bf16_t*)(p.ws + OFF_PQ);
  for (int pc = blockIdx.x; pc < 512; pc += gridDim.x) {
    const int row0 = NP + (pc & 7) * 16, col0 = (pc >> 3) * 32;
    const f32x4 z4 = {0.f, 0.f, 0.f, 0.f};
    f32x4 a2[2] = {z4, z4};
    skinny16x32(H + (size_t)row0 * 1024 + w * 256, 1024, WQ + (size_t)col0 * 1024 + w * 256, 1024, 256, a2[0], a2[1], lane);
    wave4_reduce<2>(a2, smem, w, lane);
    if (w == 0) {
      const int c = col0 + (lane & 15), rr = row0 + (lane >> 4) * 4;
#pragma unroll
      for (int j = 0; j < 4; ++j) {
        PQ[(size_t)(rr + j) * 2048 + c] = f2bf(a2[0][j]);
        PQ[(size_t)(rr + j) * 2048 + c + 16] = f2bf(a2[1][j]);
      }
    }
  }
  for (int q = blockIdx.x >> 3; q < 16 * 16; q += (gridDim.x >> 3)) {
    int mt, nt; xcd_tile(q, 16, mt, nt);
    const int row_base = mt * 128, col_base = nt * 128;
    f32x16 acc[2][2]; ZERO_ACC(acc)
    gemm_gg128(H + (size_t)row_base * 1024, 1024, WQ + (size_t)col_base * 1024, 1024, 1024, smem, acc);
    EPI_QUADS(acc, {
      const int col = col_base + lcol; const int row0 = row_base + lrow0;
      PQ[(size_t)(row0) * 2048 + col] = f2bf(v0); PQ[(size_t)(row0 + 1) * 2048 + col] = f2bf(v1);
      PQ[(size_t)(row0 + 2) * 2048 + col] = f2bf(v2); PQ[(size_t)(row0 + 3) * 2048 + col] = f2bf(v3);
    })
  }
}

__device__ __forceinline__ int f2key(float f) { int b = __float_as_int(f); return b ^ ((b >> 31) & 0x7FFFFFFF); }
__device__ __forceinline__ float key2f(int k) { return __int_as_float(k ^ ((k >> 31) & 0x7FFFFFFF)); }
#define CMPX(a, b) { const int _h = max(a, b), _l = min(a, b); a = _h; b = _l; }
#define SORT16(k, o) { CMPX(k[(o) + 0], k[(o) + 1]) CMPX(k[(o) + 2], k[(o) + 3]) CMPX(k[(o) + 0], k[(o) + 2]) CMPX(k[(o) + 1], k[(o) + 3]) CMPX(k[(o) + 1], k[(o) + 2]) CMPX(k[(o) + 4], k[(o) + 5]) CMPX(k[(o) + 6], k[(o) + 7]) CMPX(k[(o) + 4], k[(o) + 6]) CMPX(k[(o) + 5], k[(o) + 7]) CMPX(k[(o) + 5], k[(o) + 6]) CMPX(k[(o) + 0], k[(o) + 4]) CMPX(k[(o) + 2], k[(o) + 6]) CMPX(k[(o) + 2], k[(o) + 4]) CMPX(k[(o) + 1], k[(o) + 5]) CMPX(k[(o) + 3], k[(o) + 7]) CMPX(k[(o) + 3], k[(o) + 5]) CMPX(k[(o) + 1], k[(o) + 2]) CMPX(k[(o) + 3], k[(o) + 4]) CMPX(k[(o) + 5], k[(o) + 6]) CMPX(k[(o) + 8], k[(o) + 9]) CMPX(k[(o) + 10], k[(o) + 11]) CMPX(k[(o) + 8], k[(o) + 10]) CMPX(k[(o) + 9], k[(o) + 11]) CMPX(k[(o) + 9], k[(o) + 10]) CMPX(k[(o) + 12], k[(o) + 13]) CMPX(k[(o) + 14], k[(o) + 15]) CMPX(k[(o) + 12], k[(o) + 14]) CMPX(k[(o) + 13], k[(o) + 15]) CMPX(k[(o) + 13], k[(o) + 14]) CMPX(k[(o) + 8], k[(o) + 12]) CMPX(k[(o) + 10], k[(o) + 14]) CMPX(k[(o) + 10], k[(o) + 12]) CMPX(k[(o) + 9], k[(o) + 13]) CMPX(k[(o) + 11], k[(o) + 15]) CMPX(k[(o) + 11], k[(o) + 13]) CMPX(k[(o) + 9], k[(o) + 10]) CMPX(k[(o) + 11], k[(o) + 12]) CMPX(k[(o) + 13], k[(o) + 14]) CMPX(k[(o) + 0], k[(o) + 8]) CMPX(k[(o) + 4], k[(o) + 12]) CMPX(k[(o) + 4], k[(o) + 8]) CMPX(k[(o) + 2], k[(o) + 10]) CMPX(k[(o) + 6], k[(o) + 14]) CMPX(k[(o) + 6], k[(o) + 10]) CMPX(k[(o) + 2], k[(o) + 4]) CMPX(k[(o) + 6], k[(o) + 8]) CMPX(k[(o) + 10], k[(o) + 12]) CMPX(k[(o) + 1], k[(o) + 9]) CMPX(k[(o) + 5], k[(o) + 13]) CMPX(k[(o) + 5], k[(o) + 9]) CMPX(k[(o) + 3], k[(o) + 11]) CMPX(k[(o) + 7], k[(o) + 15]) CMPX(k[(o) + 7], k[(o) + 11]) CMPX(k[(o) + 3], k[(o) + 5]) CMPX(k[(o) + 7], k[(o) + 9]) CMPX(k[(o) + 11], k[(o) + 13]) CMPX(k[(o) + 1], k[(o) + 2]) CMPX(k[(o) + 3], k[(o) + 4]) CMPX(k[(o) + 5], k[(o) + 6]) CMPX(k[(o) + 7], k[(o) + 8]) CMPX(k[(o) + 9], k[(o) + 10]) CMPX(k[(o) + 11], k[(o) + 12]) CMPX(k[(o) + 13], k[(o) + 14]) }
#define MERGE16(k, a, b) { k[(a) + 0] = max(k[(a) + 0], k[(b) + 15]); k[(a) + 1] = max(k[(a) + 1], k[(b) + 14]); k[(a) + 2] = max(k[(a) + 2], k[(b) + 13]); k[(a) + 3] = max(k[(a) + 3], k[(b) + 12]); k[(a) + 4] = max(k[(a) + 4], k[(b) + 11]); k[(a) + 5] = max(k[(a) + 5], k[(b) + 10]); k[(a) + 6] = max(k[(a) + 6], k[(b) + 9]); k[(a) + 7] = max(k[(a) + 7], k[(b) + 8]); k[(a) + 8] = max(k[(a) + 8], k[(b) + 7]); k[(a) + 9] = max(k[(a) + 9], k[(b) + 6]); k[(a) + 10] = max(k[(a) + 10], k[(b) + 5]); k[(a) + 11] = max(k[(a) + 11], k[(b) + 4]); k[(a) + 12] = max(k[(a) + 12], k[(b) + 3]); k[(a) + 13] = max(k[(a) + 13], k[(b) + 2]); k[(a) + 14] = max(k[(a) + 14], k[(b) + 1]); k[(a) + 15] = max(k[(a) + 15], k[(b) + 0]); CMPX(k[(a) + 0], k[(a) + 8]) CMPX(k[(a) + 1], k[(a) + 9]) CMPX(k[(a) + 2], k[(a) + 10]) CMPX(k[(a) + 3], k[(a) + 11]) CMPX(k[(a) + 4], k[(a) + 12]) CMPX(k[(a) + 5], k[(a) + 13]) CMPX(k[(a) + 6], k[(a) + 14]) CMPX(k[(a) + 7], k[(a) + 15]) CMPX(k[(a) + 0], k[(a) + 4]) CMPX(k[(a) + 1], k[(a) + 5]) CMPX(k[(a) + 2], k[(a) + 6]) CMPX(k[(a) + 3], k[(a) + 7]) CMPX(k[(a) + 8], k[(a) + 12]) CMPX(k[(a) + 9], k[(a) + 13]) CMPX(k[(a) + 10], k[(a) + 14]) CMPX(k[(a) + 11], k[(a) + 15]) CMPX(k[(a) + 0], k[(a) + 2]) CMPX(k[(a) + 1], k[(a) + 3]) CMPX(k[(a) + 4], k[(a) + 6]) CMPX(k[(a) + 5], k[(a) + 7]) CMPX(k[(a) + 8], k[(a) + 10]) CMPX(k[(a) + 9], k[(a) + 11]) CMPX(k[(a) + 12], k[(a) + 14]) CMPX(k[(a) + 13], k[(a) + 15]) CMPX(k[(a) + 0], k[(a) + 1]) CMPX(k[(a) + 2], k[(a) + 3]) CMPX(k[(a) + 4], k[(a) + 5]) CMPX(k[(a) + 6], k[(a) + 7]) CMPX(k[(a) + 8], k[(a) + 9]) CMPX(k[(a) + 10], k[(a) + 11]) CMPX(k[(a) + 12], k[(a) + 13]) CMPX(k[(a) + 14], k[(a) + 15]) }
#define TOPK_INSERT(top, x) { int _x = (x); _Pragma("unroll") for (int _j = 0; _j < 16; ++_j) { int _hi = max(top[_j], _x); _x = min(top[_j], _x); top[_j] = _hi; } }

__device__ __forceinline__ void phase_I(const Params& p, unsigned char* smem) {
  TID_VARS
  const bf16_t* PQ = (const bf16_t*)(p.ws + OFF_PQ);
  const bf16_t* SK = (const bf16_t*)(p.ws + OFF_SUBK);
  int* IDS = (int*)(p.ws + OFF_IDS); float* GT = (float*)(p.ws + OFF_GATES);
  float* sS = (float*)smem;
  int* sM = (int*)(smem + 66048);
  int* sL = (int*)smem;
  const int n_items = 129 * 8;
  for (int it = blockIdx.x; it < n_items; it += gridDim.x) {
    const int mt = it >> 3, head = it & 7;
    const int row_base = mt * 128;
    const int t = tid & 127, half = tid >> 7;
    int top0[16], top1[16];
#pragma unroll
    for (int pp = 0; pp < 2; ++pp) {
      f32x16 acc[2][2]; ZERO_ACC(acc)
      gemm_gg<false>(PQ + (size_t)row_base * 2048 + head * 256 + pp * 128, 2048, SK + pp * 16384, 128, 128, smem, acc, nullptr);
      __syncthreads();
      EPI_QUADS(acc, {
        sS[(lrow0) * 129 + lcol] = v0; sS[(lrow0 + 1) * 129 + lcol] = v1; sS[(lrow0 + 2) * 129 + lcol] = v2; sS[(lrow0 + 3) * 129 + lcol] = v3;
      })
      __syncthreads();
      int k[64];
      const float* sr = sS + t * 129 + half * 64;
#pragma unroll
      for (int j = 0; j < 64; ++j) k[j] = (f2key(sr[j]) & ~127) | (half * 64 + j);
      SORT16(k, 0) SORT16(k, 16) SORT16(k, 32) SORT16(k, 48)
      MERGE16(k, 0, 16) MERGE16(k, 32, 48) MERGE16(k, 0, 32)
      if (half == 1) {
#pragma unroll
        for (int j = 0; j < 16; ++j) sM[t * 16 + j] = k[j];
      }
      __syncthreads();
      if (half == 0) {
#pragma unroll
        for (int j = 0; j < 16; ++j) k[16 + j] = sM[t * 16 + j];
        MERGE16(k, 0, 16)
      }
      int top[16];
#pragma unroll
      for (int j = 0; j < 16; ++j) top[j] = k[j];
      if (pp == 0) {
#pragma unroll
        for (int j = 0; j < 16; ++j) top0[j] = top[j];
      } else {
#pragma unroll
        for (int j = 0; j < 16; ++j) top1[j] = top[j];
      }
    }
    __syncthreads();
    if (half == 0) {
#pragma unroll
      for (int j = 0; j < 16; ++j) { sL[t * 33 + j] = top0[j] & 127; sL[t * 33 + 16 + j] = top1[j] & 127; }
      float va[16], vb[16];
#pragma unroll
      for (int j = 0; j < 16; ++j) { va[j] = key2f(top0[j] & ~127); vb[j] = key2f(top1[j] & ~127); }
      int k[32];
#define CKEY(i, j) ((f2key(va[i] + vb[j]) & ~255) | ((i) * 16 + (j)))
#pragma unroll
      for (int j = 0; j < 16; ++j) k[j] = CKEY(0, j);
#pragma unroll
      for (int j = 0; j < 16; ++j) k[16 + j] = (j < 8) ? CKEY(1, (j < 8 ? j : 0)) : (int)0x80000000;
      MERGE16(k, 0, 16)
#pragma unroll
      for (int j = 0; j < 16; ++j) k[16 + j] = (j < 5) ? CKEY(2, (j < 5 ? j : 0)) : (int)0x80000000;
      MERGE16(k, 0, 16)
#pragma unroll
      for (int j = 0; j < 16; ++j) k[16 + j] = (j < 4) ? CKEY(3, (j < 4 ? j : 0)) : (int)0x80000000;
      MERGE16(k, 0, 16)
#pragma unroll
      for (int j = 0; j < 16; ++j) k[16 + j] = (j < 3) ? CKEY(4, (j < 3 ? j : 0)) : (int)0x80000000;
      MERGE16(k, 0, 16)
#pragma unroll
      for (int j = 0; j < 16; ++j) k[16 + j] = (j < 2) ? CKEY(5, (j < 2 ? j : 0)) : (int)0x80000000;
      MERGE16(k, 0, 16)
#pragma unroll
      for (int j = 0; j < 16; ++j) k[16 + j] = (j < 2) ? CKEY(6, (j < 2 ? j : 0)) : (int)0x80000000;
      MERGE16(k, 0, 16)
#pragma unroll
      for (int j = 0; j < 16; ++j) k[16 + j] = (j < 2) ? CKEY(7, (j < 2 ? j : 0)) : (int)0x80000000;
      MERGE16(k, 0, 16)
#pragma unroll
      for (int j = 0; j < 16; ++j) k[16 + j] = (j < 8) ? CKEY((j < 8 ? 8 + j : 8), 0) : (int)0x80000000;
      MERGE16(k, 0, 16)
      int best[16];
#pragma unroll
      for (int j = 0; j < 16; ++j) best[j] = k[j];
      float ev[16]; float mx = key2f(best[0] & ~255); float sum = 0.f;
#pragma unroll
      for (int j = 0; j < 16; ++j) { ev[j] = __expf(key2f(best[j] & ~255) - mx); sum += ev[j]; }
      const float inv = 1.f / sum;
      const size_t ob = ((size_t)head * NT + (row_base + t)) * 16;
#pragma unroll
      for (int j = 0; j < 16; ++j) {
        int pr = best[j] & 255;
        int id = sL[t * 33 + (pr >> 4)] * 128 + sL[t * 33 + 16 + (pr & 15)];
        IDS[ob + j] = id; GT[ob + j] = ev[j] * inv;
      }
    }
  }
}

template <int CTRL> __device__ __forceinline__ float dppf(float v) {
  return __int_as_float(__builtin_amdgcn_update_dpp(0, __float_as_int(v), CTRL, 0xF, 0xF, false));
}
__device__ __forceinline__ float reduce16(float v) {
  v += dppf<0xB1>(v);
  v += dppf<0x4E>(v);
  v += dppf<0x141>(v);
  v += dppf<0x140>(v);
  return v;
}
__device__ __forceinline__ unsigned u4c(const uint4& v, int k) { return k == 0 ? v.x : (k == 1 ? v.y : (k == 2 ? v.z : v.w)); }
__device__ __forceinline__ float f4c(const float4& v, int k) { return k == 0 ? v.x : (k == 1 ? v.y : (k == 2 ? v.z : v.w)); }
__device__ __forceinline__ float dot8(const uint4& a, const uint4& h, float s) {
  s = dot2bf(a.x, h.x, s); s = dot2bf(a.y, h.y, s); s = dot2bf(a.z, h.z, s); s = dot2bf(a.w, h.w, s); return s;
}
__device__ __forceinline__ float dot4_fp8(unsigned w, float h0, float h1, float h2, float h3, float s) {
  const f32x2_t lo = __builtin_amdgcn_cvt_pk_f32_fp8((int)w, false), hi = __builtin_amdgcn_cvt_pk_f32_fp8((int)w, true);
  s = fmaf(lo.x, h0, s); s = fmaf(lo.y, h1, s); s = fmaf(hi.x, h2, s); s = fmaf(hi.y, h3, s);
  return s;
}
template <bool COOP>
__device__ __forceinline__ void peer_token(const Params& p, unsigned char* smem, int row, int w, int lane) {
  const int es = lane >> 4, sl = lane & 15;
  const bf16_t* H = (const bf16_t*)(p.ws + OFF_H);
  const unsigned char* PU = p.ws + OFF_PU; const unsigned char* PV = p.ws + OFF_PV;
  const int* IDS = (const int*)(p.ws + OFF_IDS); const float* GT = (const float*)(p.ws + OFF_GATES);
  const float* MOD = (const float*)(p.ws + OFF_MOD);
  float* Y = p.out + OUT_Y;
  int* s_id = (int*)smem + w * 256;
  float* s_cf = (float*)smem + w * 256 + 128;
  float* s_part = (float*)(smem + 8192);
  const int gi_lo = COOP ? 8 * w : 0, gi_n = COOP ? 8 : 32;
  const size_t ia0 = ((size_t)(lane >> 4) * NT + row) * 16 + (lane & 15), ia1 = ((size_t)(4 + (lane >> 4)) * NT + row) * 16 + (lane & 15);
  s_id[lane] = IDS[ia0]; s_id[64 + lane] = IDS[ia1];
  const float g0 = GT[ia0], g1 = GT[ia1];
  float hf[64];
  {
    const uint4* hp = (const uint4*)(H + (size_t)row * 1024);
#pragma unroll
    for (int i = 0; i < 4; ++i) {
#pragma unroll
      for (int k = 0; k < 2; ++k) {
        const uint4 v = hp[(sl + 16 * i) * 2 + k];
        float* f = hf + i * 16 + k * 8;
        f[0] = bflo(v.x); f[1] = bfhi(v.x); f[2] = bflo(v.y); f[3] = bfhi(v.y); f[4] = bflo(v.z); f[5] = bfhi(v.z); f[6] = bflo(v.w); f[7] = bfhi(v.w);
      }
    }
  }
  asm volatile("s_waitcnt lgkmcnt(0)" ::: "memory");
#pragma unroll 4
  for (int q = 0; q < gi_n; ++q) {
    const int gi = gi_lo + q;
    const int id = s_id[32 * es + gi];
    const uint4* up = (const uint4*)(PU + (size_t)id * 1024);
    float s0 = 0.f, s1 = 0.f;
#pragma unroll
    for (int i = 0; i < 4; ++i) {
      const uint4 a = up[sl + 16 * i];
      const float* f = hf + i * 16;
      s0 = dot4_fp8(a.x, f[0], f[1], f[2], f[3], s0); s1 = dot4_fp8(a.y, f[4], f[5], f[6], f[7], s1);
      s0 = dot4_fp8(a.z, f[8], f[9], f[10], f[11], s0); s1 = dot4_fp8(a.w, f[12], f[13], f[14], f[15], s1);
    }
    const float d = reduce16(s0 + s1) * (1.f / 512.f);
    if (sl == 0) s_cf[32 * es + gi] = d;
  }
  asm volatile("s_waitcnt lgkmcnt(0)" ::: "memory");
  {
    const float d0 = s_cf[lane], d1 = s_cf[64 + lane];
    asm volatile("s_waitcnt lgkmcnt(0)" ::: "memory");
    s_cf[lane] = g0 * (0.5f / 64.f) * d0 * (1.f + erff(d0 * 0.7071067811865476f));
    s_cf[64 + lane] = g1 * (0.5f / 64.f) * d1 * (1.f + erff(d1 * 0.7071067811865476f));
    asm volatile("s_waitcnt lgkmcnt(0)" ::: "memory");
  }
  float y[16];
#pragma unroll
  for (int i = 0; i < 16; ++i) y[i] = 0.f;
#pragma unroll 8
  for (int q = 0; q < 4 * gi_n; ++q) {
    const int e = COOP ? (32 * (q & 3) + gi_lo + (q >> 2)) : q;
    const int id = __builtin_amdgcn_readfirstlane(s_id[e]);
    const float ce = __int_as_float(__builtin_amdgcn_readfirstlane(__float_as_int(s_cf[e])));
    const uint4 a = ((const uint4*)(PV + (size_t)id * 1024))[lane];
    const f32x2_t l0 = __builtin_amdgcn_cvt_pk_f32_fp8((int)a.x, false), h0 = __builtin_amdgcn_cvt_pk_f32_fp8((int)a.x, true);
    const f32x2_t l1 = __builtin_amdgcn_cvt_pk_f32_fp8((int)a.y, false), h1 = __builtin_amdgcn_cvt_pk_f32_fp8((int)a.y, true);
    const f32x2_t l2 = __builtin_amdgcn_cvt_pk_f32_fp8((int)a.z, false), h2 = __builtin_amdgcn_cvt_pk_f32_fp8((int)a.z, true);
    const f32x2_t l3 = __builtin_amdgcn_cvt_pk_f32_fp8((int)a.w, false), h3 = __builtin_amdgcn_cvt_pk_f32_fp8((int)a.w, true);
    y[0] += ce * l0.x; y[1] += ce * l0.y; y[2] += ce * h0.x; y[3] += ce * h0.y;
    y[4] += ce * l1.x; y[5] += ce * l1.y; y[6] += ce * h1.x; y[7] += ce * h1.y;
    y[8] += ce * l2.x; y[9] += ce * l2.y; y[10] += ce * h2.x; y[11] += ce * h2.y;
    y[12] += ce * l3.x; y[13] += ce * l3.y; y[14] += ce * h3.x; y[15] += ce * h3.y;
  }
  asm volatile("s_waitcnt lgkmcnt(0)" ::: "memory");
  if (COOP) {
    __syncthreads();
#pragma unroll
    for (int k = 0; k < 4; ++k) *(float4*)(s_part + w * 1024 + lane * 16 + k * 4) = make_float4(y[4 * k], y[4 * k + 1], y[4 * k + 2], y[4 * k + 3]);
    __syncthreads();
    if (w != 0) return;
#pragma unroll
    for (int k = 0; k < 4; ++k) {
      const float4 b1 = *(const float4*)(s_part + 1024 + lane * 16 + k * 4), b2 = *(const float4*)(s_part + 2048 + lane * 16 + k * 4),
                   b3 = *(const float4*)(s_part + 3072 + lane * 16 + k * 4);
      y[4 * k] += b1.x + b2.x + b3.x; y[4 * k + 1] += b1.y + b2.y + b3.y; y[4 * k + 2] += b1.z + b2.z + b3.z; y[4 * k + 3] += b1.w + b2.w + b3.w;
    }
  }
  float* yr = Y + (size_t)row * 1024;
  const float* mr = MOD + (size_t)mod_row(row) * 6144 + 5120;
  float v[16];
  float s = 0.f;
#pragma unroll
  for (int k = 0; k < 4; ++k) {
    const int c = lane * 16 + k * 4;
    const float4 x1 = *(const float4*)(yr + c), g2 = *(const float4*)(mr + c);
    const int o = k * 4;
    v[o] = ALPHA * x1.x + g2.x * y[o]; v[o + 1] = ALPHA * x1.y + g2.y * y[o + 1];
    v[o + 2] = ALPHA * x1.z + g2.z * y[o + 2]; v[o + 3] = ALPHA * x1.w + g2.w * y[o + 3];
    s += v[o] + v[o + 1] + v[o + 2] + v[o + 3];
  }
  const float mu = wave_sum(s) * (1.f / 1024.f);
  float q2 = 0.f;
#pragma unroll
  for (int i = 0; i < 16; ++i) { float d = v[i] - mu; q2 += d * d; }
  const float rstd = rsqrtf(wave_sum(q2) * (1.f / 1024.f) + LN_EPS);
#pragma unroll
  for (int k = 0; k < 4; ++k) {
    const int c = lane * 16 + k * 4;
    const float4 gg = *(const float4*)(P_L2G(p) + c), bb = *(const float4*)(P_L2B(p) + c);
    const int o = k * 4;
    *(float4*)(yr + c) = make_float4((v[o] - mu) * rstd * gg.x + bb.x, (v[o + 1] - mu) * rstd * gg.y + bb.y,
                                     (v[o + 2] - mu) * rstd * gg.z + bb.z, (v[o + 3] - mu) * rstd * gg.w + bb.w);
  }
}
__device__ __forceinline__ void phase_J(const Params& p, unsigned char* smem) {
  const int tid = threadIdx.x, lane = tid & 63, w = tid >> 6;
  const int nw = gridDim.x * 4;
  const int main_rows = (NT / nw) * nw;
  for (int row = blockIdx.x * 4 + w; row < main_rows; row += nw) peer_token<false>(p, smem, row, w, lane);
  __syncthreads();
  for (int row = main_rows + blockIdx.x; row < NT; row += gridDim.x) peer_token<true>(p, smem, row, w, lane);
}

#define XB_TMO      128
#define XB_XCNT(j)  (256  + 64 * (j))
#define XB_XSUB(j)  (1280 + 64 * (j))
#define XB_XGEN(j)  (2304 + 64 * (j))
#define XB_TOP      3328
#define XB_TOPGEN   3392
#define XCD_BAR_WORDS 3456
#define XB_SPIN_CAP (1u << 22)
#define LAS __attribute__((address_space(3)))
__device__ __forceinline__ unsigned xb_ld(unsigned* p)              { return __hip_atomic_load(p, __ATOMIC_RELAXED, __HIP_MEMORY_SCOPE_AGENT); }
__device__ __forceinline__ unsigned xb_add(unsigned* p, unsigned v) { return __hip_atomic_fetch_add(p, v, __ATOMIC_RELAXED, __HIP_MEMORY_SCOPE_AGENT); }
__device__ __forceinline__ unsigned xb_xcc_id() { return (unsigned)__builtin_amdgcn_s_getreg((3 << 11) | 20) & 0xFu; }
#define XB_SPIN(cond, bar) do { unsigned _sp = 0; while (cond) { __builtin_amdgcn_s_sleep(1); \
    if ((++_sp & 255u) == 0u) { if (xb_ld(&(bar)[XB_TMO])) break; if (_sp > XB_SPIN_CAP) { atomicAdd(&(bar)[XB_TMO], 1u); break; } } } } while (0)
struct XcdBarrier { unsigned* bar; unsigned x; volatile LAS unsigned* st; };
__device__ __forceinline__ XcdBarrier xcd_barrier_post(unsigned* bar, volatile LAS unsigned* st) {
    XcdBarrier b; b.bar = bar; b.x = xb_xcc_id(); b.st = st;
    if (threadIdx.x == 0) (void)xb_add(&bar[XB_XCNT(b.x)], 1u);
    return b;
}
__device__ __forceinline__ void xcd_barrier_complete(unsigned* bar, unsigned x, unsigned& nloc, unsigned& nx) {
    const unsigned G = gridDim.x * gridDim.y * gridDim.z;
    unsigned sum, cnt, mine, sp = 0u;
    for (;;) {
        sum = 0u; cnt = 0u; mine = 0u;
#pragma unroll
        for (unsigned j = 0; j < 16; ++j) { const unsigned c = xb_ld(&bar[XB_XCNT(j)]); sum += c; cnt += (c > 0u) ? 1u : 0u; mine = (j == x) ? c : mine; }
        if (sum == G) break;
        __builtin_amdgcn_s_sleep(1);
        if ((++sp & 255u) == 0u) { if (xb_ld(&bar[XB_TMO])) break; if (sp > XB_SPIN_CAP) { atomicAdd(&bar[XB_TMO], 1u); break; } }
    }
    nloc = mine > 0u ? mine : 1u; nx = cnt > 0u ? cnt : 1u;
}
__device__ __forceinline__ void xcd_barrier(const XcdBarrier& b) {
    asm volatile("s_waitcnt vmcnt(0)" ::: "memory");
    __syncthreads();
    if (threadIdx.x == 0) {
        unsigned* bar = b.bar;
        __builtin_amdgcn_s_waitcnt(0);
        unsigned nloc = b.st[0], nx = b.st[1];
        if (nloc == 0u) { xcd_barrier_complete(bar, b.x, nloc, nx); b.st[0] = nloc; b.st[1] = nx; }
        const unsigned old = xb_add(&bar[XB_XSUB(b.x)], 1u);
        const unsigned gen = old / nloc;
        if (old + 1u == (gen + 1u) * nloc) {
            __builtin_amdgcn_fence(__ATOMIC_RELEASE, "agent");
            asm volatile("s_waitcnt vmcnt(0)" ::: "memory");
            const unsigned og = xb_add(&bar[XB_TOP], 1u);
            const unsigned tg = og / nx;
            if (og + 1u == (tg + 1u) * nx) xb_add(&bar[XB_TOPGEN], 1u);
            else XB_SPIN(xb_ld(&bar[XB_TOPGEN]) == tg, bar);
            __builtin_amdgcn_fence(__ATOMIC_ACQUIRE, "agent");
            xb_add(&bar[XB_XGEN(b.x)], 1u);
            asm volatile("s_waitcnt vmcnt(0)" ::: "memory");
        } else {
            XB_SPIN(xb_ld(&bar[XB_XGEN(b.x)]) == gen, bar);
            __builtin_amdgcn_fence(__ATOMIC_ACQUIRE, "agent");
            asm volatile("s_waitcnt vmcnt(0)" ::: "memory");
        }
    }
    __syncthreads();
}
#define gsync(grid) xcd_barrier(xb)
__global__ void __launch_bounds__(256, 2) fwd_megakernel(Params p) {
  cg::grid_group grid = cg::this_grid();
  __shared__ __attribute__((aligned(16))) unsigned char smem[SM_TOTAL];
  __shared__ uint4 xb_words;
  if (threadIdx.x == 0) xb_words = make_uint4(0u, 0u, 0u, 0u);
  __syncthreads();
  XcdBarrier xb = xcd_barrier_post((unsigned*)(p.ws + OFF_BAR), (volatile LAS unsigned*)&xb_words);
  grid.sync();
#ifndef ONLY
#define ONLY 0xFFF
#endif
  if (ONLY & 1) phase_A(p, smem);  gsync(grid);
  if (ONLY & 2) phase_B(p);        gsync(grid);
  if (ONLY & 4) phase_C(p, smem);  gsync(grid);
  if (ONLY & 8) phase_D1(p, smem); gsync(grid);
  if (ONLY & 16) phase_D2(p);       gsync(grid);
  if (ONLY & 32) phase_D3(p, smem); gsync(grid);
  if (ONLY & 64) phase_E(p, smem);  gsync(grid);
  if (ONLY & 128) phase_F(p, smem);  gsync(grid);
  if (ONLY & 256) phase_G(p);        gsync(grid);
  if (ONLY & 512) phase_H(p, smem);  gsync(grid);
  if (ONLY & 1024) phase_I(p, smem);  gsync(grid);
  if (ONLY & 2048) phase_J(p, smem);
}

extern "C" void kernel_launch(void* const* d_in, const int* in_sizes, int n_in, void* d_out,
                              int out_size, void* d_ws, size_t ws_size, hipStream_t stream) {
  static int grid_blocks = 0;
  if (!grid_blocks) {
    int dev = 0, cus = 0, per_cu = 0;
    hipGetDevice(&dev);
    hipDeviceGetAttribute(&cus, hipDeviceAttributeMultiprocessorCount, dev);
    hipOccupancyMaxActiveBlocksPerMultiprocessor(&per_cu, fwd_megakernel, 256, 0);
    if (per_cu > 2) per_cu = 2;
    if (per_cu < 1) per_cu = 1;
    grid_blocks = cus * per_cu;
  }
  if (ws_size < WS_TOTAL) fprintf(stderr, "workspace too small: %zu < %zu\n", ws_size, (size_t)WS_TOTAL);
  Params p{};
  const float* const* in = (const float* const*)d_in;
  p.x_prompt = in[0]; p.x_sample = in[1]; p.c_prompt = in[2]; p.c_sample = in[3];
  p.st_C = in[4]; p.st_n = in[5]; p.st_m = in[6]; p.st_pool = in[7];
  p.w_mod = in[8]; p.b_mod = in[9]; p.w_in = in[10]; p.b_in = in[11]; p.b_fgate = in[12]; p.gn_gain = in[13];
  p.w_pool = in[14]; p.pool_scale = in[15]; p.w_a = in[16]; p.w_b = in[17]; p.w_out = in[18];
  p.ln1_g = in[19]; p.ln1_b = in[20]; p.w_pq = in[21]; p.subkeys = in[22]; p.peer_u = in[23]; p.peer_v = in[24];
  p.ln2_g = in[25]; p.ln2_b = in[26];
  p.out = (float*)d_out; p.ws = (unsigned char*)d_ws;
  hipMemsetAsync((unsigned char*)d_ws + OFF_BAR, 0, 16384, stream);
  void* args[] = {&p};
  hipError_t e = hipLaunchCooperativeKernel((void*)fwd_megakernel, dim3(grid_blocks), dim3(256), args, 0, stream);
  if (e != hipSuccess) fprintf(stderr, "cooperative launch failed: %s (grid %d)\n", hipGetErrorString(e), grid_blocks);
}
```

```cpp
#include <hip/hip_runtime.h>
#include <hip/hip_cooperative_groups.h>
#include <cstdio>
namespace cg = cooperative_groups;

typedef unsigned short bf16_t;
typedef __attribute__((ext_vector_type(8))) short bf16x8;
typedef __attribute__((ext_vector_type(16))) float f32x16;
typedef __attribute__((ext_vector_type(4))) float f32x4;
typedef __attribute__((ext_vector_type(2))) __bf16 bf16x2_t;

#define NT 16512
#define NP 16384
#define DM 1024
#define NIN 4616
#define ALPHA 1.189207115002721f
#define LN_EPS 1e-5f

constexpr size_t OFF_WIN   = 0;
constexpr size_t OFF_WA    = OFF_WIN + 9453568;
constexpr size_t OFF_WB    = OFF_WA + 1048576;
constexpr size_t OFF_WOUT  = OFF_WB + 1048576;
constexpr size_t OFF_WPQ   = OFF_WOUT + 2097152;
constexpr size_t OFF_WPOOL = OFF_WPQ + 4194304;
constexpr size_t OFF_SUBK  = OFF_WPOOL + 131072;
constexpr size_t OFF_PU    = OFF_SUBK + 65536;
constexpr size_t OFF_PV    = OFF_PU + 33554432;
constexpr size_t OFF_MOD   = OFF_PV + 33554432;
constexpr size_t OFF_H     = OFF_MOD + 3342336;
constexpr size_t OFF_Q     = OFF_H + 33816576;
constexpr size_t OFF_K     = OFF_Q + 16908288;
constexpr size_t OFF_V     = OFF_K + 16908288;
constexpr size_t OFF_O     = OFF_V + 16908288;
constexpr size_t OFF_PQ    = OFF_Q;
constexpr size_t OFF_KT    = OFF_O + 16908288;
constexpr size_t OFF_VT    = OFF_KT + 16777216;
constexpr size_t OFF_IDS   = OFF_KT;
constexpr size_t OFF_GATES = OFF_KT + 8454144;
constexpr size_t OFF_IG    = OFF_VT + 16777216;
constexpr size_t OFF_LF    = OFF_IG + 264192;
constexpr size_t OFF_U     = OFF_LF + 264192;
constexpr size_t OFF_CT    = OFF_U;
constexpr size_t OFF_MERGED= OFF_U;
constexpr size_t OFF_CHB   = OFF_U + 33816576;
constexpr size_t OFF_MPREV = OFF_CHB + 65536;
constexpr size_t OFF_NLOC  = OFF_MPREV + 65536;
constexpr size_t OFF_NPREV = OFF_NLOC + 262144;
constexpr size_t OFF_BAR   = OFF_NPREV + 262144;
constexpr size_t OFF_CB    = OFF_BAR + 16384;
constexpr size_t WS_TOTAL  = OFF_CB + 40960;
#define CB_(p) ((const float*)((p).ws + OFF_CB))
#define P_BIN(p) (CB_(p) + 0)
#define P_FG(p)  (CB_(p) + 4624)
#define P_GN(p)  (CB_(p) + 4632)
#define P_PS(p)  (CB_(p) + 5144)
#define P_L1G(p) (CB_(p) + 5656)
#define P_L1B(p) (CB_(p) + 6680)
#define P_L2G(p) (CB_(p) + 7704)
#define P_L2B(p) (CB_(p) + 8728)

constexpr size_t OUT_Y   = 0;
constexpr size_t OUT_CP  = 16908288;
constexpr size_t OUT_NP  = 17432576;
constexpr size_t OUT_MP  = 17436672;
constexpr size_t OUT_PP  = 17436704;
constexpr size_t OUT_CS  = 17498144;
constexpr size_t OUT_NS  = 25886752;
constexpr size_t OUT_MS  = 25952288;
constexpr size_t OUT_PS  = 25952800;
constexpr size_t OUT_SBUF = 0;
constexpr size_t OUT_PB   = 9000000;

#define LS 72
#define LW 136
#define SM_A 0
#define SM_B 18432
#define SM_W 36864
#define SM_MISC 71680
#define SM_TOTAL 75776

struct Params {
  const float *x_prompt, *x_sample, *c_prompt, *c_sample, *st_C, *st_n, *st_m, *st_pool;
  const float *w_mod, *b_mod, *w_in, *b_in, *b_fgate, *gn_gain, *w_pool, *pool_scale, *w_a, *w_b, *w_out;
  const float *ln1_g, *ln1_b, *w_pq, *subkeys, *peer_u, *peer_v, *ln2_g, *ln2_b;
  float* out;
  unsigned char* ws;
};

__device__ __forceinline__ bf16_t f2bf(float f) {
  unsigned u = __float_as_uint(f);
  u += 0x7FFFu + ((u >> 16) & 1u);
  return (bf16_t)(u >> 16);
}
__device__ __forceinline__ float bf2f(bf16_t h) { return __uint_as_float(((unsigned)h) << 16); }
__device__ __forceinline__ unsigned pack2(float a, float b) { return (unsigned)f2bf(a) | ((unsigned)f2bf(b) << 16); }
__device__ __forceinline__ float bflo(unsigned u) { return __uint_as_float(u << 16); }
__device__ __forceinline__ float bfhi(unsigned u) { return __uint_as_float(u & 0xFFFF0000u); }
__device__ __forceinline__ float sigmoidf_(float x) { return 1.f / (1.f + __expf(-x)); }
__device__ __forceinline__ float logsigmoidf_(float x) { return fminf(x, 0.f) - log1pf(__expf(-fabsf(x))); }
__device__ __forceinline__ float wave_sum(float v) {
#pragma unroll
  for (int o = 32; o > 0; o >>= 1) v += __shfl_xor(v, o);
  return v;
}
__device__ __forceinline__ float dot2bf(unsigned a, unsigned b, float acc) {
  return __builtin_amdgcn_fdot2_f32_bf16(__builtin_bit_cast(bf16x2_t, a), __builtin_bit_cast(bf16x2_t, b), acc, false);
}
__device__ __forceinline__ int mod_row(int row) { return row < NP ? (row >> 11) : (8 + row - NP); }
__device__ __forceinline__ const float* x_row(const Params& p, int row) {
  return row < NP ? p.x_prompt + (size_t)row * DM : p.x_sample + (size_t)(row - NP) * DM;
}

typedef __attribute__((ext_vector_type(4))) unsigned u32x4;
struct Stage4 { u32x4 v0, v1, v2, v3; };
__device__ __forceinline__ Stage4 g_load4(const bf16_t* __restrict__ A, int lda, int k0, int tid) {
  const int row = tid >> 3, kc = tid & 7;
  const bf16_t* b = A + (size_t)row * lda + k0 + kc * 8;
  Stage4 r;
  r.v0 = *(const u32x4*)(b);
  r.v1 = *(const u32x4*)(b + (size_t)32 * lda);
  r.v2 = *(const u32x4*)(b + (size_t)64 * lda);
  r.v3 = *(const u32x4*)(b + (size_t)96 * lda);
  return r;
}
__device__ __forceinline__ void s_store4(bf16_t* s, const Stage4& r, int tid) {
  const int row = tid >> 3, kc = tid & 7;
  bf16_t* b = s + row * LS + kc * 8;
  *(u32x4*)(b) = r.v0;
  *(u32x4*)(b + 32 * LS) = r.v1;
  *(u32x4*)(b + 64 * LS) = r.v2;
  *(u32x4*)(b + 96 * LS) = r.v3;
}
__device__ __forceinline__ u32x4 scale8(u32x4 v, const float* f) {
  u32x4 o;
  o.x = pack2(bflo(v.x) * f[0], bfhi(v.x) * f[1]);
  o.y = pack2(bflo(v.y) * f[2], bfhi(v.y) * f[3]);
  o.z = pack2(bflo(v.z) * f[4], bfhi(v.z) * f[5]);
  o.w = pack2(bflo(v.w) * f[6], bfhi(v.w) * f[7]);
  return o;
}
__device__ __forceinline__ void s_store4_scaled(bf16_t* s, const Stage4& r, int tid, const float* ksc) {
  const int row = tid >> 3, kc = tid & 7;
  bf16_t* b = s + row * LS + kc * 8;
  const float* f = ksc + kc * 8;
  *(u32x4*)(b) = scale8(r.v0, f);
  *(u32x4*)(b + 32 * LS) = scale8(r.v1, f);
  *(u32x4*)(b + 64 * LS) = scale8(r.v2, f);
  *(u32x4*)(b + 96 * LS) = scale8(r.v3, f);
}
__device__ __forceinline__ void mma_ktile(const bf16_t* As, int a_stride, const bf16_t* Bs, int b_stride, int nk16,
                                          f32x16 (&acc)[2][2], int wm, int wn, int lane) {
  const int r = lane & 31, h = lane >> 5;
  const bf16_t* ap = As + (wm * 64 + r) * a_stride + h * 8;
  const bf16_t* bp = Bs + (wn * 64 + r) * b_stride + h * 8;
#pragma unroll
  for (int ks = 0; ks < nk16; ++ks) {
    bf16x8 a0 = *(const bf16x8*)(ap + ks * 16);
    bf16x8 a1 = *(const bf16x8*)(ap + 32 * a_stride + ks * 16);
    bf16x8 b0 = *(const bf16x8*)(bp + ks * 16);
    bf16x8 b1 = *(const bf16x8*)(bp + 32 * b_stride + ks * 16);
    acc[0][0] = __builtin_amdgcn_mfma_f32_32x32x16_bf16(a0, b0, acc[0][0], 0, 0, 0);
    acc[0][1] = __builtin_amdgcn_mfma_f32_32x32x16_bf16(a0, b1, acc[0][1], 0, 0, 0);
    acc[1][0] = __builtin_amdgcn_mfma_f32_32x32x16_bf16(a1, b0, acc[1][0], 0, 0, 0);
    acc[1][1] = __builtin_amdgcn_mfma_f32_32x32x16_bf16(a1, b1, acc[1][1], 0, 0, 0);
  }
}
template <bool SCALE_A>
__device__ __forceinline__ void gemm_gg(const bf16_t* __restrict__ A, int lda, const bf16_t* __restrict__ Bt, int ldb, int K,
                                        unsigned char* smem, f32x16 (&acc)[2][2], const float* ksc) {
  const int tid = threadIdx.x, lane = tid & 63, w = tid >> 6, wm = w >> 1, wn = w & 1;
  bf16_t* sA = (bf16_t*)(smem + SM_A);
  bf16_t* sB = (bf16_t*)(smem + SM_B);
  Stage4 ra = g_load4(A, lda, 0, tid);
  Stage4 rb = g_load4(Bt, ldb, 0, tid);
  for (int k0 = 0; k0 < K; k0 += 64) {
    __syncthreads();
    if (SCALE_A) s_store4_scaled(sA, ra, tid, ksc + k0); else s_store4(sA, ra, tid);
    s_store4(sB, rb, tid);
    __syncthreads();
    if (k0 + 64 < K) { ra = g_load4(A, lda, k0 + 64, tid); rb = g_load4(Bt, ldb, k0 + 64, tid); }
    mma_ktile(sA, LS, sB, LS, 4, acc, wm, wn, lane);
  }
}
#define SM_B128 34816
struct Stage8 { u32x4 v0, v1, v2, v3, v4, v5, v6, v7; };
__device__ __forceinline__ Stage8 g_load8(const bf16_t* __restrict__ A, int lda, int k0, int tid) {
  const int row = tid >> 4, kc = tid & 15;
  const bf16_t* b = A + (size_t)row * lda + k0 + kc * 8;
  Stage8 r;
  r.v0 = *(const u32x4*)(b);
  r.v1 = *(const u32x4*)(b + (size_t)16 * lda);
  r.v2 = *(const u32x4*)(b + (size_t)32 * lda);
  r.v3 = *(const u32x4*)(b + (size_t)48 * lda);
  r.v4 = *(const u32x4*)(b + (size_t)64 * lda);
  r.v5 = *(const u32x4*)(b + (size_t)80 * lda);
  r.v6 = *(const u32x4*)(b + (size_t)96 * lda);
  r.v7 = *(const u32x4*)(b + (size_t)112 * lda);
  return r;
}
__device__ __forceinline__ void s_store8(bf16_t* s, const Stage8& r, int tid) {
  const int row = tid >> 4, kc = tid & 15;
  bf16_t* b = s + row * LW + kc * 8;
  *(u32x4*)(b) = r.v0;
  *(u32x4*)(b + 16 * LW) = r.v1;
  *(u32x4*)(b + 32 * LW) = r.v2;
  *(u32x4*)(b + 48 * LW) = r.v3;
  *(u32x4*)(b + 64 * LW) = r.v4;
  *(u32x4*)(b + 80 * LW) = r.v5;
  *(u32x4*)(b + 96 * LW) = r.v6;
  *(u32x4*)(b + 112 * LW) = r.v7;
}
__device__ __forceinline__ void gemm_gg128(const bf16_t* __restrict__ A, int lda, const bf16_t* __restrict__ Bt, int ldb, int K,
                                           unsigned char* smem, f32x16 (&acc)[2][2]) {
  const int tid = threadIdx.x, lane = tid & 63, w = tid >> 6, wm = w >> 1, wn = w & 1;
  bf16_t* sA = (bf16_t*)(smem);
  bf16_t* sB = (bf16_t*)(smem + SM_B128);
  Stage8 ra = g_load8(A, lda, 0, tid);
  Stage8 rb = g_load8(Bt, ldb, 0, tid);
  for (int k0 = 0; k0 < K; k0 += 128) {
    __syncthreads();
    s_store8(sA, ra, tid);
    s_store8(sB, rb, tid);
    __syncthreads();
    if (k0 + 128 < K) { ra = g_load8(A, lda, k0 + 128, tid); rb = g_load8(Bt, ldb, k0 + 128, tid); }
    mma_ktile(sA, LW, sB, LW, 8, acc, wm, wn, lane);
  }
}
__device__ __forceinline__ void gemm_sg(const bf16_t* sW, const bf16_t* __restrict__ Bt, int ldb, int K,
                                        unsigned char* smem, f32x16 (&acc)[2][2]) {
  const int tid = threadIdx.x, lane = tid & 63, w = tid >> 6, wm = w >> 1, wn = w & 1;
  bf16_t* sB = (bf16_t*)(smem + SM_B);
  Stage4 rb = g_load4(Bt, ldb, 0, tid);
  for (int k0 = 0; k0 < K; k0 += 64) {
    __syncthreads();
    s_store4(sB, rb, tid);
    __syncthreads();
    if (k0 + 64 < K) rb = g_load4(Bt, ldb, k0 + 64, tid);
    mma_ktile(sW + k0, LW, sB, LS, 4, acc, wm, wn, lane);
  }
}
#define ZERO_ACC(acc) _Pragma("unroll") for (int _i = 0; _i < 2; ++_i) _Pragma("unroll") for (int _j = 0; _j < 2; ++_j) _Pragma("unroll") for (int _r = 0; _r < 16; ++_r) acc[_i][_j][_r] = 0.f;

#define EPI_QUADS(acc, ...)                                                       \
  _Pragma("unroll") for (int mi = 0; mi < 2; ++mi)                                \
  _Pragma("unroll") for (int ni = 0; ni < 2; ++ni)                                \
  _Pragma("unroll") for (int g = 0; g < 4; ++g) {                                 \
    const int lrow0 = wm * 64 + mi * 32 + 8 * g + 4 * (lane >> 5);                \
    const int lcol = wn * 64 + ni * 32 + (lane & 31);                             \
    const float v0 = acc[mi][ni][4 * g], v1 = acc[mi][ni][4 * g + 1];             \
    const float v2 = acc[mi][ni][4 * g + 2], v3 = acc[mi][ni][4 * g + 3];         \
    (void)v0; (void)v1; (void)v2; (void)v3; (void)lrow0; (void)lcol;              \
    __VA_ARGS__ }

__device__ __forceinline__ void skinny16x32(const bf16_t* __restrict__ A, int lda, const bf16_t* __restrict__ Bt, int ldb, int K,
                                            f32x4& c0, f32x4& c1, int lane) {
  const int r = lane & 15, q = lane >> 4;
  const bf16_t* ap = A + (size_t)r * lda + q * 8;
  const bf16_t* bp0 = Bt + (size_t)r * ldb + q * 8;
  const bf16_t* bp1 = Bt + (size_t)(16 + r) * ldb + q * 8;
#pragma unroll 8
  for (int k0 = 0; k0 < K; k0 += 32) {
    const bf16x8 a = *(const bf16x8*)(ap + k0);
    const bf16x8 b0 = *(const bf16x8*)(bp0 + k0);
    const bf16x8 b1 = *(const bf16x8*)(bp1 + k0);
    c0 = __builtin_amdgcn_mfma_f32_16x16x32_bf16(a, b0, c0, 0, 0, 0);
    c1 = __builtin_amdgcn_mfma_f32_16x16x32_bf16(a, b1, c1, 0, 0, 0);
  }
}

template <int NACC>
__device__ __forceinline__ void wave4_reduce(f32x4 (&a)[NACC], unsigned char* smem, int w, int lane) {
  float* red = (float*)smem;
  __syncthreads();
#pragma unroll
  for (int i = 0; i < NACC; ++i)
#pragma unroll
    for (int j = 0; j < 4; ++j) red[((w * NACC + i) * 4 + j) * 64 + lane] = a[i][j];
  __syncthreads();
  if (w == 0) {
#pragma unroll
    for (int i = 0; i < NACC; ++i)
#pragma unroll
      for (int j = 0; j < 4; ++j)
        a[i][j] = red[((0 * NACC + i) * 4 + j) * 64 + lane] + red[((1 * NACC + i) * 4 + j) * 64 + lane] +
                  red[((2 * NACC + i) * 4 + j) * 64 + lane] + red[((3 * NACC + i) * 4 + j) * 64 + lane];
  }
}

__device__ __forceinline__ void xcd_tile(int q, int NN, int& mt, int& nt) {
  const int x = blockIdx.x & 7, npan = NN >> 3, p = q >> 6, wi = q & 63;
  mt = x * 16 + (p / npan) * 8 + (wi >> 3);
  nt = (p % npan) * 8 + (wi & 7);
}

#define TID_VARS const int tid = threadIdx.x, lane = tid & 63, w = tid >> 6, wm = w >> 1, wn = w & 1; (void)lane; (void)wm; (void)wn;

template <bool REMAP>
__device__ __forceinline__ void transpose_tile(const float* __restrict__ src, int K, int N, bf16_t* __restrict__ dst,
                                               int kt, int nt, unsigned char* smem) {
  float* sm = (float*)smem;
  const int tid = threadIdx.x; const int k0 = kt * 64, n0 = nt * 64;
  __syncthreads();
#pragma unroll
  for (int ib = 0; ib < 16; ib += 8) {
    float tv[8];
#pragma unroll
    for (int i = 0; i < 8; ++i) {
      int idx = tid + 256 * (ib + i); int r = idx >> 6, c = idx & 63; int n = n0 + c;
      tv[i] = (n < N) ? src[(size_t)(k0 + r) * N + n] : 0.f;
    }
#pragma unroll
    for (int i = 0; i < 8; ++i) {
      int idx = tid + 256 * (ib + i); int r = idx >> 6, c = idx & 63;
      sm[r * 65 + c] = tv[i];
    }
  }
  __syncthreads();
#pragma unroll 4
  for (int i = 0; i < 8; ++i) {
    int idx = tid + 256 * i; int r = idx >> 5, cp = idx & 31; int n = n0 + r;
    int nd = n;
    if (REMAP) { if (n >= 2048 && n < 2056) nd = n + 512; else if (n >= 2056 && n < 2568) nd = n - 8; }
    if (n < N) *(unsigned*)(dst + (size_t)nd * K + k0 + 2 * cp) = pack2(sm[(2 * cp) * 65 + r], sm[(2 * cp + 1) * 65 + r]);
  }
}
__device__ __forceinline__ void convert_chunk(const float* __restrict__ src, bf16_t* __restrict__ dst, size_t base) {
  const int tid = threadIdx.x;
#pragma unroll
  for (int i = 0; i < 8; ++i) {
    size_t e = base + (size_t)(tid + 256 * i) * 8;
    float4 a = *(const float4*)(src + e), b = *(const float4*)(src + e + 4);
    uint4 o; o.x = pack2(a.x, a.y); o.y = pack2(a.z, a.w); o.z = pack2(b.x, b.y); o.w = pack2(b.z, b.w);
    *(uint4*)(dst + e) = o;
  }
}
typedef __attribute__((ext_vector_type(2))) float f32x2_t;
__device__ __forceinline__ unsigned pack4_fp8(float a, float b, float c, float d) {
  int r = __builtin_amdgcn_cvt_pk_fp8_f32(a, b, 0, false);
  r = __builtin_amdgcn_cvt_pk_fp8_f32(c, d, r, true);
  return (unsigned)r;
}
__device__ __forceinline__ void convert_chunk_fp8(const float* __restrict__ src, unsigned char* __restrict__ dst, size_t base, float scale) {
  const int tid = threadIdx.x;
#pragma unroll
  for (int i = 0; i < 4; ++i) {
    size_t e = base + (size_t)(tid + 256 * i) * 16;
    float4 a = *(const float4*)(src + e), b = *(const float4*)(src + e + 4), c = *(const float4*)(src + e + 8), d = *(const float4*)(src + e + 12);
    uint4 o;
    o.x = pack4_fp8(a.x * scale, a.y * scale, a.z * scale, a.w * scale);
    o.y = pack4_fp8(b.x * scale, b.y * scale, b.z * scale, b.w * scale);
    o.z = pack4_fp8(c.x * scale, c.y * scale, c.z * scale, c.w * scale);
    o.w = pack4_fp8(d.x * scale, d.y * scale, d.z * scale, d.w * scale);
    *(uint4*)(dst + e) = o;
  }
}
__device__ __forceinline__ void mod_slab(const Params& p, int item, unsigned char* smem) {
  const int tid = threadIdx.x, lane = tid & 63, w = tid >> 6;
  const int n0 = item * 16, nl = lane & 15, kq = lane >> 4;
  f32x4 acc[9];
#pragma unroll
  for (int i = 0; i < 9; ++i) acc[i] = (f32x4){0.f, 0.f, 0.f, 0.f};
  for (int ks = 0; ks < 8; ++ks) {
    const int kb = w * 256 + ks * 32 + kq * 8;
    bf16x8 b;
#pragma unroll
    for (int j = 0; j < 8; ++j) b[j] = (short)f2bf(p.w_mod[(size_t)(kb + j) * 6144 + n0 + nl]);
#pragma unroll
    for (int mi = 0; mi < 9; ++mi) {
      int row = mi * 16 + nl; if (row > 135) row = 135;
      const float* cp = (row < 8) ? p.c_prompt + row * 1024 : p.c_sample + (row - 8) * 1024;
      float4 x0 = *(const float4*)(cp + kb), x1 = *(const float4*)(cp + kb + 4);
      bf16x8 a;
      a[0] = (short)f2bf(x0.x * sigmoidf_(x0.x)); a[1] = (short)f2bf(x0.y * sigmoidf_(x0.y));
      a[2] = (short)f2bf(x0.z * sigmoidf_(x0.z)); a[3] = (short)f2bf(x0.w * sigmoidf_(x0.w));
      a[4] = (short)f2bf(x1.x * sigmoidf_(x1.x)); a[5] = (short)f2bf(x1.y * sigmoidf_(x1.y));
      a[6] = (short)f2bf(x1.z * sigmoidf_(x1.z)); a[7] = (short)f2bf(x1.w * sigmoidf_(x1.w));
      acc[mi] = __builtin_amdgcn_mfma_f32_16x16x32_bf16(a, b, acc[mi], 0, 0, 0);
    }
  }
  float* red = (float*)smem;
  __syncthreads();
#pragma unroll
  for (int mi = 0; mi < 9; ++mi)
#pragma unroll
    for (int r = 0; r < 4; ++r) red[(w * 36 + mi * 4 + r) * 64 + lane] = acc[mi][r];
  __syncthreads();
  float* MOD = (float*)(p.ws + OFF_MOD);
  for (int i = 0; i < 9; ++i) {
    int idx = tid + 256 * i; int e = idx >> 6, l = idx & 63;
    float s = red[(0 * 36 + e) * 64 + l] + red[(1 * 36 + e) * 64 + l] + red[(2 * 36 + e) * 64 + l] + red[(3 * 36 + e) * 64 + l];
    int mi = e >> 2, r = e & 3; int row = mi * 16 + (l >> 4) * 4 + r; int col = n0 + (l & 15);
    if (row < 136) MOD[(size_t)row * 6144 + col] = s + p.b_mod[col];
  }
}
__device__ __forceinline__ void phase_A(const Params& p, unsigned char* smem) {
  const int n_items = 384 + 1168 + 128 + 128 + 256 + 512 + 16 + 1024 + 1024 + 2 + 128 + 1;
  for (int it = blockIdx.x; it < n_items; it += gridDim.x) {
    int i = it;
    if (i == n_items - 1) {
      float* cb = (float*)(p.ws + OFF_CB);
      const int tid = threadIdx.x;
      for (int k = tid; k < 4616; k += 256) cb[k] = p.b_in[k];
      if (tid < 4) cb[4624 + tid] = p.b_fgate[tid];
      for (int k = tid; k < 512; k += 256) { cb[4632 + k] = p.gn_gain[k]; cb[5144 + k] = p.pool_scale[k]; }
      for (int k = tid; k < 1024; k += 256) { cb[5656 + k] = p.ln1_g[k]; cb[6680 + k] = p.ln1_b[k]; cb[7704 + k] = p.ln2_g[k]; cb[8728 + k] = p.ln2_b[k]; }
      continue;
    }
    if (i < 384) { mod_slab(p, i, smem); continue; } i -= 384;
    if (i < 1168) { transpose_tile<true>(p.w_in, 1024, NIN, (bf16_t*)(p.ws + OFF_WIN), i / 73, i % 73, smem); continue; } i -= 1168;
    if (i < 128) { transpose_tile<false>(p.w_a, 512, 1024, (bf16_t*)(p.ws + OFF_WA), i / 16, i % 16, smem); continue; } i -= 128;
    if (i < 128) { transpose_tile<false>(p.w_b, 512, 1024, (bf16_t*)(p.ws + OFF_WB), i / 16, i % 16, smem); continue; } i -= 128;
    if (i < 256) { transpose_tile<false>(p.w_out, 1024, 1024, (bf16_t*)(p.ws + OFF_WOUT), i / 16, i % 16, smem); continue; } i -= 256;
    if (i < 512) { transpose_tile<false>(p.w_pq, 1024, 2048, (bf16_t*)(p.ws + OFF_WPQ), i / 32, i % 32, smem); continue; } i -= 512;
    if (i < 16) { int g = i >> 2, r = i & 3;
      transpose_tile<false>(p.w_pool + g * 16384, 128, 128, (bf16_t*)(p.ws + OFF_WPOOL) + g * 16384, r >> 1, r & 1, smem); continue; } i -= 16;
    if (i < 1024) { convert_chunk_fp8(p.peer_u, p.ws + OFF_PU, (size_t)i * 16384, 512.f); continue; } i -= 1024;
    if (i < 1024) { convert_chunk_fp8(p.peer_v, p.ws + OFF_PV, (size_t)i * 16384, 64.f); continue; } i -= 1024;
    if (i < 2) { convert_chunk(p.subkeys, (bf16_t*)(p.ws + OFF_SUBK), (size_t)i * 16384); continue; } i -= 2;
    {
      const float4* src = (const float4*)(p.st_pool + (size_t)i * 7680 + 512);
      float4* dst = (float4*)(p.out + OUT_PS + (size_t)i * 7680);
#pragma unroll
      for (int k = 0; k < 7; ++k) dst[threadIdx.x + 256 * k] = src[threadIdx.x + 256 * k];
    }
  }
}

__device__ __forceinline__ void phase_B(const Params& p) {
  const int tid = threadIdx.x, lane = tid & 63, w = tid >> 6;
  const float* MOD = (const float*)(p.ws + OFF_MOD);
  bf16_t* H = (bf16_t*)(p.ws + OFF_H);
  for (int row = blockIdx.x * 4 + w; row < NT; row += gridDim.x * 4) {
    const float* xr = x_row(p, row);
    float4 v[4];
#pragma unroll
    for (int i = 0; i < 4; ++i) v[i] = *(const float4*)(xr + i * 256 + lane * 4);
    float s = 0.f;
#pragma unroll
    for (int i = 0; i < 4; ++i) s += v[i].x + v[i].y + v[i].z + v[i].w;
    float mu = wave_sum(s) * (1.f / 1024.f);
    float q = 0.f;
#pragma unroll
    for (int i = 0; i < 4; ++i) { float a = v[i].x - mu, b = v[i].y - mu, c = v[i].z - mu, d = v[i].w - mu; q += a * a + b * b + c * c + d * d; }
    float rstd = rsqrtf(wave_sum(q) * (1.f / 1024.f) + LN_EPS);
    const float* mr = MOD + (size_t)mod_row(row) * 6144;
#pragma unroll
    for (int i = 0; i < 4; ++i) {
      int c = i * 256 + lane * 4;
      float4 sh = *(const float4*)(mr + c), sc = *(const float4*)(mr + 1024 + c);
      uint2 o;
      o.x = pack2((v[i].x - mu) * rstd * (1.f + sc.x) + sh.x, (v[i].y - mu) * rstd * (1.f + sc.y) + sh.y);
      o.y = pack2((v[i].z - mu) * rstd * (1.f + sc.z) + sh.z, (v[i].w - mu) * rstd * (1.f + sc.w) + sh.w);
      *(uint2*)(H + (size_t)row * 1024 + c) = o;
    }
  }
}

__device__ __forceinline__ void phase_C(const Params& p, unsigned char* smem) {
  TID_VARS
  const bf16_t* H = (const bf16_t*)(p.ws + OFF_H);
  const bf16_t* WT = (const bf16_t*)(p.ws + OFF_WIN);
  bf16_t* Q = (bf16_t*)(p.ws + OFF_Q); bf16_t* Kb = (bf16_t*)(p.ws + OFF_K); bf16_t* V = (bf16_t*)(p.ws + OFF_V);
  bf16_t* O = (bf16_t*)(p.ws + OFF_O); bf16_t* KT = (bf16_t*)(p.ws + OFF_KT); bf16_t* VT = (bf16_t*)(p.ws + OFF_VT);
  float* IG = (float*)(p.ws + OFF_IG); float* LF = (float*)(p.ws + OFF_LF); float* U = (float*)(p.ws + OFF_U);
  const int n_items = 129 * 21;
  for (int it = blockIdx.x; it < n_items; it += gridDim.x) {
    const int mt = it / 21, nt = it % 21;
    f32x16 acc[2][2]; ZERO_ACC(acc)
    gemm_gg128(H + (size_t)mt * 128 * 1024, 1024, WT + (size_t)nt * 128 * 1024, 1024, 1024, smem, acc);
    const int row_base = mt * 128, col_base = nt * 128;
    if (nt < 16) {
      const int sect = nt >> 2;
      const int hh = nt & 3;
      EPI_QUADS(acc, {
        const int col = col_base + lcol; const float bias = P_BIN(p)[col];
        const int c512 = col & 511; const int row0 = row_base + lrow0;
        float a0 = v0 + bias, a1 = v1 + bias, a2 = v2 + bias, a3 = v3 + bias;
        if (sect == 0) {
          Q[(size_t)(row0) * 512 + c512] = f2bf(a0); Q[(size_t)(row0 + 1) * 512 + c512] = f2bf(a1);
          Q[(size_t)(row0 + 2) * 512 + c512] = f2bf(a2); Q[(size_t)(row0 + 3) * 512 + c512] = f2bf(a3);
        } else if (sect == 1) {
          const float sc = 0.08838834764831845f;
          a0 *= sc; a1 *= sc; a2 *= sc; a3 *= sc;
          Kb[(size_t)(row0) * 512 + c512] = f2bf(a0); Kb[(size_t)(row0 + 1) * 512 + c512] = f2bf(a1);
          Kb[(size_t)(row0 + 2) * 512 + c512] = f2bf(a2); Kb[(size_t)(row0 + 3) * 512 + c512] = f2bf(a3);
          if (mt < 128) {
            const int b = mt >> 4, t = (mt & 15) * 128 + lrow0;
            uint2 o; o.x = pack2(a0, a1); o.y = pack2(a2, a3);
            *(uint2*)(KT + ((size_t)((b * 4 + hh) * 128 + (c512 & 127))) * 2048 + t) = o;
          }
        } else if (sect == 2) {
          if (mt >= 128) {
            V[(size_t)(row0) * 512 + c512] = f2bf(a0); V[(size_t)(row0 + 1) * 512 + c512] = f2bf(a1);
            V[(size_t)(row0 + 2) * 512 + c512] = f2bf(a2); V[(size_t)(row0 + 3) * 512 + c512] = f2bf(a3);
          }
          if (mt < 128) {
            const int b = mt >> 4, t = (mt & 15) * 128 + lrow0;
            uint2 o; o.x = pack2(a0, a1); o.y = pack2(a2, a3);
            *(uint2*)(VT + ((size_t)((b * 4 + hh) * 128 + (c512 & 127))) * 2048 + t) = o;
          }
        } else {
          O[(size_t)(row0) * 512 + c512] = f2bf(sigmoidf_(a0)); O[(size_t)(row0 + 1) * 512 + c512] = f2bf(sigmoidf_(a1));
          O[(size_t)(row0 + 2) * 512 + c512] = f2bf(sigmoidf_(a2)); O[(size_t)(row0 + 3) * 512 + c512] = f2bf(sigmoidf_(a3));
        }
      })
    } else if (nt < 20) {
      EPI_QUADS(acc, {
        const int uc = (nt - 16) * 128 + lcol; const int row0 = row_base + lrow0;
        const float bias = P_BIN(p)[2056 + uc];
        U[(size_t)(row0) * 512 + uc] = v0 + bias; U[(size_t)(row0 + 1) * 512 + uc] = v1 + bias;
        U[(size_t)(row0 + 2) * 512 + uc] = v2 + bias; U[(size_t)(row0 + 3) * 512 + uc] = v3 + bias;
      })
    } else {
      EPI_QUADS(acc, {
        const int row0 = row_base + lrow0;
        if (lcol < 4) {
          const float bias = P_BIN(p)[2048 + lcol];
          IG[(size_t)(row0) * 4 + lcol] = v0 + bias; IG[(size_t)(row0 + 1) * 4 + lcol] = v1 + bias;
          IG[(size_t)(row0 + 2) * 4 + lcol] = v2 + bias; IG[(size_t)(row0 + 3) * 4 + lcol] = v3 + bias;
        } else if (lcol < 8) {
          const int hh = lcol - 4; const float bias = P_BIN(p)[2052 + hh] + P_FG(p)[hh];
          LF[(size_t)(row0) * 4 + hh] = logsigmoidf_(v0 + bias); LF[(size_t)(row0 + 1) * 4 + hh] = logsigmoidf_(v1 + bias);
          LF[(size_t)(row0 + 2) * 4 + hh] = logsigmoidf_(v2 + bias); LF[(size_t)(row0 + 3) * 4 + hh] = logsigmoidf_(v3 + bias);
        }
      })
    }
  }
}

__device__ __forceinline__ void d1_prompt_chunk(const Params& p, int item, unsigned char* smem) {
  TID_VARS
  const int bh = item >> 4, c = item & 15, b = bh >> 2, h = bh & 3;
  const int r0 = b * 2048 + c * 128;
  float* misc = (float*)(smem + SM_MISC);
  float* s_lf = misc, *s_ig = misc + 128, *s_b = misc + 256, *s_g = misc + 384, *s_d = misc + 512;
  const float* IG = (const float*)(p.ws + OFF_IG); const float* LF = (const float*)(p.ws + OFF_LF);
  __syncthreads();
  if (tid < 128) { s_lf[tid] = LF[(size_t)(r0 + tid) * 4 + h]; s_ig[tid] = IG[(size_t)(r0 + tid) * 4 + h]; }
  __syncthreads();
  if (tid < 128) { float a = 0.f; for (int j = 0; j <= tid; ++j) a += s_lf[j]; s_b[tid] = a; }
  __syncthreads();
  const float Btot = s_b[127];
  if (tid < 128) s_g[tid] = Btot - s_b[tid] + s_ig[tid];
  __syncthreads();
  float amax = -3.0e38f;
  for (int j = 0; j < 128; ++j) amax = fmaxf(amax, s_g[j]);
  if (tid < 128) s_d[tid] = __expf(s_g[tid] - amax);
  if (tid == 0) { ((float*)(p.ws + OFF_CHB))[item * 32] = Btot; ((float*)(p.ws + OFF_CHB))[item * 32 + 1] = amax; }
  __syncthreads();
  const bf16_t* KT = (const bf16_t*)(p.ws + OFF_KT) + (size_t)bh * 128 * 2048 + c * 128;
  const bf16_t* VT = (const bf16_t*)(p.ws + OFF_VT) + (size_t)bh * 128 * 2048 + c * 128;
  if (tid < 128) {
    const uint4* kr = (const uint4*)(KT + (size_t)tid * 2048);
    float a = 0.f;
#pragma unroll 4
    for (int j = 0; j < 16; ++j) {
      uint4 v = kr[j]; const float* d = s_d + j * 8;
      a += bflo(v.x) * d[0] + bfhi(v.x) * d[1] + bflo(v.y) * d[2] + bfhi(v.y) * d[3] + bflo(v.z) * d[4] + bfhi(v.z) * d[5] + bflo(v.w) * d[6] + bfhi(v.w) * d[7];
    }
    ((float*)(p.ws + OFF_NLOC))[(size_t)item * 128 + tid] = a;
  }
  f32x16 acc[2][2]; ZERO_ACC(acc)
  gemm_gg<true>(VT, 2048, KT, 2048, 128, smem, acc, s_d);
  float* SB = p.out + OUT_SBUF + (size_t)item * 16384;
  EPI_QUADS(acc, {
    SB[(size_t)(lrow0) * 128 + lcol] = v0; SB[(size_t)(lrow0 + 1) * 128 + lcol] = v1;
    SB[(size_t)(lrow0 + 2) * 128 + lcol] = v2; SB[(size_t)(lrow0 + 3) * 128 + lcol] = v3;
  })
}
__device__ __forceinline__ void d1_sample_step(const Params& p, int item, unsigned char* smem) {
  const int tid = threadIdx.x;
  const int s = item >> 2, h = item & 3, row = NP + s;
  float* misc = (float*)(smem + SM_MISC);
  float* s_q = misc, *s_k = misc + 128, *s_red = misc + 256, *s_num = misc + 512  , *s_h = misc + 768  ;
  bf16_t* Q = (bf16_t*)(p.ws + OFF_Q); const bf16_t* Kb = (const bf16_t*)(p.ws + OFF_K); const bf16_t* V = (const bf16_t*)(p.ws + OFF_V);
  const bf16_t* O = (const bf16_t*)(p.ws + OFF_O);
  __syncthreads();
  if (tid < 128) { s_q[tid] = bf2f(Q[(size_t)row * 512 + h * 128 + tid]); s_k[tid] = bf2f(Kb[(size_t)row * 512 + h * 128 + tid]); }
  else {
    const int c = tid - 128, g = h, wlen = 2 << g;
    const float ut = ((const float*)(p.ws + OFF_U))[(size_t)row * 512 + g * 128 + c];
    const float* __restrict__ pre = p.st_pool + (size_t)s * 15 * 512 + g * 128 + c;
    float sum = ut;
    for (int q = 1; q < wlen; ++q) sum += pre[(size_t)(15 - q) * 512];
    s_red[c] = sum / (float)wlen - ut;
    p.out[OUT_PS + ((size_t)s * 15 + 14) * 512 + g * 128 + c] = ut;
  }
  __syncthreads();
  {
    const int d = tid & 127, ch = tid >> 7, g = h;
    const float* __restrict__ wp = p.w_pool + (size_t)g * 16384 + (size_t)(ch * 64) * 128 + d;
    float a = 0.f;
#pragma unroll
    for (int cb = 0; cb < 64; cb += 16) {
      float wv[16];
#pragma unroll
      for (int j = 0; j < 16; ++j) wv[j] = wp[(size_t)(cb + j) * 128];
#pragma unroll
      for (int j = 0; j < 16; ++j) a += s_red[ch * 64 + cb + j] * wv[j];
    }
    s_num[tid] = a;
    __syncthreads();
    if (tid < 128) ((bf16_t*)(p.out + OUT_PB))[(size_t)row * 512 + g * 128 + tid] = f2bf((s_num[tid] + s_num[tid + 128]) * P_PS(p)[g * 128 + tid]);
    __syncthreads();
  }
  const float ig = ((const float*)(p.ws + OFF_IG))[(size_t)row * 4 + h];
  const float lf = ((const float*)(p.ws + OFF_LF))[(size_t)row * 4 + h];
  const float m0 = p.st_m[s * 4 + h];
  const float* n0 = p.st_n + (size_t)(s * 4 + h) * 128;
  float qk = 0.f, qn = 0.f;
#pragma unroll 4
  for (int j = 0; j < 128; ++j) { qk += s_q[j] * s_k[j]; qn += s_q[j] * n0[j]; }
  const float log_g = lf + m0;
  const float mt = fmaxf(log_g, ig);
  const float wq = __expf(ig - mt) * qk;
  const float wst = __expf(log_g - mt);
  const float dcs = __expf(ig - mt);
  const float dcc = __expf(lf + m0 - mt);
  const int dv = tid & 127, half = tid >> 7;
  const float vv = bf2f(V[(size_t)row * 512 + h * 128 + dv]);
  const float* __restrict__ C0 = p.st_C + (size_t)(s * 4 + h) * 16384;
  float* __restrict__ Cn = p.out + OUT_CS + (size_t)(s * 4 + h) * 16384;
  float part = 0.f;
#pragma unroll
  for (int jb = 0; jb < 64; jb += 16) {
    float c0v[16];
#pragma unroll
    for (int j = 0; j < 16; ++j) c0v[j] = C0[(half * 64 + jb + j) * 128 + dv];
#pragma unroll
    for (int j = 0; j < 16; ++j) {
      const int dk = half * 64 + jb + j;
      part += s_q[dk] * c0v[j];
      Cn[dk * 128 + dv] = dcc * c0v[j] + dcs * s_k[dk] * vv;
    }
  }
  s_num[tid] = part;
  if (tid < 128) p.out[OUT_NS + (size_t)(s * 4 + h) * 128 + tid] = dcc * n0[tid] + dcs * s_k[tid];
  if (tid == 0) p.out[OUT_MS + s * 4 + h] = mt;
  __syncthreads();
  if (tid < 128) {
    float num = wq * vv + wst * (s_num[tid] + s_num[tid + 128]);
    float den = wq + wst * qn;
    float hv = num / fmaxf(fabsf(den), __expf(-mt));
    s_h[tid] = hv;
  }
  __syncthreads();
  if (tid < 128) {
    float mu = 0.f;
#pragma unroll 4
    for (int j = 0; j < 128; ++j) mu += s_h[j];
    mu *= (1.f / 128.f);
    float var = 0.f;
#pragma unroll 4
    for (int j = 0; j < 128; ++j) { float d = s_h[j] - mu; var += d * d; }
    var *= (1.f / 128.f);
    float y = (s_h[tid] - mu) * rsqrtf(var + LN_EPS) * P_GN(p)[h * 128 + tid] * bf2f(O[(size_t)row * 512 + h * 128 + tid]);
    Q[(size_t)row * 512 + h * 128 + tid] = f2bf(y);
  }
}
template <int WLEN>
__device__ __forceinline__ void pool_rows(const Params& p, const float* __restrict__ U, int mt, int g, unsigned* sW32, int tid) {
  const int cp = tid & 63, qtr = tid >> 6;
  if (mt < 128) {
    const int b = mt >> 4, t0 = (mt & 15) * 128 + qtr * 32;
    const float* Ub = U + (size_t)b * 2048 * 512 + g * 128 + cp * 2;
    float2 u[31 + WLEN];
#pragma unroll
    for (int k = 0; k < 31 + WLEN; ++k) {
      const int t = t0 - (WLEN - 1) + k;
      u[k] = (t >= 0) ? *(const float2*)(Ub + (size_t)t * 512) : make_float2(0.f, 0.f);
    }
    float s0 = 0.f, s1 = 0.f;
#pragma unroll
    for (int k = 0; k < WLEN - 1; ++k) { s0 += u[k].x; s1 += u[k].y; }
#pragma unroll
    for (int j = 0; j < 32; ++j) {
      const float2 ut = u[WLEN - 1 + j];
      const int t = t0 + j;
      s0 += ut.x; s1 += ut.y;
      const float rc = 1.f / (float)min(WLEN, t + 1);
      sW32[(qtr * 32 + j) * (LW / 2) + cp] = pack2(s0 * rc - ut.x, s1 * rc - ut.y);
      s0 -= u[j].x; s1 -= u[j].y;
      if (t >= 2033) *(float2*)(p.out + OUT_PP + ((size_t)b * 15 + (t - 2033)) * 512 + g * 128 + cp * 2) = ut;
    }
  } else {
    const float rc = 1.f / (float)WLEN;
#pragma unroll 2
    for (int j = 0; j < 32; ++j) {
      const int sidx = qtr * 32 + j;
      const float2 ut = *(const float2*)(U + (size_t)(NP + sidx) * 512 + g * 128 + cp * 2);
      const float* __restrict__ pre = p.st_pool + (size_t)sidx * 15 * 512 + g * 128 + cp * 2;
      float2 pr[WLEN - 1];
#pragma unroll
      for (int q = 1; q < WLEN; ++q) pr[q - 1] = *(const float2*)(pre + (size_t)(15 - q) * 512);
      float s0 = ut.x, s1 = ut.y;
#pragma unroll
      for (int q = 0; q < WLEN - 1; ++q) { s0 += pr[q].x; s1 += pr[q].y; }
      sW32[sidx * (LW / 2) + cp] = pack2(s0 * rc - ut.x, s1 * rc - ut.y);
      *(float2*)(p.out + OUT_PS + ((size_t)sidx * 15 + 14) * 512 + g * 128 + cp * 2) = ut;
    }
  }
}
__device__ __forceinline__ void d1_pool(const Params& p, int item, unsigned char* smem) {
  TID_VARS
  const int mt = item >> 2, g = item & 3;
  const float* U = (const float*)(p.ws + OFF_U);
  bf16_t* sW = (bf16_t*)(smem + SM_W);
  __syncthreads();
  if (g == 0) pool_rows<2>(p, U, mt, g, (unsigned*)sW, tid);
  else if (g == 1) pool_rows<4>(p, U, mt, g, (unsigned*)sW, tid);
  else if (g == 2) pool_rows<8>(p, U, mt, g, (unsigned*)sW, tid);
  else pool_rows<16>(p, U, mt, g, (unsigned*)sW, tid);
  f32x16 acc[2][2]; ZERO_ACC(acc)
  gemm_sg(sW, (const bf16_t*)(p.ws + OFF_WPOOL) + g * 16384, 128, 128, smem, acc);
  bf16_t* PB = (bf16_t*)(p.out + OUT_PB);
  const int row_base = mt * 128;
  const int grp_col0 = g * 128;
  EPI_QUADS(acc, {
    const int col = grp_col0 + lcol; const float sc = P_PS(p)[col]; const int row0 = row_base + lrow0;
    PB[(size_t)(row0) * 512 + col] = f2bf(v0 * sc); PB[(size_t)(row0 + 1) * 512 + col] = f2bf(v1 * sc);
    PB[(size_t)(row0 + 2) * 512 + col] = f2bf(v2 * sc); PB[(size_t)(row0 + 3) * 512 + col] = f2bf(v3 * sc);
  })
}
__device__ __forceinline__ void phase_D1(const Params& p, unsigned char* smem) {
  for (int it = blockIdx.x; it < 512; it += gridDim.x) d1_prompt_chunk(p, it, smem);
  for (int it = blockIdx.x; it < 512; it += gridDim.x) d1_sample_step(p, it, smem);
  for (int it = blockIdx.x; it < 512; it += gridDim.x) d1_pool(p, it, smem);
}

__device__ __forceinline__ void phase_D2(const Params& p) {
  const int tid = threadIdx.x;
  const float* CHB = (const float*)(p.ws + OFF_CHB);
  const int n_items = 32 * 64 + 32;
  for (int it = blockIdx.x; it < n_items; it += gridDim.x) {
    if (it < 2048) {
      const int bh = it >> 6, e = (it & 63) * 256 + tid;
      const float* __restrict__ SB = p.out + OUT_SBUF + (size_t)bh * 16 * 16384 + e;
      bf16_t* __restrict__ CT = (bf16_t*)(p.ws + OFF_CT) + (size_t)bh * 16 * 16384 + e;
      float dcv[16], dsv[16], sb[16];
#pragma unroll
      for (int c = 0; c < 16; ++c) sb[c] = SB[(size_t)c * 16384];
      {
        float Bv[16], av[16];
#pragma unroll
        for (int c = 0; c < 16; ++c) { Bv[c] = CHB[(bh * 16 + c) * 32]; av[c] = CHB[(bh * 16 + c) * 32 + 1]; }
        float m = 0.f;
#pragma unroll
        for (int c = 0; c < 16; ++c) { float mn = fmaxf(Bv[c] + m, av[c]); dcv[c] = __expf(Bv[c] + m - mn); dsv[c] = __expf(av[c] - mn); m = mn; }
      }
      float C = 0.f;
#pragma unroll
      for (int c = 0; c < 16; ++c) { CT[(size_t)c * 16384] = f2bf(C); C = dcv[c] * C + dsv[c] * sb[c]; }
      const int dv = e >> 7, dk = e & 127;
      p.out[OUT_CP + (size_t)bh * 16384 + dk * 128 + dv] = C;
    } else {
      const int bh = it - 2048;
      if (tid < 128) {
        const float* NL = (const float*)(p.ws + OFF_NLOC) + (size_t)bh * 16 * 128 + tid;
        float* NPV = (float*)(p.ws + OFF_NPREV) + (size_t)bh * 16 * 128 + tid;
        float* MPV = (float*)(p.ws + OFF_MPREV) + bh * 16 * 32;
        float m = 0.f, n = 0.f;
        for (int c = 0; c < 16; ++c) {
          NPV[c * 128] = n;
          if (tid == 0) MPV[c * 32] = m;
          float B = CHB[(bh * 16 + c) * 32], a = CHB[(bh * 16 + c) * 32 + 1];
          float mn = fmaxf(B + m, a);
          n = __expf(B + m - mn) * n + __expf(a - mn) * NL[c * 128];
          m = mn;
        }
        p.out[OUT_NP + bh * 128 + tid] = n;
        if (tid == 0) p.out[OUT_MP + bh] = m;
      }
    }
  }
}

__device__ __forceinline__ void phase_D3(const Params& p, unsigned char* smem) {
  TID_VARS
  float* misc = (float*)(smem + SM_MISC);
  float* s_lf = misc, *s_ig = misc + 128, *s_b = misc + 256, *s_colf = misc + 384, *s_rowf = misc + 512, *s_wst = misc + 640, *s_inv = misc + 768;
  bf16_t* sW = (bf16_t*)(smem + SM_W);
  float* sH = (float*)smem;
  bf16_t* Q = (bf16_t*)(p.ws + OFF_Q); const bf16_t* Kb = (const bf16_t*)(p.ws + OFF_K); const bf16_t* O = (const bf16_t*)(p.ws + OFF_O);
  const float* IG = (const float*)(p.ws + OFF_IG); const float* LF = (const float*)(p.ws + OFF_LF);
  for (int item = blockIdx.x; item < 512; item += gridDim.x) {
    const int bh = item >> 4, c = item & 15, b = bh >> 2, h = bh & 3;
    const int r0 = b * 2048 + c * 128;
    const float m_prev = ((const float*)(p.ws + OFF_MPREV))[item * 32];
    __syncthreads();
    if (tid < 128) { s_lf[tid] = LF[(size_t)(r0 + tid) * 4 + h]; s_ig[tid] = IG[(size_t)(r0 + tid) * 4 + h];
                     misc[896 + tid] = ((const float*)(p.ws + OFF_NPREV))[(size_t)item * 128 + tid]; }
    __syncthreads();
    if (tid < 128) { float a = 0.f;
#pragma unroll 2
      for (int j = 0; j <= tid; ++j) a += s_lf[j];
      s_b[tid] = a; s_colf[tid] = s_ig[tid] - a; }
    __syncthreads();
    if (tid < 128) {
      float pm = -3.0e38f;
#pragma unroll 2
      for (int j = 0; j <= tid; ++j) pm = fmaxf(pm, s_colf[j]);
      float bt = s_b[tid];
      float mt = bt + fmaxf(m_prev, pm);
      s_rowf[tid] = bt - mt;
      s_wst[tid] = __expf(bt + m_prev - mt);
      s_inv[tid] = mt;
    }
    const bf16_t* Qp = Q + (size_t)r0 * 512 + h * 128;
    const bf16_t* Kp = Kb + (size_t)r0 * 512 + h * 128;
    f32x16 acc[2][2]; ZERO_ACC(acc)
    gemm_gg<false>(Qp, 512, Kp, 512, 128, smem, acc, nullptr);
    EPI_QUADS(acc, {
      const float cf = s_colf[lcol];
      float w0 = (lcol <= lrow0) ? __expf(s_rowf[lrow0] + cf) * v0 : 0.f;
      float w1 = (lcol <= lrow0 + 1) ? __expf(s_rowf[lrow0 + 1] + cf) * v1 : 0.f;
      float w2 = (lcol <= lrow0 + 2) ? __expf(s_rowf[lrow0 + 2] + cf) * v2 : 0.f;
      float w3 = (lcol <= lrow0 + 3) ? __expf(s_rowf[lrow0 + 3] + cf) * v3 : 0.f;
      sW[(lrow0) * LW + lcol] = f2bf(w0); sW[(lrow0 + 1) * LW + lcol] = f2bf(w1);
      sW[(lrow0 + 2) * LW + lcol] = f2bf(w2); sW[(lrow0 + 3) * LW + lcol] = f2bf(w3);
    })
    __syncthreads();
    if (tid < 128) {
      float d1 = 0.f;
      const unsigned* wr = (const unsigned*)(sW + tid * LW);
#pragma unroll 4
      for (int j = 0; j < 64; ++j) { unsigned u = wr[j]; d1 += bflo(u) + bfhi(u); }
      const float* npv = misc + 896;
      const uint4* qr = (const uint4*)(Qp + (size_t)tid * 512);
      float qn = 0.f;
#pragma unroll 2
      for (int j = 0; j < 16; ++j) {
        const uint4 v = qr[j]; const float* n = npv + j * 8;
        qn += bflo(v.x) * n[0] + bfhi(v.x) * n[1] + bflo(v.y) * n[2] + bfhi(v.y) * n[3] + bflo(v.z) * n[4] + bfhi(v.z) * n[5] + bflo(v.w) * n[6] + bfhi(v.w) * n[7];
      }
      float den = d1 + s_wst[tid] * qn;
      float mt = s_inv[tid];
      s_inv[tid] = 1.f / fmaxf(fabsf(den), __expf(-mt));
    }
    ZERO_ACC(acc)
    gemm_gg<false>(Qp, 512, (const bf16_t*)(p.ws + OFF_CT) + (size_t)item * 16384, 128, 128, smem, acc, nullptr);
    EPI_QUADS(acc, {
      acc[mi][ni][4 * g] = v0 * s_wst[lrow0]; acc[mi][ni][4 * g + 1] = v1 * s_wst[lrow0 + 1];
      acc[mi][ni][4 * g + 2] = v2 * s_wst[lrow0 + 2]; acc[mi][ni][4 * g + 3] = v3 * s_wst[lrow0 + 3];
    })
    gemm_sg(sW, (const bf16_t*)(p.ws + OFF_VT) + (size_t)bh * 128 * 2048 + c * 128, 2048, 128, smem, acc);
    __syncthreads();
    EPI_QUADS(acc, {
      sH[(lrow0) * 129 + lcol] = v0 * s_inv[lrow0]; sH[(lrow0 + 1) * 129 + lcol] = v1 * s_inv[lrow0 + 1];
      sH[(lrow0 + 2) * 129 + lcol] = v2 * s_inv[lrow0 + 2]; sH[(lrow0 + 3) * 129 + lcol] = v3 * s_inv[lrow0 + 3];
    })
    __syncthreads();
    {
      const int t = tid >> 1, half = tid & 1;
      const float* hr = sH + t * 129 + half * 64;
      float s = 0.f;
#pragma unroll 4
      for (int j = 0; j < 64; ++j) s += hr[j];
      s += __shfl_xor(s, 1);
      const float mu = s * (1.f / 128.f);
      float q = 0.f;
#pragma unroll 4
      for (int j = 0; j < 64; ++j) { float d = hr[j] - mu; q += d * d; }
      q += __shfl_xor(q, 1);
      const float rstd = rsqrtf(q * (1.f / 128.f) + LN_EPS);
      const size_t gofs = (size_t)(r0 + t) * 512 + h * 128 + half * 64;
      const float* __restrict__ gn = P_GN(p) + h * 128 + half * 64;
      uint4 ov[8];
#pragma unroll
      for (int k = 0; k < 8; ++k) ov[k] = *(const uint4*)(O + gofs + 8 * k);
#pragma unroll
      for (int k = 0; k < 8; ++k) {
        const float* hk = hr + 8 * k; const float* gk = gn + 8 * k;
        uint4 o;
        o.x = pack2((hk[0] - mu) * rstd * gk[0] * bflo(ov[k].x), (hk[1] - mu) * rstd * gk[1] * bfhi(ov[k].x));
        o.y = pack2((hk[2] - mu) * rstd * gk[2] * bflo(ov[k].y), (hk[3] - mu) * rstd * gk[3] * bfhi(ov[k].y));
        o.z = pack2((hk[4] - mu) * rstd * gk[4] * bflo(ov[k].z), (hk[5] - mu) * rstd * gk[5] * bfhi(ov[k].z));
        o.w = pack2((hk[6] - mu) * rstd * gk[6] * bflo(ov[k].w), (hk[7] - mu) * rstd * gk[7] * bfhi(ov[k].w));
        *(uint4*)(Q + gofs + 8 * k) = o;
      }
    }
  }
}

__device__ __forceinline__ void phase_E(const Params& p, unsigned char* smem) {
  TID_VARS
  const bf16_t* H = (const bf16_t*)(p.ws + OFF_H);
  const bf16_t* WT = (const bf16_t*)(p.ws + OFF_WIN);
  const bf16_t* HA = (const bf16_t*)(p.ws + OFF_Q);
  const bf16_t* PB = (const bf16_t*)(p.out + OUT_PB);
  bf16_t* MG = (bf16_t*)(p.ws + OFF_MERGED);
  for (int pc = blockIdx.x; pc < 256; pc += gridDim.x) {
    const int row0 = NP + (pc & 7) * 16, col0 = (pc >> 3) * 32;
    const f32x4 z4 = {0.f, 0.f, 0.f, 0.f};
    f32x4 a8[8] = {z4, z4, z4, z4, z4, z4, z4, z4};
    skinny16x32(H + (size_t)row0 * 1024 + w * 256, 1024, WT + (size_t)(2568 + col0) * 1024 + w * 256, 1024, 256, a8[0], a8[1], lane);
    skinny16x32(HA + (size_t)row0 * 512 + w * 128, 512, (const bf16_t*)(p.ws + OFF_WA) + (size_t)col0 * 512 + w * 128, 512, 128, a8[2], a8[3], lane);
    skinny16x32(H + (size_t)row0 * 1024 + w * 256, 1024, WT + (size_t)(3592 + col0) * 1024 + w * 256, 1024, 256, a8[4], a8[5], lane);
    skinny16x32(PB + (size_t)row0 * 512 + w * 128, 512, (const bf16_t*)(p.ws + OFF_WB) + (size_t)col0 * 512 + w * 128, 512, 128, a8[6], a8[7], lane);
    wave4_reduce<8>(a8, smem, w, lane);
    if (w == 0) {
      const int c = col0 + (lane & 15), rr = row0 + (lane >> 4) * 4;
      const float ba0 = P_BIN(p)[2568 + c], ba1 = P_BIN(p)[2568 + c + 16], bb0 = P_BIN(p)[3592 + c], bb1 = P_BIN(p)[3592 + c + 16];
#pragma unroll
      for (int j = 0; j < 4; ++j) {
        MG[(size_t)(rr + j) * 1024 + c] = f2bf(sigmoidf_(a8[0][j] + ba0) * a8[2][j] + sigmoidf_(a8[4][j] + bb0) * a8[6][j]);
        MG[(size_t)(rr + j) * 1024 + c + 16] = f2bf(sigmoidf_(a8[1][j] + ba1) * a8[3][j] + sigmoidf_(a8[5][j] + bb1) * a8[7][j]);
      }
    }
  }
  for (int q = blockIdx.x >> 3; q < 16 * 8; q += (gridDim.x >> 3)) {
    int mt, nt; xcd_tile(q, 8, mt, nt);
    const int row_base = mt * 128, col_base = nt * 128;
    unsigned gpk[32];
    unsigned* mlds = (unsigned*)(smem + SM_W) + tid;
    f32x16 acc[2][2];
    ZERO_ACC(acc)
    gemm_gg<false>(H + (size_t)row_base * 1024, 1024, WT + (size_t)(2568 + col_base) * 1024, 1024, 1024, smem, acc, nullptr);
    EPI_QUADS(acc, {
      const float bias = P_BIN(p)[2568 + col_base + lcol];
      gpk[(mi * 2 + ni) * 8 + g * 2] = pack2(sigmoidf_(v0 + bias), sigmoidf_(v1 + bias));
      gpk[(mi * 2 + ni) * 8 + g * 2 + 1] = pack2(sigmoidf_(v2 + bias), sigmoidf_(v3 + bias));
    })
    ZERO_ACC(acc)
    gemm_gg<false>(HA + (size_t)row_base * 512, 512, (const bf16_t*)(p.ws + OFF_WA) + (size_t)col_base * 512, 512, 512, smem, acc, nullptr);
    EPI_QUADS(acc, {
      unsigned g0 = gpk[(mi * 2 + ni) * 8 + g * 2], g1 = gpk[(mi * 2 + ni) * 8 + g * 2 + 1];
      mlds[((mi * 2 + ni) * 8 + g * 2) * 256] = pack2(bflo(g0) * v0, bfhi(g0) * v1);
      mlds[((mi * 2 + ni) * 8 + g * 2 + 1) * 256] = pack2(bflo(g1) * v2, bfhi(g1) * v3);
    })
    ZERO_ACC(acc)
    gemm_gg<false>(H + (size_t)row_base * 1024, 1024, WT + (size_t)(3592 + col_base) * 1024, 1024, 1024, smem, acc, nullptr);
    EPI_QUADS(acc, {
      const float bias = P_BIN(p)[3592 + col_base + lcol];
      gpk[(mi * 2 + ni) * 8 + g * 2] = pack2(sigmoidf_(v0 + bias), sigmoidf_(v1 + bias));
      gpk[(mi * 2 + ni) * 8 + g * 2 + 1] = pack2(sigmoidf_(v2 + bias), sigmoidf_(v3 + bias));
    })
    ZERO_ACC(acc)
    gemm_gg<false>(PB + (size_t)row_base * 512, 512, (const bf16_t*)(p.ws + OFF_WB) + (size_t)col_base * 512, 512, 512, smem, acc, nullptr);
    EPI_QUADS(acc, {
      unsigned g0 = gpk[(mi * 2 + ni) * 8 + g * 2], g1 = gpk[(mi * 2 + ni) * 8 + g * 2 + 1];
      unsigned m0 = mlds[((mi * 2 + ni) * 8 + g * 2) * 256], m1 = mlds[((mi * 2 + ni) * 8 + g * 2 + 1) * 256];
      const int col = col_base + lcol; const int row0 = row_base + lrow0;
      MG[(size_t)(row0) * 1024 + col] = f2bf(bflo(m0) + bflo(g0) * v0);
      MG[(size_t)(row0 + 1) * 1024 + col] = f2bf(bfhi(m0) + bfhi(g0) * v1);
      MG[(size_t)(row0 + 2) * 1024 + col] = f2bf(bflo(m1) + bflo(g1) * v2);
      MG[(size_t)(row0 + 3) * 1024 + col] = f2bf(bfhi(m1) + bfhi(g1) * v3);
    })
  }
}

__device__ __forceinline__ void phase_F(const Params& p, unsigned char* smem) {
  TID_VARS
  const bf16_t* MG = (const bf16_t*)(p.ws + OFF_MERGED);
  const bf16_t* WO = (const bf16_t*)(p.ws + OFF_WOUT);
  const float* MOD = (const float*)(p.ws + OFF_MOD);
  float* Y = p.out + OUT_Y;
  for (int pc = blockIdx.x; pc < 256; pc += gridDim.x) {
    const int row0 = NP + (pc & 7) * 16, col0 = (pc >> 3) * 32;
    const f32x4 z4 = {0.f, 0.f, 0.f, 0.f};
    f32x4 a2[2] = {z4, z4};
    skinny16x32(MG + (size_t)row0 * 1024 + w * 256, 1024, WO + (size_t)col0 * 1024 + w * 256, 1024, 256, a2[0], a2[1], lane);
    wave4_reduce<2>(a2, smem, w, lane);
    if (w == 0) {
      const int c = col0 + (lane & 15), rr = row0 + (lane >> 4) * 4;
#pragma unroll
      for (int j = 0; j < 4; ++j) {
        const int row = rr + j;
        const float* mg = MOD + (size_t)mod_row(row) * 6144 + 2048;
        const float* xr = x_row(p, row);
        Y[(size_t)row * 1024 + c] = ALPHA * xr[c] + mg[c] * a2[0][j];
        Y[(size_t)row * 1024 + c + 16] = ALPHA * xr[c + 16] + mg[c + 16] * a2[1][j];
      }
    }
  }
  for (int q = blockIdx.x >> 3; q < 16 * 8; q += (gridDim.x >> 3)) {
    int mt, nt; xcd_tile(q, 8, mt, nt);
    const int row_base = mt * 128, col_base = nt * 128;
    f32x16 acc[2][2]; ZERO_ACC(acc)
    gemm_gg128(MG + (size_t)row_base * 1024, 1024, WO + (size_t)col_base * 1024, 1024, 1024, smem, acc);
    EPI_QUADS(acc, {
      const int col = col_base + lcol; const int row0 = row_base + lrow0;
      const float* mg = MOD + (size_t)mod_row(row0) * 6144 + 2048 + col;
      const float g1 = *mg;
      Y[(size_t)(row0) * 1024 + col] = ALPHA * x_row(p, row0)[col] + g1 * v0;
      Y[(size_t)(row0 + 1) * 1024 + col] = ALPHA * x_row(p, row0 + 1)[col] + (row0 < NP ? g1 : mg[6144]) * v1;
      Y[(size_t)(row0 + 2) * 1024 + col] = ALPHA * x_row(p, row0 + 2)[col] + (row0 < NP ? g1 : mg[2 * 6144]) * v2;
      Y[(size_t)(row0 + 3) * 1024 + col] = ALPHA * x_row(p, row0 + 3)[col] + (row0 < NP ? g1 : mg[3 * 6144]) * v3;
    })
  }
}

__device__ __forceinline__ void phase_G(const Params& p) {
  const int tid = threadIdx.x, lane = tid & 63, w = tid >> 6;
  const float* MOD = (const float*)(p.ws + OFF_MOD);
  bf16_t* H = (bf16_t*)(p.ws + OFF_H);
  float* Y = p.out + OUT_Y;
  const int rstep = gridDim.x * 4;
  float4 nx[4];
  {
    const int row = blockIdx.x * 4 + w;
    if (row < NT) {
#pragma unroll
      for (int i = 0; i < 4; ++i) nx[i] = *(const float4*)(Y + (size_t)row * 1024 + i * 256 + lane * 4); }
  }
  for (int row = blockIdx.x * 4 + w; row < NT; row += rstep) {
    float* yr = Y + (size_t)row * 1024;
    float v[16];
#pragma unroll
    for (int i = 0; i < 4; ++i) { float4 t = nx[i]; v[4 * i] = t.x; v[4 * i + 1] = t.y; v[4 * i + 2] = t.z; v[4 * i + 3] = t.w; }
    if (row + rstep < NT) {
#pragma unroll
      for (int i = 0; i < 4; ++i) nx[i] = *(const float4*)(Y + (size_t)(row + rstep) * 1024 + i * 256 + lane * 4); }
    float s = 0.f;
#pragma unroll
    for (int i = 0; i < 16; ++i) s += v[i];
    float mu = wave_sum(s) * (1.f / 1024.f);
    float q = 0.f;
#pragma unroll
    for (int i = 0; i < 16; ++i) { float d = v[i] - mu; q += d * d; }
    float rstd = rsqrtf(wave_sum(q) * (1.f / 1024.f) + LN_EPS);
    s = 0.f;
#pragma unroll
    for (int i = 0; i < 4; ++i) {
      int c = i * 256 + lane * 4;
      float4 gg = *(const float4*)(P_L1G(p) + c), bb = *(const float4*)(P_L1B(p) + c);
      v[4 * i] = (v[4 * i] - mu) * rstd * gg.x + bb.x; v[4 * i + 1] = (v[4 * i + 1] - mu) * rstd * gg.y + bb.y;
      v[4 * i + 2] = (v[4 * i + 2] - mu) * rstd * gg.z + bb.z; v[4 * i + 3] = (v[4 * i + 3] - mu) * rstd * gg.w + bb.w;
      *(float4*)(yr + c) = make_float4(v[4 * i], v[4 * i + 1], v[4 * i + 2], v[4 * i + 3]);
      s += v[4 * i] + v[4 * i + 1] + v[4 * i + 2] + v[4 * i + 3];
    }
    mu = wave_sum(s) * (1.f / 1024.f);
    q = 0.f;
#pragma unroll
    for (int i = 0; i < 16; ++i) { float d = v[i] - mu; q += d * d; }
    rstd = rsqrtf(wave_sum(q) * (1.f / 1024.f) + LN_EPS);
    const float* mr = MOD + (size_t)mod_row(row) * 6144;
#pragma unroll
    for (int i = 0; i < 4; ++i) {
      int c = i * 256 + lane * 4;
      float4 sh = *(const float4*)(mr + 3072 + c), sc = *(const float4*)(mr + 4096 + c);
      uint2 o;
      o.x = pack2((v[4 * i] - mu) * rstd * (1.f + sc.x) + sh.x, (v[4 * i + 1] - mu) * rstd * (1.f + sc.y) + sh.y);
      o.y = pack2((v[4 * i + 2] - mu) * rstd * (1.f + sc.z) + sh.z, (v[4 * i + 3] - mu) * rstd * (1.f + sc.w) + sh.w);
      *(uint2*)(H + (size_t)row * 1024 + c) = o;
    }
  }
}

__device__ __forceinline__ void phase_H(const Params& p, unsigned char* smem) {
  TID_VARS
  const bf16_t* H = (const bf16_t*)(p.ws + OFF_H);
  const bf16_t* WQ = (const bf16_t*)(p.ws + OFF_WPQ);
  bf16_t* PQ = (bf16_t*)(p.ws + OFF_PQ);
  for (int pc = blockIdx.x; pc < 512; pc += gridDim.x) {
    const int row0 = NP + (pc & 7) * 16, col0 = (pc >> 3) * 32;
    const f32x4 z4 = {0.f, 0.f, 0.f, 0.f};
    f32x4 a2[2] = {z4, z4};
    skinny16x32(H + (size_t)row0 * 1024 + w * 256, 1024, WQ + (size_t)col0 * 1024 + w * 256, 1024, 256, a2[0], a2[1], lane);
    wave4_reduce<2>(a2, smem, w, lane);
    if (w == 0) {
      const int c = col0 + (lane & 15), rr = row0 + (lane >> 4) * 4;
#pragma unroll
      for (int j = 0; j < 4; ++j) {
        PQ[(size_t)(rr + j) * 2048 + c] = f2bf(a2[0][j]);
        PQ[(size_t)(rr + j) * 2048 + c + 16] = f2bf(a2[1][j]);
      }
    }
  }
  for (int q = blockIdx.x >> 3; q < 16 * 16; q += (gridDim.x >> 3)) {
    int mt, nt; xcd_tile(q, 16, mt, nt);
    const int row_base = mt * 128, col_base = nt * 128;
    f32x16 acc[2][2]; ZERO_ACC(acc)
    gemm_gg128(H + (size_t)row_base * 1024, 1024, WQ + (size_t)col_base * 1024, 1024, 1024, smem, acc);
    EPI_QUADS(acc, {
      const int col = col_base + lcol; const int row0 = row_base + lrow0;
      PQ[(size_t)(row0) * 2048 + col] = f2bf(v0); PQ[(size_t)(row0 + 1) * 2048 + col] = f2bf(v1);
      PQ[(size_t)(row0 + 2) * 2048 + col] = f2bf(v2); PQ[(size_t)(row0 + 3) * 2048 + col] = f2bf(v3);
    })
  }
}

__device__ __forceinline__ int f2key(float f) { int b = __float_as_int(f); return b ^ ((b >> 31) & 0x7FFFFFFF); }
__device__ __forceinline__ float key2f(int k) { return __int_as_float(k ^ ((k >> 31) & 0x7FFFFFFF)); }
#define CMPX(a, b) { const int _h = max(a, b), _l = min(a, b); a = _h; b = _l; }
#define SORT16(k, o) { CMPX(k[(o) + 0], k[(o) + 1]) CMPX(k[(o) + 2], k[(o) + 3]) CMPX(k[(o) + 0], k[(o) + 2]) CMPX(k[(o) + 1], k[(o) + 3]) CMPX(k[(o) + 1], k[(o) + 2]) CMPX(k[(o) + 4], k[(o) + 5]) CMPX(k[(o) + 6], k[(o) + 7]) CMPX(k[(o) + 4], k[(o) + 6]) CMPX(k[(o) + 5], k[(o) + 7]) CMPX(k[(o) + 5], k[(o) + 6]) CMPX(k[(o) + 0], k[(o) + 4]) CMPX(k[(o) + 2], k[(o) + 6]) CMPX(k[(o) + 2], k[(o) + 4]) CMPX(k[(o) + 1], k[(o) + 5]) CMPX(k[(o) + 3], k[(o) + 7]) CMPX(k[(o) + 3], k[(o) + 5]) CMPX(k[(o) + 1], k[(o) + 2]) CMPX(k[(o) + 3], k[(o) + 4]) CMPX(k[(o) + 5], k[(o) + 6]) CMPX(k[(o) + 8], k[(o) + 9]) CMPX(k[(o) + 10], k[(o) + 11]) CMPX(k[(o) + 8], k[(o) + 10]) CMPX(k[(o) + 9], k[(o) + 11]) CMPX(k[(o) + 9], k[(o) + 10]) CMPX(k[(o) + 12], k[(o) + 13]) CMPX(k[(o) + 14], k[(o) + 15]) CMPX(k[(o) + 12], k[(o) + 14]) CMPX(k[(o) + 13], k[(o) + 15]) CMPX(k[(o) + 13], k[(o) + 14]) CMPX(k[(o) + 8], k[(o) + 12]) CMPX(k[(o) + 10], k[(o) + 14]) CMPX(k[(o) + 10], k[(o) + 12]) CMPX(k[(o) + 9], k[(o) + 13]) CMPX(k[(o) + 11], k[(o) + 15]) CMPX(k[(o) + 11], k[(o) + 13]) CMPX(k[(o) + 9], k[(o) + 10]) CMPX(k[(o) + 11], k[(o) + 12]) CMPX(k[(o) + 13], k[(o) + 14]) CMPX(k[(o) + 0], k[(o) + 8]) CMPX(k[(o) + 4], k[(o) + 12]) CMPX(k[(o) + 4], k[(o) + 8]) CMPX(k[(o) + 2], k[(o) + 10]) CMPX(k[(o) + 6], k[(o) + 14]) CMPX(k[(o) + 6], k[(o) + 10]) CMPX(k[(o) + 2], k[(o) + 4]) CMPX(k[(o) + 6], k[(o) + 8]) CMPX(k[(o) + 10], k[(o) + 12]) CMPX(k[(o) + 1], k[(o) + 9]) CMPX(k[(o) + 5], k[(o) + 13]) CMPX(k[(o) + 5], k[(o) + 9]) CMPX(k[(o) + 3], k[(o) + 11]) CMPX(k[(o) + 7], k[(o) + 15]) CMPX(k[(o) + 7], k[(o) + 11]) CMPX(k[(o) + 3], k[(o) + 5]) CMPX(k[(o) + 7], k[(o) + 9]) CMPX(k[(o) + 11], k[(o) + 13]) CMPX(k[(o) + 1], k[(o) + 2]) CMPX(k[(o) + 3], k[(o) + 4]) CMPX(k[(o) + 5], k[(o) + 6]) CMPX(k[(o) + 7], k[(o) + 8]) CMPX(k[(o) + 9], k[(o) + 10]) CMPX(k[(o) + 11], k[(o) + 12]) CMPX(k[(o) + 13], k[(o) + 14]) }
#define MERGE16(k, a, b) { k[(a) + 0] = max(k[(a) + 0], k[(b) + 15]); k[(a) + 1] = max(k[(a) + 1], k[(b) + 14]); k[(a) + 2] = max(k[(a) + 2], k[(b) + 13]); k[(a) + 3] = max(k[(a) + 3], k[(b) + 12]); k[(a) + 4] = max(k[(a) + 4], k[(b) + 11]); k[(a) + 5] = max(k[(a) + 5], k[(b) + 10]); k[(a) + 6] = max(k[(a) + 6], k[(b) + 9]); k[(a) + 7] = max(k[(a) + 7], k[(b) + 8]); k[(a) + 8] = max(k[(a) + 8], k[(b) + 7]); k[(a) + 9] = max(k[(a) + 9], k[(b) + 6]); k[(a) + 10] = max(k[(a) + 10], k[(b) + 5]); k[(a) + 11] = max(k[(a) + 11], k[(b) + 4]); k[(a) + 12] = max(k[(a) + 12], k[(b) + 3]); k[(a) + 13] = max(k[(a) + 13], k[(b) + 2]); k[(a) + 14] = max(k[(a) + 14], k[(b) + 1]); k[(a) + 15] = max(k[(a) + 15], k[(b) + 0]); CMPX(k[(a) + 0], k[(a) + 8]) CMPX(k[(a) + 1], k[(a) + 9]) CMPX(k[(a) + 2], k[(a) + 10]) CMPX(k[(a) + 3], k[(a) + 11]) CMPX(k[(a) + 4], k[(a) + 12]) CMPX(k[(a) + 5], k[(a) + 13]) CMPX(k[(a) + 6], k[(a) + 14]) CMPX(k[(a) + 7], k[(a) + 15]) CMPX(k[(a) + 0], k[(a) + 4]) CMPX(k[(a) + 1], k[(a) + 5]) CMPX(k[(a) + 2], k[(a) + 6]) CMPX(k[(a) + 3], k[(a) + 7]) CMPX(k[(a) + 8], k[(a) + 12]) CMPX(k[(a) + 9], k[(a) + 13]) CMPX(k[(a) + 10], k[(a) + 14]) CMPX(k[(a) + 11], k[(a) + 15]) CMPX(k[(a) + 0], k[(a) + 2]) CMPX(k[(a) + 1], k[(a) + 3]) CMPX(k[(a) + 4], k[(a) + 6]) CMPX(k[(a) + 5], k[(a) + 7]) CMPX(k[(a) + 8], k[(a) + 10]) CMPX(k[(a) + 9], k[(a) + 11]) CMPX(k[(a) + 12], k[(a) + 14]) CMPX(k[(a) + 13], k[(a) + 15]) CMPX(k[(a) + 0], k[(a) + 1]) CMPX(k[(a) + 2], k[(a) + 3]) CMPX(k[(a) + 4], k[(a) + 5]) CMPX(k[(a) + 6], k[(a) + 7]) CMPX(k[(a) + 8], k[(a) + 9]) CMPX(k[(a) + 10], k[(a) + 11]) CMPX(k[(a) + 12], k[(a) + 13]) CMPX(k[(a) + 14], k[(a) + 15]) }
#define TOPK_INSERT(top, x) { int _x = (x); _Pragma("unroll") for (int _j = 0; _j < 16; ++_j) { int _hi = max(top[_j], _x); _x = min(top[_j], _x); top[_j] = _hi; } }

__device__ __forceinline__ void phase_I(const Params& p, unsigned char* smem) {
  TID_VARS
  const bf16_t* PQ = (const bf16_t*)(p.ws + OFF_PQ);
  const bf16_t* SK = (const bf16_t*)(p.ws + OFF_SUBK);
  int* IDS = (int*)(p.ws + OFF_IDS); float* GT = (float*)(p.ws + OFF_GATES);
  float* sS = (float*)smem;
  int* sM = (int*)(smem + 66048);
  int* sL = (int*)smem;
  const int n_items = 129 * 8;
  for (int it = blockIdx.x; it < n_items; it += gridDim.x) {
    const int mt = it >> 3, head = it & 7;
    const int row_base = mt * 128;
    const int t = tid & 127, half = tid >> 7;
    int top0[16], top1[16];
#pragma unroll
    for (int pp = 0; pp < 2; ++pp) {
      f32x16 acc[2][2]; ZERO_ACC(acc)
      gemm_gg<false>(PQ + (size_t)row_base * 2048 + head * 256 + pp * 128, 2048, SK + pp * 16384, 128, 128, smem, acc, nullptr);
      __syncthreads();
      EPI_QUADS(acc, {
        sS[(lrow0) * 129 + lcol] = v0; sS[(lrow0 + 1) * 129 + lcol] = v1; sS[(lrow0 + 2) * 129 + lcol] = v2; sS[(lrow0 + 3) * 129 + lcol] = v3;
      })
      __syncthreads();
      int k[64];
      const float* sr = sS + t * 129 + half * 64;
#pragma unroll
      for (int j = 0; j < 64; ++j) k[j] = (f2key(sr[j]) & ~127) | (half * 64 + j);
      SORT16(k, 0) SORT16(k, 16) SORT16(k, 32) SORT16(k, 48)
      MERGE16(k, 0, 16) MERGE16(k, 32, 48) MERGE16(k, 0, 32)
      if (half == 1) {
#pragma unroll
        for (int j = 0; j < 16; ++j) sM[t * 16 + j] = k[j];
      }
      __syncthreads();
      if (half == 0) {
#pragma unroll
        for (int j = 0; j < 16; ++j) k[16 + j] = sM[t * 16 + j];
        MERGE16(k, 0, 16)
      }
      int top[16];
#pragma unroll
      for (int j = 0; j < 16; ++j) top[j] = k[j];
      if (pp == 0) {
#pragma unroll
        for (int j = 0; j < 16; ++j) top0[j] = top[j];
      } else {
#pragma unroll
        for (int j = 0; j < 16; ++j) top1[j] = top[j];
      }
    }
    __syncthreads();
    if (half == 0) {
#pragma unroll
      for (int j = 0; j < 16; ++j) { sL[t * 33 + j] = top0[j] & 127; sL[t * 33 + 16 + j] = top1[j] & 127; }
      float va[16], vb[16];
#pragma unroll
      for (int j = 0; j < 16; ++j) { va[j] = key2f(top0[j] & ~127); vb[j] = key2f(top1[j] & ~127); }
      int k[32];
#define CKEY(i, j) ((f2key(va[i] + vb[j]) & ~255) | ((i) * 16 + (j)))
#pragma unroll
      for (int j = 0; j < 16; ++j) k[j] = CKEY(0, j);
#pragma unroll
      for (int j = 0; j < 16; ++j) k[16 + j] = (j < 8) ? CKEY(1, (j < 8 ? j : 0)) : (int)0x80000000;
      MERGE16(k, 0, 16)
#pragma unroll
      for (int j = 0; j < 16; ++j) k[16 + j] = (j < 5) ? CKEY(2, (j < 5 ? j : 0)) : (int)0x80000000;
      MERGE16(k, 0, 16)
#pragma unroll
      for (int j = 0; j < 16; ++j) k[16 + j] = (j < 4) ? CKEY(3, (j < 4 ? j : 0)) : (int)0x80000000;
      MERGE16(k, 0, 16)
#pragma unroll
      for (int j = 0; j < 16; ++j) k[16 + j] = (j < 3) ? CKEY(4, (j < 3 ? j : 0)) : (int)0x80000000;
      MERGE16(k, 0, 16)
#pragma unroll
      for (int j = 0; j < 16; ++j) k[16 + j] = (j < 2) ? CKEY(5, (j < 2 ? j : 0)) : (int)0x80000000;
      MERGE16(k, 0, 16)
#pragma unroll
      for (int j = 0; j < 16; ++j) k[16 + j] = (j < 2) ? CKEY(6, (j < 2 ? j : 0)) : (int)0x80000000;
      MERGE16(k, 0, 16)
#pragma unroll
      for (int j = 0; j < 16; ++j) k[16 + j] = (j < 2) ? CKEY(7, (j < 2 ? j : 0)) : (int)0x80000000;
      MERGE16(k, 0, 16)
#pragma unroll
      for (int j = 0; j < 16; ++j) k[16 + j] = (j < 8) ? CKEY((j < 8 ? 8 + j : 8), 0) : (int)0x80000000;
      MERGE16(k, 0, 16)
      int best[16];
#pragma unroll
      for (int j = 0; j < 16; ++j) best[j] = k[j];
      float ev[16]; float mx = key2f(best[0] & ~255); float sum = 0.f;
#pragma unroll
      for (int j = 0; j < 16; ++j) { ev[j] = __expf(key2f(best[j] & ~255) - mx); sum += ev[j]; }
      const float inv = 1.f / sum;
      const size_t ob = ((size_t)head * NT + (row_base + t)) * 16;
#pragma unroll
      for (int j = 0; j < 16; ++j) {
        int pr = best[j] & 255;
        int id = sL[t * 33 + (pr >> 4)] * 128 + sL[t * 33 + 16 + (pr & 15)];
        IDS[ob + j] = id; GT[ob + j] = ev[j] * inv;
      }
    }
  }
}

template <int CTRL> __device__ __forceinline__ float dppf(float v) {
  return __int_as_float(__builtin_amdgcn_update_dpp(0, __float_as_int(v), CTRL, 0xF, 0xF, false));
}
__device__ __forceinline__ float reduce16(float v) {
  v += dppf<0xB1>(v);
  v += dppf<0x4E>(v);
  v += dppf<0x141>(v);
  v += dppf<0x140>(v);
  return v;
}
__device__ __forceinline__ unsigned u4c(const uint4& v, int k) { return k == 0 ? v.x : (k == 1 ? v.y : (k == 2 ? v.z : v.w)); }
__device__ __forceinline__ float f4c(const float4& v, int k) { return k == 0 ? v.x : (k == 1 ? v.y : (k == 2 ? v.z : v.w)); }
__device__ __forceinline__ float dot8(const uint4& a, const uint4& h, float s) {
  s = dot2bf(a.x, h.x, s); s = dot2bf(a.y, h.y, s); s = dot2bf(a.z, h.z, s); s = dot2bf(a.w, h.w, s); return s;
}
__device__ __forceinline__ float dot4_fp8(unsigned w, float h0, float h1, float h2, float h3, float s) {
  const f32x2_t lo = __builtin_amdgcn_cvt_pk_f32_fp8((int)w, false), hi = __builtin_amdgcn_cvt_pk_f32_fp8((int)w, true);
  s = fmaf(lo.x, h0, s); s = fmaf(lo.y, h1, s); s = fmaf(hi.x, h2, s); s = fmaf(hi.y, h3, s);
  return s;
}
template <bool COOP>
__device__ __forceinline__ void peer_token(const Params& p, unsigned char* smem, int row, int w, int lane) {
  const int es = lane >> 4, sl = lane & 15;
  const bf16_t* H = (const bf16_t*)(p.ws + OFF_H);
  const unsigned char* PU = p.ws + OFF_PU; const unsigned char* PV = p.ws + OFF_PV;
  const int* IDS = (const int*)(p.ws + OFF_IDS); const float* GT = (const float*)(p.ws + OFF_GATES);
  const float* MOD = (const float*)(p.ws + OFF_MOD);
  float* Y = p.out + OUT_Y;
  int* s_id = (int*)smem + w * 256;
  float* s_cf = (float*)smem + w * 256 + 128;
  float* s_part = (float*)(smem + 8192);
  const int gi_lo = COOP ? 8 * w : 0, gi_n = COOP ? 8 : 32;
  const size_t ia0 = ((size_t)(lane >> 4) * NT + row) * 16 + (lane & 15), ia1 = ((size_t)(4 + (lane >> 4)) * NT + row) * 16 + (lane & 15);
  s_id[lane] = IDS[ia0]; s_id[64 + lane] = IDS[ia1];
  const float g0 = GT[ia0], g1 = GT[ia1];
  float hf[64];
  {
    const uint4* hp = (const uint4*)(H + (size_t)row * 1024);
#pragma unroll
    for (int i = 0; i < 4; ++i) {
#pragma unroll
      for (int k = 0; k < 2; ++k) {
        const uint4 v = hp[(sl + 16 * i) * 2 + k];
        float* f = hf + i * 16 + k * 8;
        f[0] = bflo(v.x); f[1] = bfhi(v.x); f[2] = bflo(v.y); f[3] = bfhi(v.y); f[4] = bflo(v.z); f[5] = bfhi(v.z); f[6] = bflo(v.w); f[7] = bfhi(v.w);
      }
    }
  }
  asm volatile("s_waitcnt lgkmcnt(0)" ::: "memory");
#pragma unroll 4
  for (int q = 0; q < gi_n; ++q) {
    const int gi = gi_lo + q;
    const int id = s_id[32 * es + gi];
    const uint4* up = (const uint4*)(PU + (size_t)id * 1024);
    float s0 = 0.f, s1 = 0.f;
#pragma unroll
    for (int i = 0; i < 4; ++i) {
      const uint4 a = up[sl + 16 * i];
      const float* f = hf + i * 16;
      s0 = dot4_fp8(a.x, f[0], f[1], f[2], f[3], s0); s1 = dot4_fp8(a.y, f[4], f[5], f[6], f[7], s1);
      s0 = dot4_fp8(a.z, f[8], f[9], f[10], f[11], s0); s1 = dot4_fp8(a.w, f[12], f[13], f[14], f[15], s1);
    }
    const float d = reduce16(s0 + s1) * (1.f / 512.f);
    if (sl == 0) s_cf[32 * es + gi] = d;
  }
  asm volatile("s_waitcnt lgkmcnt(0)" ::: "memory");
  {
    const float d0 = s_cf[lane], d1 = s_cf[64 + lane];
    asm volatile("s_waitcnt lgkmcnt(0)" ::: "memory");
    s_cf[lane] = g0 * (0.5f / 64.f) * d0 * (1.f + erff(d0 * 0.7071067811865476f));
    s_cf[64 + lane] = g1 * (0.5f / 64.f) * d1 * (1.f + erff(d1 * 0.7071067811865476f));
    asm volatile("s_waitcnt lgkmcnt(0)" ::: "memory");
  }
  float y[16];
#pragma unroll
  for (int i = 0; i < 16; ++i) y[i] = 0.f;
#pragma unroll 8
  for (int q = 0; q < 4 * gi_n; ++q) {
    const int e = COOP ? (32 * (q & 3) + gi_lo + (q >> 2)) : q;
    const int id = __builtin_amdgcn_readfirstlane(s_id[e]);
    const float ce = __int_as_float(__builtin_amdgcn_readfirstlane(__float_as_int(s_cf[e])));
    const uint4 a = ((const uint4*)(PV + (size_t)id * 1024))[lane];
    const f32x2_t l0 = __builtin_amdgcn_cvt_pk_f32_fp8((int)a.x, false), h0 = __builtin_amdgcn_cvt_pk_f32_fp8((int)a.x, true);
    const f32x2_t l1 = __builtin_amdgcn_cvt_pk_f32_fp8((int)a.y, false), h1 = __builtin_amdgcn_cvt_pk_f32_fp8((int)a.y, true);
    const f32x2_t l2 = __builtin_amdgcn_cvt_pk_f32_fp8((int)a.z, false), h2 = __builtin_amdgcn_cvt_pk_f32_fp8((int)a.z, true);
    const f32x2_t l3 = __builtin_amdgcn_cvt_pk_f32_fp8((int)a.w, false), h3 = __builtin_amdgcn_cvt_pk_f32_fp8((int)a.w, true);
    y[0] += ce * l0.x; y[1] += ce * l0.y; y[2] += ce * h0.x; y[3] += ce * h0.y;
    y[4] += ce * l1.x; y[5] += ce * l1.y; y[6] += ce * h1.x; y[7] += ce * h1.y;
    y[8] += ce * l2.x; y[9] += ce * l2.y; y[10] += ce * h2.x; y[11] += ce * h2.y;
    y[12] += ce * l3.x; y[13] += ce * l3.y; y[14] += ce * h3.x; y[15] += ce * h3.y;
  }
  asm volatile("s_waitcnt lgkmcnt(0)" ::: "memory");
  if (COOP) {
    __syncthreads();
#pragma unroll
    for (int k = 0; k < 4; ++k) *(float4*)(s_part + w * 1024 + lane * 16 + k * 4) = make_float4(y[4 * k], y[4 * k + 1], y[4 * k + 2], y[4 * k + 3]);
    __syncthreads();
    if (w != 0) return;
#pragma unroll
    for (int k = 0; k < 4; ++k) {
      const float4 b1 = *(const float4*)(s_part + 1024 + lane * 16 + k * 4), b2 = *(const float4*)(s_part + 2048 + lane * 16 + k * 4),
                   b3 = *(const float4*)(s_part + 3072 + lane * 16 + k * 4);
      y[4 * k] += b1.x + b2.x + b3.x; y[4 * k + 1] += b1.y + b2.y + b3.y; y[4 * k + 2] += b1.z + b2.z + b3.z; y[4 * k + 3] += b1.w + b2.w + b3.w;
    }
  }
  float* yr = Y + (size_t)row * 1024;
  const float* mr = MOD + (size_t)mod_row(row) * 6144 + 5120;
  float v[16];
  float s = 0.f;
#pragma unroll
  for (int k = 0; k < 4; ++k) {
    const int c = lane * 16 + k * 4;
    const float4 x1 = *(const float4*)(yr + c), g2 = *(const float4*)(mr + c);
    const int o = k * 4;
    v[o] = ALPHA * x1.x + g2.x * y[o]; v[o + 1] = ALPHA * x1.y + g2.y * y[o + 1];
    v[o + 2] = ALPHA * x1.z + g2.z * y[o + 2]; v[o + 3] = ALPHA * x1.w + g2.w * y[o + 3];
    s += v[o] + v[o + 1] + v[o + 2] + v[o + 3];
  }
  const float mu = wave_sum(s) * (1.f / 1024.f);
  float q2 = 0.f;
#pragma unroll
  for (int i = 0; i < 16; ++i) { float d = v[i] - mu; q2 += d * d; }
  const float rstd = rsqrtf(wave_sum(q2) * (1.f / 1024.f) + LN_EPS);
#pragma unroll
  for (int k = 0; k < 4; ++k) {
    const int c = lane * 16 + k * 4;
    const float4 gg = *(const float4*)(P_L2G(p) + c), bb = *(const float4*)(P_L2B(p) + c);
    const int o = k * 4;
    *(float4*)(yr + c) = make_float4((v[o] - mu) * rstd * gg.x + bb.x, (v[o + 1] - mu) * rstd * gg.y + bb.y,
                                     (v[o + 2] - mu) * rstd * gg.z + bb.z, (v[o + 3] - mu) * rstd * gg.w + bb.w);
  }
}
__device__ __forceinline__ void phase_J(const Params& p, unsigned char* smem) {
  const int tid = threadIdx.x, lane = tid & 63, w = tid >> 6;
  const int nw = gridDim.x * 4;
  const int main_rows = (NT / nw) * nw;
  for (int row = blockIdx.x * 4 + w; row < main_rows; row += nw) peer_token<false>(p, smem, row, w, lane);
  __syncthreads();
  for (int row = main_rows + blockIdx.x; row < NT; row += gridDim.x) peer_token<true>(p, smem, row, w, lane);
}

#define XB_TMO      128
#define XB_XCNT(j)  (256  + 64 * (j))
#define XB_XSUB(j)  (1280 + 64 * (j))
#define XB_XGEN(j)  (2304 + 64 * (j))
#define XB_TOP      3328
#define XB_TOPGEN   3392
#define XCD_BAR_WORDS 3456
#define XB_SPIN_CAP (1u << 22)
#define LAS __attribute__((address_space(3)))
__device__ __forceinline__ unsigned xb_ld(unsigned* p)              { return __hip_atomic_load(p, __ATOMIC_RELAXED, __HIP_MEMORY_SCOPE_AGENT); }
__device__ __forceinline__ unsigned xb_add(unsigned* p, unsigned v) { return __hip_atomic_fetch_add(p, v, __ATOMIC_RELAXED, __HIP_MEMORY_SCOPE_AGENT); }
__device__ __forceinline__ unsigned xb_xcc_id() { return (unsigned)__builtin_amdgcn_s_getreg((3 << 11) | 20) & 0xFu; }
#define XB_SPIN(cond, bar) do { unsigned _sp = 0; while (cond) { __builtin_amdgcn_s_sleep(1); \
    if ((++_sp & 255u) == 0u) { if (xb_ld(&(bar)[XB_TMO])) break; if (_sp > XB_SPIN_CAP) { atomicAdd(&(bar)[XB_TMO], 1u); break; } } } } while (0)
struct XcdBarrier { unsigned* bar; unsigned x; volatile LAS unsigned* st; };
__device__ __forceinline__ XcdBarrier xcd_barrier_post(unsigned* bar, volatile LAS unsigned* st) {
    XcdBarrier b; b.bar = bar; b.x = xb_xcc_id(); b.st = st;
    if (threadIdx.x == 0) (void)xb_add(&bar[XB_XCNT(b.x)], 1u);
    return b;
}
__device__ __forceinline__ void xcd_barrier_complete(unsigned* bar, unsigned x, unsigned& nloc, unsigned& nx) {
    const unsigned G = gridDim.x * gridDim.y * gridDim.z;
    unsigned sum, cnt, mine, sp = 0u;
    for (;;) {
        sum = 0u; cnt = 0u; mine = 0u;
#pragma unroll
        for (unsigned j = 0; j < 16; ++j) { const unsigned c = xb_ld(&bar[XB_XCNT(j)]); sum += c; cnt += (c > 0u) ? 1u : 0u; mine = (j == x) ? c : mine; }
        if (sum == G) break;
        __builtin_amdgcn_s_sleep(1);
        if ((++sp & 255u) == 0u) { if (xb_ld(&bar[XB_TMO])) break; if (sp > XB_SPIN_CAP) { atomicAdd(&bar[XB_TMO], 1u); break; } }
    }
    nloc = mine > 0u ? mine : 1u; nx = cnt > 0u ? cnt : 1u;
}
__device__ __forceinline__ void xcd_barrier(const XcdBarrier& b) {
    asm volatile("s_waitcnt vmcnt(0)" ::: "memory");
    __syncthreads();
    if (threadIdx.x == 0) {
        unsigned* bar = b.bar;
        __builtin_amdgcn_s_waitcnt(0);
        unsigned nloc = b.st[0], nx = b.st[1];
        if (nloc == 0u) { xcd_barrier_complete(bar, b.x, nloc, nx); b.st[0] = nloc; b.st[1] = nx; }
        const unsigned old = xb_add(&bar[XB_XSUB(b.x)], 1u);
        const unsigned gen = old / nloc;
        if (old + 1u == (gen + 1u) * nloc) {
            __builtin_amdgcn_fence(__ATOMIC_RELEASE, "agent");
            asm volatile("s_waitcnt vmcnt(0)" ::: "memory");
            const unsigned og = xb_add(&bar[XB_TOP], 1u);
            const unsigned tg = og / nx;
            if (og + 1u == (tg + 1u) * nx) xb_add(&bar[XB_TOPGEN], 1u);
            else XB_SPIN(xb_ld(&bar[XB_TOPGEN]) == tg, bar);
            __builtin_amdgcn_fence(__ATOMIC_ACQUIRE, "agent");
            xb_add(&bar[XB_XGEN(b.x)], 1u);
            asm volatile("s_waitcnt vmcnt(0)" ::: "memory");
        } else {
            XB_SPIN(xb_ld(&bar[XB_XGEN(b.x)]) == gen, bar);
            __builtin_amdgcn_fence(__ATOMIC_ACQUIRE, "agent");
            asm volatile("s_waitcnt vmcnt(0)" ::: "memory");
        }
    }
    __syncthreads();
}
#define gsync(grid) xcd_barrier(xb)
__global__ void __launch_bounds__(256, 2) fwd_megakernel(Params p) {
  cg::grid_group grid = cg::this_grid();
  __shared__ __attribute__((aligned(16))) unsigned char smem[SM_TOTAL];
  __shared__ uint4 xb_words;
  if (threadIdx.x == 0) xb_words = make_uint4(0u, 0u, 0u, 0u);
  __syncthreads();
  XcdBarrier xb = xcd_barrier_post((unsigned*)(p.ws + OFF_BAR), (volatile LAS unsigned*)&xb_words);
  grid.sync();
#ifndef ONLY
#define ONLY 0xFFF
#endif
  if (ONLY & 1) phase_A(p, smem);  gsync(grid);
  if (ONLY & 2) phase_B(p);        gsync(grid);
  if (ONLY & 4) phase_C(p, smem);  gsync(grid);
  if (ONLY & 8) phase_D1(p, smem); gsync(grid);
  if (ONLY & 16) phase_D2(p);       gsync(grid);
  if (ONLY & 32) phase_D3(p, smem); gsync(grid);
  if (ONLY & 64) phase_E(p, smem);  gsync(grid);
  if (ONLY & 128) phase_F(p, smem);  gsync(grid);
  if (ONLY & 256) phase_G(p);        gsync(grid);
  if (ONLY & 512) phase_H(p, smem);  gsync(grid);
  if (ONLY & 1024) phase_I(p, smem);  gsync(grid);
  if (ONLY & 2048) phase_J(p, smem);
}

extern "C" void kernel_launch(void* const* d_in, const int* in_sizes, int n_in, void* d_out,
                              int out_size, void* d_ws, size_t ws_size, hipStream_t stream) {
  static int grid_blocks = 0;
  if (!grid_blocks) {
    int dev = 0, cus = 0, per_cu = 0;
    hipGetDevice(&dev);
    hipDeviceGetAttribute(&cus, hipDeviceAttributeMultiprocessorCount, dev);
    hipOccupancyMaxActiveBlocksPerMultiprocessor(&per_cu, fwd_megakernel, 256, 0);
    if (per_cu > 2) per_cu = 2;
    if (per_cu < 1) per_cu = 1;
    grid_blocks = cus * per_cu;
  }
  if (ws_size < WS_TOTAL) fprintf(stderr, "workspace too small: %zu < %zu\n", ws_size, (size_t)WS_TOTAL);
  Params p{};
  const float* const* in = (const float* const*)d_in;
  p.x_prompt = in[0]; p.x_sample = in[1]; p.c_prompt = in[2]; p.c_sample = in[3];
  p.st_C = in[4]; p.st_n = in[5]; p.st_m = in[6]; p.st_pool = in[7];
  p.w_mod = in[8]; p.b_mod = in[9]; p.w_in = in[10]; p.b_in = in[11]; p.b_fgate = in[12]; p.gn_gain = in[13];
  p.w_pool = in[14]; p.pool_scale = in[15]; p.w_a = in[16]; p.w_b = in[17]; p.w_out = in[18];
  p.ln1_g = in[19]; p.ln1_b = in[20]; p.w_pq = in[21]; p.subkeys = in[22]; p.peer_u = in[23]; p.peer_v = in[24];
  p.ln2_g = in[25]; p.ln2_b = in[26];
  p.out = (float*)d_out; p.ws = (unsigned char*)d_ws;
  hipMemsetAsync((unsigned char*)d_ws + OFF_BAR, 0, 16384, stream);
  void* args[] = {&p};
  hipError_t e = hipLaunchCooperativeKernel((void*)fwd_megakernel, dim3(grid_blocks), dim3(256), args, 0, stream);
  if (e != hipSuccess) fprintf(stderr, "cooperative launch failed: %s (grid %d)\n", hipGetErrorString(e), grid_blocks);
}
```

```cpp
#include <hip/hip_runtime.h>
#include <hip/hip_cooperative_groups.h>
#include <cstdio>
namespace cg = cooperative_groups;

typedef unsigned short bf16_t;
typedef __attribute__((ext_vector_type(8))) short bf16x8;
typedef __attribute__((ext_vector_type(16))) float f32x16;
typedef __attribute__((ext_vector_type(4))) float f32x4;
typedef __attribute__((ext_vector_type(2))) __bf16 bf16x2_t;

#define NT 16512
#define NP 16384
#define DM 1024
#define NIN 4616
#define ALPHA 1.189207115002721f
#define LN_EPS 1e-5f

constexpr size_t OFF_WIN   = 0;
constexpr size_t OFF_WA    = OFF_WIN + 9453568;
constexpr size_t OFF_WB    = OFF_WA + 1048576;
constexpr size_t OFF_WOUT  = OFF_WB + 1048576;
constexpr size_t OFF_WPQ   = OFF_WOUT + 2097152;
constexpr size_t OFF_WPOOL = OFF_WPQ + 4194304;
constexpr size_t OFF_SUBK  = OFF_WPOOL + 131072;
constexpr size_t OFF_PU    = OFF_SUBK + 65536;
constexpr size_t OFF_PV    = OFF_PU + 33554432;
constexpr size_t OFF_MOD   = OFF_PV + 33554432;
constexpr size_t OFF_H     = OFF_MOD + 3342336;
constexpr size_t OFF_Q     = OFF_H + 33816576;
constexpr size_t OFF_K     = OFF_Q + 16908288;
constexpr size_t OFF_V     = OFF_K + 16908288;
constexpr size_t OFF_O     = OFF_V + 16908288;
constexpr size_t OFF_PQ    = OFF_Q;
constexpr size_t OFF_KT    = OFF_O + 16908288;
constexpr size_t OFF_VT    = OFF_KT + 16777216;
constexpr size_t OFF_IDS   = OFF_KT;
constexpr size_t OFF_GATES = OFF_KT + 8454144;
constexpr size_t OFF_IG    = OFF_VT + 16777216;
constexpr size_t OFF_LF    = OFF_IG + 264192;
constexpr size_t OFF_U     = OFF_LF + 264192;
constexpr size_t OFF_CT    = OFF_U;
constexpr size_t OFF_MERGED= OFF_U;
constexpr size_t OFF_CHB   = OFF_U + 33816576;
constexpr size_t OFF_MPREV = OFF_CHB + 65536;
constexpr size_t OFF_NLOC  = OFF_MPREV + 65536;
constexpr size_t OFF_NPREV = OFF_NLOC + 262144;
constexpr size_t OFF_BAR   = OFF_NPREV + 262144;
constexpr size_t OFF_CB    = OFF_BAR + 16384;
constexpr size_t WS_TOTAL  = OFF_CB + 40960;
#define CB_(p) ((const float*)((p).ws + OFF_CB))
#define P_BIN(p) (CB_(p) + 0)
#define P_FG(p)  (CB_(p) + 4624)
#define P_GN(p)  (CB_(p) + 4632)
#define P_PS(p)  (CB_(p) + 5144)
#define P_L1G(p) (CB_(p) + 5656)
#define P_L1B(p) (CB_(p) + 6680)
#define P_L2G(p) (CB_(p) + 7704)
#define P_L2B(p) (CB_(p) + 8728)

constexpr size_t OUT_Y   = 0;
constexpr size_t OUT_CP  = 16908288;
constexpr size_t OUT_NP  = 17432576;
constexpr size_t OUT_MP  = 17436672;
constexpr size_t OUT_PP  = 17436704;
constexpr size_t OUT_CS  = 17498144;
constexpr size_t OUT_NS  = 25886752;
constexpr size_t OUT_MS  = 25952288;
constexpr size_t OUT_PS  = 25952800;
constexpr size_t OUT_SBUF = 0;
constexpr size_t OUT_PB   = 9000000;

#define LS 72
#define LW 136
#define SM_A 0
#define SM_B 18432
#define SM_W 36864
#define SM_MISC 71680
#define SM_TOTAL 75776

struct Params {
  const float *x_prompt, *x_sample, *c_prompt, *c_sample, *st_C, *st_n, *st_m, *st_pool;
  const float *w_mod, *b_mod, *w_in, *b_in, *b_fgate, *gn_gain, *w_pool, *pool_scale, *w_a, *w_b, *w_out;
  const float *ln1_g, *ln1_b, *w_pq, *subkeys, *peer_u, *peer_v, *ln2_g, *ln2_b;
  float* out;
  unsigned char* ws;
};

__device__ __forceinline__ bf16_t f2bf(float f) {
  unsigned u = __float_as_uint(f);
  u += 0x7FFFu + ((u >> 16) & 1u);
  return (bf16_t)(u >> 16);
}
__device__ __forceinline__ float bf2f(bf16_t h) { return __uint_as_float(((unsigned)h) << 16); }
__device__ __forceinline__ unsigned pack2(float a, float b) { return (unsigned)f2bf(a) | ((unsigned)f2bf(b) << 16); }
__device__ __forceinline__ float bflo(unsigned u) { return __uint_as_float(u << 16); }
__device__ __forceinline__ float bfhi(unsigned u) { return __uint_as_float(u & 0xFFFF0000u); }
__device__ __forceinline__ float sigmoidf_(float x) { return 1.f / (1.f + __expf(-x)); }
__device__ __forceinline__ float logsigmoidf_(float x) { return fminf(x, 0.f) - log1pf(__expf(-fabsf(x))); }
__device__ __forceinline__ float wave_sum(float v) {
#pragma unroll
  for (int o = 32; o > 0; o >>= 1) v += __shfl_xor(v, o);
  return v;
}
__device__ __forceinline__ float dot2bf(unsigned a, unsigned b, float acc) {
  return __builtin_amdgcn_fdot2_f32_bf16(__builtin_bit_cast(bf16x2_t, a), __builtin_bit_cast(bf16x2_t, b), acc, false);
}
__device__ __forceinline__ int mod_row(int row) { return row < NP ? (row >> 11) : (8 + row - NP); }
__device__ __forceinline__ const float* x_row(const Params& p, int row) {
  return row < NP ? p.x_prompt + (size_t)row * DM : p.x_sample + (size_t)(row - NP) * DM;
}

typedef __attribute__((ext_vector_type(4))) unsigned u32x4;
struct Stage4 { u32x4 v0, v1, v2, v3; };
__device__ __forceinline__ Stage4 g_load4(const bf16_t* __restrict__ A, int lda, int k0, int tid) {
  const int row = tid >> 3, kc = tid & 7;
  const bf16_t* b = A + (size_t)row * lda + k0 + kc * 8;
  Stage4 r;
  r.v0 = *(const u32x4*)(b);
  r.v1 = *(const u32x4*)(b + (size_t)32 * lda);
  r.v2 = *(const u32x4*)(b + (size_t)64 * lda);
  r.v3 = *(const u32x4*)(b + (size_t)96 * lda);
  return r;
}
__device__ __forceinline__ void s_store4(bf16_t* s, const Stage4& r, int tid) {
  const int row = tid >> 3, kc = tid & 7;
  bf16_t* b = s + row * LS + kc * 8;
  *(u32x4*)(b) = r.v0;
  *(u32x4*)(b + 32 * LS) = r.v1;
  *(u32x4*)(b + 64 * LS) = r.v2;
  *(u32x4*)(b + 96 * LS) = r.v3;
}
__device__ __forceinline__ u32x4 scale8(u32x4 v, const float* f) {
  u32x4 o;
  o.x = pack2(bflo(v.x) * f[0], bfhi(v.x) * f[1]);
  o.y = pack2(bflo(v.y) * f[2], bfhi(v.y) * f[3]);
  o.z = pack2(bflo(v.z) * f[4], bfhi(v.z) * f[5]);
  o.w = pack2(bflo(v.w) * f[6], bfhi(v.w) * f[7]);
  return o;
}
__device__ __forceinline__ void s_store4_scaled(bf16_t* s, const Stage4& r, int tid, const float* ksc) {
  const int row = tid >> 3, kc = tid & 7;
  bf16_t* b = s + row * LS + kc * 8;
  const float* f = ksc + kc * 8;
  *(u32x4*)(b) = scale8(r.v0, f);
  *(u32x4*)(b + 32 * LS) = scale8(r.v1, f);
  *(u32x4*)(b + 64 * LS) = scale8(r.v2, f);
  *(u32x4*)(b + 96 * LS) = scale8(r.v3, f);
}
__device__ __forceinline__ void mma_ktile(const bf16_t* As, int a_stride, const bf16_t* Bs, int b_stride, int nk16,
                                          f32x16 (&acc)[2][2], int wm, int wn, int lane) {
  const int r = lane & 31, h = lane >> 5;
  const bf16_t* ap = As + (wm * 64 + r) * a_stride + h * 8;
  const bf16_t* bp = Bs + (wn * 64 + r) * b_stride + h * 8;
#pragma unroll
  for (int ks = 0; ks < nk16; ++ks) {
    bf16x8 a0 = *(const bf16x8*)(ap + ks * 16);
    bf16x8 a1 = *(const bf16x8*)(ap + 32 * a_stride + ks * 16);
    bf16x8 b0 = *(const bf16x8*)(bp + ks * 16);
    bf16x8 b1 = *(const bf16x8*)(bp + 32 * b_stride + ks * 16);
    acc[0][0] = __builtin_amdgcn_mfma_f32_32x32x16_bf16(a0, b0, acc[0][0], 0, 0, 0);
    acc[0][1] = __builtin_amdgcn_mfma_f32_32x32x16_bf16(a0, b1, acc[0][1], 0, 0, 0);
    acc[1][0] = __builtin_amdgcn_mfma_f32_32x32x16_bf16(a1, b0, acc[1][0], 0, 0, 0);
    acc[1][1] = __builtin_amdgcn_mfma_f32_32x32x16_bf16(a1, b1, acc[1][1], 0, 0, 0);
  }
  __builtin_amdgcn_sched_group_barrier(0x100, 4, 0);
#pragma unroll
  for (int ks = 0; ks + 1 < nk16; ++ks) {
    __builtin_amdgcn_sched_group_barrier(0x008, 1, 0); __builtin_amdgcn_sched_group_barrier(0x100, 1, 0);
    __builtin_amdgcn_sched_group_barrier(0x008, 1, 0); __builtin_amdgcn_sched_group_barrier(0x100, 1, 0);
    __builtin_amdgcn_sched_group_barrier(0x008, 1, 0); __builtin_amdgcn_sched_group_barrier(0x100, 1, 0);
    __builtin_amdgcn_sched_group_barrier(0x008, 1, 0); __builtin_amdgcn_sched_group_barrier(0x100, 1, 0);
  }
  __builtin_amdgcn_sched_group_barrier(0x008, 4, 0);
}
template <bool SCALE_A>
__device__ __forceinline__ void gemm_gg(const bf16_t* __restrict__ A, int lda, const bf16_t* __restrict__ Bt, int ldb, int K,
                                        unsigned char* smem, f32x16 (&acc)[2][2], const float* ksc) {
  const int tid = threadIdx.x, lane = tid & 63, w = tid >> 6, wm = w >> 1, wn = w & 1;
  bf16_t* sA = (bf16_t*)(smem + SM_A);
  bf16_t* sB = (bf16_t*)(smem + SM_B);
  Stage4 ra = g_load4(A, lda, 0, tid);
  Stage4 rb = g_load4(Bt, ldb, 0, tid);
  for (int k0 = 0; k0 < K; k0 += 64) {
    __syncthreads();
    if (SCALE_A) s_store4_scaled(sA, ra, tid, ksc + k0); else s_store4(sA, ra, tid);
    s_store4(sB, rb, tid);
    __syncthreads();
    if (k0 + 64 < K) { ra = g_load4(A, lda, k0 + 64, tid); rb = g_load4(Bt, ldb, k0 + 64, tid); }
    mma_ktile(sA, LS, sB, LS, 4, acc, wm, wn, lane);
  }
}
#define SM_B128 34816
struct Stage8 { u32x4 v0, v1, v2, v3, v4, v5, v6, v7; };
__device__ __forceinline__ Stage8 g_load8(const bf16_t* __restrict__ A, int lda, int k0, int tid) {
  const int row = tid >> 4, kc = tid & 15;
  const bf16_t* b = A + (size_t)row * lda + k0 + kc * 8;
  Stage8 r;
  r.v0 = *(const u32x4*)(b);
  r.v1 = *(const u32x4*)(b + (size_t)16 * lda);
  r.v2 = *(const u32x4*)(b + (size_t)32 * lda);
  r.v3 = *(const u32x4*)(b + (size_t)48 * lda);
  r.v4 = *(const u32x4*)(b + (size_t)64 * lda);
  r.v5 = *(const u32x4*)(b + (size_t)80 * lda);
  r.v6 = *(const u32x4*)(b + (size_t)96 * lda);
  r.v7 = *(const u32x4*)(b + (size_t)112 * lda);
  return r;
}
__device__ __forceinline__ void s_store8(bf16_t* s, const Stage8& r, int tid) {
  const int row = tid >> 4, kc = tid & 15;
  bf16_t* b = s + row * LW + kc * 8;
  *(u32x4*)(b) = r.v0;
  *(u32x4*)(b + 16 * LW) = r.v1;
  *(u32x4*)(b + 32 * LW) = r.v2;
  *(u32x4*)(b + 48 * LW) = r.v3;
  *(u32x4*)(b + 64 * LW) = r.v4;
  *(u32x4*)(b + 80 * LW) = r.v5;
  *(u32x4*)(b + 96 * LW) = r.v6;
  *(u32x4*)(b + 112 * LW) = r.v7;
}
__device__ __forceinline__ void gemm_gg128(const bf16_t* __restrict__ A, int lda, const bf16_t* __restrict__ Bt, int ldb, int K,
                                           unsigned char* smem, f32x16 (&acc)[2][2]) {
  const int tid = threadIdx.x, lane = tid & 63, w = tid >> 6, wm = w >> 1, wn = w & 1;
  bf16_t* sA = (bf16_t*)(smem);
  bf16_t* sB = (bf16_t*)(smem + SM_B128);
  Stage8 ra = g_load8(A, lda, 0, tid);
  Stage8 rb = g_load8(Bt, ldb, 0, tid);
  for (int k0 = 0; k0 < K; k0 += 128) {
    __syncthreads();
    s_store8(sA, ra, tid);
    s_store8(sB, rb, tid);
    __syncthreads();
    if (k0 + 128 < K) { ra = g_load8(A, lda, k0 + 128, tid); rb = g_load8(Bt, ldb, k0 + 128, tid); }
    mma_ktile(sA, LW, sB, LW, 8, acc, wm, wn, lane);
  }
}
__device__ __forceinline__ void gemm_sg(const bf16_t* sW, const bf16_t* __restrict__ Bt, int ldb, int K,
                                        unsigned char* smem, f32x16 (&acc)[2][2]) {
  const int tid = threadIdx.x, lane = tid & 63, w = tid >> 6, wm = w >> 1, wn = w & 1;
  bf16_t* sB = (bf16_t*)(smem + SM_B);
  Stage4 rb = g_load4(Bt, ldb, 0, tid);
  for (int k0 = 0; k0 < K; k0 += 64) {
    __syncthreads();
    s_store4(sB, rb, tid);
    __syncthreads();
    if (k0 + 64 < K) rb = g_load4(Bt, ldb, k0 + 64, tid);
    mma_ktile(sW + k0, LW, sB, LS, 4, acc, wm, wn, lane);
  }
}
#define ZERO_ACC(acc) _Pragma("unroll") for (int _i = 0; _i < 2; ++_i) _Pragma("unroll") for (int _j = 0; _j < 2; ++_j) _Pragma("unroll") for (int _r = 0; _r < 16; ++_r) acc[_i][_j][_r] = 0.f;

#define EPI_QUADS(acc, ...)                                                       \
  _Pragma("unroll") for (int mi = 0; mi < 2; ++mi)                                \
  _Pragma("unroll") for (int ni = 0; ni < 2; ++ni)                                \
  _Pragma("unroll") for (int g = 0; g < 4; ++g) {                                 \
    const int lrow0 = wm * 64 + mi * 32 + 8 * g + 4 * (lane >> 5);                \
    const int lcol = wn * 64 + ni * 32 + (lane & 31);                             \
    const float v0 = acc[mi][ni][4 * g], v1 = acc[mi][ni][4 * g + 1];             \
    const float v2 = acc[mi][ni][4 * g + 2], v3 = acc[mi][ni][4 * g + 3];         \
    (void)v0; (void)v1; (void)v2; (void)v3; (void)lrow0; (void)lcol;              \
    __VA_ARGS__ }

__device__ __forceinline__ void skinny16x32(const bf16_t* __restrict__ A, int lda, const bf16_t* __restrict__ Bt, int ldb, int K,
                                            f32x4& c0, f32x4& c1, int lane) {
  const int r = lane & 15, q = lane >> 4;
  const bf16_t* ap = A + (size_t)r * lda + q * 8;
  const bf16_t* bp0 = Bt + (size_t)r * ldb + q * 8;
  const bf16_t* bp1 = Bt + (size_t)(16 + r) * ldb + q * 8;
#pragma unroll 8
  for (int k0 = 0; k0 < K; k0 += 32) {
    const bf16x8 a = *(const bf16x8*)(ap + k0);
    const bf16x8 b0 = *(const bf16x8*)(bp0 + k0);
    const bf16x8 b1 = *(const bf16x8*)(bp1 + k0);
    c0 = __builtin_amdgcn_mfma_f32_16x16x32_bf16(a, b0, c0, 0, 0, 0);
    c1 = __builtin_amdgcn_mfma_f32_16x16x32_bf16(a, b1, c1, 0, 0, 0);
  }
}

template <int NACC>
__device__ __forceinline__ void wave4_reduce(f32x4 (&a)[NACC], unsigned char* smem, int w, int lane) {
  float* red = (float*)smem;
  __syncthreads();
#pragma unroll
  for (int i = 0; i < NACC; ++i)
#pragma unroll
    for (int j = 0; j < 4; ++j) red[((w * NACC + i) * 4 + j) * 64 + lane] = a[i][j];
  __syncthreads();
  if (w == 0) {
#pragma unroll
    for (int i = 0; i < NACC; ++i)
#pragma unroll
      for (int j = 0; j < 4; ++j)
        a[i][j] = red[((0 * NACC + i) * 4 + j) * 64 + lane] + red[((1 * NACC + i) * 4 + j) * 64 + lane] +
                  red[((2 * NACC + i) * 4 + j) * 64 + lane] + red[((3 * NACC + i) * 4 + j) * 64 + lane];
  }
}

__device__ __forceinline__ void xcd_tile(int q, int NN, int& mt, int& nt) {
  const int x = blockIdx.x & 7, npan = NN >> 3, p = q >> 6, wi = q & 63;
  mt = x * 16 + (p / npan) * 8 + (wi >> 3);
  nt = (p % npan) * 8 + (wi & 7);
}

#define TID_VARS const int tid = threadIdx.x, lane = tid & 63, w = tid >> 6, wm = w >> 1, wn = w & 1; (void)lane; (void)wm; (void)wn;

template <bool REMAP>
__device__ __forceinline__ void transpose_tile(const float* __restrict__ src, int K, int N, bf16_t* __restrict__ dst,
                                               int kt, int nt, unsigned char* smem) {
  float* sm = (float*)smem;
  const int tid = threadIdx.x; const int k0 = kt * 64, n0 = nt * 64;
  __syncthreads();
#pragma unroll
  for (int ib = 0; ib < 16; ib += 8) {
    float tv[8];
#pragma unroll
    for (int i = 0; i < 8; ++i) {
      int idx = tid + 256 * (ib + i); int r = idx >> 6, c = idx & 63; int n = n0 + c;
      tv[i] = (n < N) ? src[(size_t)(k0 + r) * N + n] : 0.f;
    }
#pragma unroll
    for (int i = 0; i < 8; ++i) {
      int idx = tid + 256 * (ib + i); int r = idx >> 6, c = idx & 63;
      sm[r * 65 + c] = tv[i];
    }
  }
  __syncthreads();
#pragma unroll 4
  for (int i = 0; i < 8; ++i) {
    int idx = tid + 256 * i; int r = idx >> 5, cp = idx & 31; int n = n0 + r;
    int nd = n;
    if (REMAP) { if (n >= 2048 && n < 2056) nd = n + 512; else if (n >= 2056 && n < 2568) nd = n - 8; }
    if (n < N) *(unsigned*)(dst + (size_t)nd * K + k0 + 2 * cp) = pack2(sm[(2 * cp) * 65 + r], sm[(2 * cp + 1) * 65 + r]);
  }
}
__device__ __forceinline__ void convert_chunk(const float* __restrict__ src, bf16_t* __restrict__ dst, size_t base) {
  const int tid = threadIdx.x;
#pragma unroll
  for (int i = 0; i < 8; ++i) {
    size_t e = base + (size_t)(tid + 256 * i) * 8;
    float4 a = *(const float4*)(src + e), b = *(const float4*)(src + e + 4);
    uint4 o; o.x = pack2(a.x, a.y); o.y = pack2(a.z, a.w); o.z = pack2(b.x, b.y); o.w = pack2(b.z, b.w);
    *(uint4*)(dst + e) = o;
  }
}
typedef __attribute__((ext_vector_type(2))) float f32x2_t;
__device__ __forceinline__ unsigned pack4_fp8(float a, float b, float c, float d) {
  int r = __builtin_amdgcn_cvt_pk_fp8_f32(a, b, 0, false);
  r = __builtin_amdgcn_cvt_pk_fp8_f32(c, d, r, true);
  return (unsigned)r;
}
__device__ __forceinline__ void convert_chunk_fp8(const float* __restrict__ src, unsigned char* __restrict__ dst, size_t base, float scale) {
  const int tid = threadIdx.x;
#pragma unroll
  for (int i = 0; i < 4; ++i) {
    size_t e = base + (size_t)(tid + 256 * i) * 16;
    float4 a = *(const float4*)(src + e), b = *(const float4*)(src + e + 4), c = *(const float4*)(src + e + 8), d = *(const float4*)(src + e + 12);
    uint4 o;
    o.x = pack4_fp8(a.x * scale, a.y * scale, a.z * scale, a.w * scale);
    o.y = pack4_fp8(b.x * scale, b.y * scale, b.z * scale, b.w * scale);
    o.z = pack4_fp8(c.x * scale, c.y * scale, c.z * scale, c.w * scale);
    o.w = pack4_fp8(d.x * scale, d.y * scale, d.z * scale, d.w * scale);
    *(uint4*)(dst + e) = o;
  }
}
__device__ __forceinline__ void mod_slab(const Params& p, int item, unsigned char* smem) {
  const int tid = threadIdx.x, lane = tid & 63, w = tid >> 6;
  const int n0 = item * 16, nl = lane & 15, kq = lane >> 4;
  f32x4 acc[9];
#pragma unroll
  for (int i = 0; i < 9; ++i) acc[i] = (f32x4){0.f, 0.f, 0.f, 0.f};
  for (int ks = 0; ks < 8; ++ks) {
    const int kb = w * 256 + ks * 32 + kq * 8;
    bf16x8 b;
#pragma unroll
    for (int j = 0; j < 8; ++j) b[j] = (short)f2bf(p.w_mod[(size_t)(kb + j) * 6144 + n0 + nl]);
#pragma unroll
    for (int mi = 0; mi < 9; ++mi) {
      int row = mi * 16 + nl; if (row > 135) row = 135;
      const float* cp = (row < 8) ? p.c_prompt + row * 1024 : p.c_sample + (row - 8) * 1024;
      float4 x0 = *(const float4*)(cp + kb), x1 = *(const float4*)(cp + kb + 4);
      bf16x8 a;
      a[0] = (short)f2bf(x0.x * sigmoidf_(x0.x)); a[1] = (short)f2bf(x0.y * sigmoidf_(x0.y));
      a[2] = (short)f2bf(x0.z * sigmoidf_(x0.z)); a[3] = (short)f2bf(x0.w * sigmoidf_(x0.w));
      a[4] = (short)f2bf(x1.x * sigmoidf_(x1.x)); a[5] = (short)f2bf(x1.y * sigmoidf_(x1.y));
      a[6] = (short)f2bf(x1.z * sigmoidf_(x1.z)); a[7] = (short)f2bf(x1.w * sigmoidf_(x1.w));
      acc[mi] = __builtin_amdgcn_mfma_f32_16x16x32_bf16(a, b, acc[mi], 0, 0, 0);
    }
  }
  float* red = (float*)smem;
  __syncthreads();
#pragma unroll
  for (int mi = 0; mi < 9; ++mi)
#pragma unroll
    for (int r = 0; r < 4; ++r) red[(w * 36 + mi * 4 + r) * 64 + lane] = acc[mi][r];
  __syncthreads();
  float* MOD = (float*)(p.ws + OFF_MOD);
  for (int i = 0; i < 9; ++i) {
    int idx = tid + 256 * i; int e = idx >> 6, l = idx & 63;
    float s = red[(0 * 36 + e) * 64 + l] + red[(1 * 36 + e) * 64 + l] + red[(2 * 36 + e) * 64 + l] + red[(3 * 36 + e) * 64 + l];
    int mi = e >> 2, r = e & 3; int row = mi * 16 + (l >> 4) * 4 + r; int col = n0 + (l & 15);
    if (row < 136) MOD[(size_t)row * 6144 + col] = s + p.b_mod[col];
  }
}
__device__ __forceinline__ void phase_A(const Params& p, unsigned char* smem) {
  const int n_items = 384 + 1168 + 128 + 128 + 256 + 512 + 16 + 1024 + 1024 + 2 + 128 + 1;
  for (int it = blockIdx.x; it < n_items; it += gridDim.x) {
    int i = it;
    if (i == n_items - 1) {
      float* cb = (float*)(p.ws + OFF_CB);
      const int tid = threadIdx.x;
      for (int k = tid; k < 4616; k += 256) cb[k] = p.b_in[k];
      if (tid < 4) cb[4624 + tid] = p.b_fgate[tid];
      for (int k = tid; k < 512; k += 256) { cb[4632 + k] = p.gn_gain[k]; cb[5144 + k] = p.pool_scale[k]; }
      for (int k = tid; k < 1024; k += 256) { cb[5656 + k] = p.ln1_g[k]; cb[6680 + k] = p.ln1_b[k]; cb[7704 + k] = p.ln2_g[k]; cb[8728 + k] = p.ln2_b[k]; }
      continue;
    }
    if (i < 384) { mod_slab(p, i, smem); continue; } i -= 384;
    if (i < 1168) { transpose_tile<true>(p.w_in, 1024, NIN, (bf16_t*)(p.ws + OFF_WIN), i / 73, i % 73, smem); continue; } i -= 1168;
    if (i < 128) { transpose_tile<false>(p.w_a, 512, 1024, (bf16_t*)(p.ws + OFF_WA), i / 16, i % 16, smem); continue; } i -= 128;
    if (i < 128) { transpose_tile<false>(p.w_b, 512, 1024, (bf16_t*)(p.ws + OFF_WB), i / 16, i % 16, smem); continue; } i -= 128;
    if (i < 256) { transpose_tile<false>(p.w_out, 1024, 1024, (bf16_t*)(p.ws + OFF_WOUT), i / 16, i % 16, smem); continue; } i -= 256;
    if (i < 512) { transpose_tile<false>(p.w_pq, 1024, 2048, (bf16_t*)(p.ws + OFF_WPQ), i / 32, i % 32, smem); continue; } i -= 512;
    if (i < 16) { int g = i >> 2, r = i & 3;
      transpose_tile<false>(p.w_pool + g * 16384, 128, 128, (bf16_t*)(p.ws + OFF_WPOOL) + g * 16384, r >> 1, r & 1, smem); continue; } i -= 16;
    if (i < 1024) { convert_chunk_fp8(p.peer_u, p.ws + OFF_PU, (size_t)i * 16384, 512.f); continue; } i -= 1024;
    if (i < 1024) { convert_chunk_fp8(p.peer_v, p.ws + OFF_PV, (size_t)i * 16384, 64.f); continue; } i -= 1024;
    if (i < 2) { convert_chunk(p.subkeys, (bf16_t*)(p.ws + OFF_SUBK), (size_t)i * 16384); continue; } i -= 2;
    {
      const float4* src = (const float4*)(p.st_pool + (size_t)i * 7680 + 512);
      float4* dst = (float4*)(p.out + OUT_PS + (size_t)i * 7680);
#pragma unroll
      for (int k = 0; k < 7; ++k) dst[threadIdx.x + 256 * k] = src[threadIdx.x + 256 * k];
    }
  }
}

__device__ __forceinline__ void phase_B(const Params& p) {
  const int tid = threadIdx.x, lane = tid & 63, w = tid >> 6;
  const float* MOD = (const float*)(p.ws + OFF_MOD);
  bf16_t* H = (bf16_t*)(p.ws + OFF_H);
  for (int row = blockIdx.x * 4 + w; row < NT; row += gridDim.x * 4) {
    const float* xr = x_row(p, row);
    float4 v[4];
#pragma unroll
    for (int i = 0; i < 4; ++i) v[i] = *(const float4*)(xr + i * 256 + lane * 4);
    float s = 0.f;
#pragma unroll
    for (int i = 0; i < 4; ++i) s += v[i].x + v[i].y + v[i].z + v[i].w;
    float mu = wave_sum(s) * (1.f / 1024.f);
    float q = 0.f;
#pragma unroll
    for (int i = 0; i < 4; ++i) { float a = v[i].x - mu, b = v[i].y - mu, c = v[i].z - mu, d = v[i].w - mu; q += a * a + b * b + c * c + d * d; }
    float rstd = rsqrtf(wave_sum(q) * (1.f / 1024.f) + LN_EPS);
    const float* mr = MOD + (size_t)mod_row(row) * 6144;
#pragma unroll
    for (int i = 0; i < 4; ++i) {
      int c = i * 256 + lane * 4;
      float4 sh = *(const float4*)(mr + c), sc = *(const float4*)(mr + 1024 + c);
      uint2 o;
      o.x = pack2((v[i].x - mu) * rstd * (1.f + sc.x) + sh.x, (v[i].y - mu) * rstd * (1.f + sc.y) + sh.y);
      o.y = pack2((v[i].z - mu) * rstd * (1.f + sc.z) + sh.z, (v[i].w - mu) * rstd * (1.f + sc.w) + sh.w);
      *(uint2*)(H + (size_t)row * 1024 + c) = o;
    }
  }
}

__device__ __forceinline__ void phase_C(const Params& p, unsigned char* smem) {
  TID_VARS
  const bf16_t* H = (const bf16_t*)(p.ws + OFF_H);
  const bf16_t* WT = (const bf16_t*)(p.ws + OFF_WIN);
  bf16_t* Q = (bf16_t*)(p.ws + OFF_Q); bf16_t* Kb = (bf16_t*)(p.ws + OFF_K); bf16_t* V = (bf16_t*)(p.ws + OFF_V);
  bf16_t* O = (bf16_t*)(p.ws + OFF_O); bf16_t* KT = (bf16_t*)(p.ws + OFF_KT); bf16_t* VT = (bf16_t*)(p.ws + OFF_VT);
  float* IG = (float*)(p.ws + OFF_IG); float* LF = (float*)(p.ws + OFF_LF); float* U = (float*)(p.ws + OFF_U);
  const int n_items = 129 * 21;
  for (int it = blockIdx.x; it < n_items; it += gridDim.x) {
    const int mt = it / 21, nt = it % 21;
    f32x16 acc[2][2]; ZERO_ACC(acc)
    gemm_gg128(H + (size_t)mt * 128 * 1024, 1024, WT + (size_t)nt * 128 * 1024, 1024, 1024, smem, acc);
    const int row_base = mt * 128, col_base = nt * 128;
    if (nt < 16) {
      const int sect = nt >> 2;
      const int hh = nt & 3;
      EPI_QUADS(acc, {
        const int col = col_base + lcol; const float bias = P_BIN(p)[col];
        const int c512 = col & 511; const int row0 = row_base + lrow0;
        float a0 = v0 + bias, a1 = v1 + bias, a2 = v2 + bias, a3 = v3 + bias;
        if (sect == 0) {
          Q[(size_t)(row0) * 512 + c512] = f2bf(a0); Q[(size_t)(row0 + 1) * 512 + c512] = f2bf(a1);
          Q[(size_t)(row0 + 2) * 512 + c512] = f2bf(a2); Q[(size_t)(row0 + 3) * 512 + c512] = f2bf(a3);
        } else if (sect == 1) {
          const float sc = 0.08838834764831845f;
          a0 *= sc; a1 *= sc; a2 *= sc; a3 *= sc;
          Kb[(size_t)(row0) * 512 + c512] = f2bf(a0); Kb[(size_t)(row0 + 1) * 512 + c512] = f2bf(a1);
          Kb[(size_t)(row0 + 2) * 512 + c512] = f2bf(a2); Kb[(size_t)(row0 + 3) * 512 + c512] = f2bf(a3);
          if (mt < 128) {
            const int b = mt >> 4, t = (mt & 15) * 128 + lrow0;
            uint2 o; o.x = pack2(a0, a1); o.y = pack2(a2, a3);
            *(uint2*)(KT + ((size_t)((b * 4 + hh) * 128 + (c512 & 127))) * 2048 + t) = o;
          }
        } else if (sect == 2) {
          if (mt >= 128) {
            V[(size_t)(row0) * 512 + c512] = f2bf(a0); V[(size_t)(row0 + 1) * 512 + c512] = f2bf(a1);
            V[(size_t)(row0 + 2) * 512 + c512] = f2bf(a2); V[(size_t)(row0 + 3) * 512 + c512] = f2bf(a3);
          }
          if (mt < 128) {
            const int b = mt >> 4, t = (mt & 15) * 128 + lrow0;
            uint2 o; o.x = pack2(a0, a1); o.y = pack2(a2, a3);
            *(uint2*)(VT + ((size_t)((b * 4 + hh) * 128 + (c512 & 127))) * 2048 + t) = o;
          }
        } else {
          O[(size_t)(row0) * 512 + c512] = f2bf(sigmoidf_(a0)); O[(size_t)(row0 + 1) * 512 + c512] = f2bf(sigmoidf_(a1));
          O[(size_t)(row0 + 2) * 512 + c512] = f2bf(sigmoidf_(a2)); O[(size_t)(row0 + 3) * 512 + c512] = f2bf(sigmoidf_(a3));
        }
      })
    } else if (nt < 20) {
      EPI_QUADS(acc, {
        const int uc = (nt - 16) * 128 + lcol; const int row0 = row_base + lrow0;
        const float bias = P_BIN(p)[2056 + uc];
        U[(size_t)(row0) * 512 + uc] = v0 + bias; U[(size_t)(row0 + 1) * 512 + uc] = v1 + bias;
        U[(size_t)(row0 + 2) * 512 + uc] = v2 + bias; U[(size_t)(row0 + 3) * 512 + uc] = v3 + bias;
      })
    } else {
      EPI_QUADS(acc, {
        const int row0 = row_base + lrow0;
        if (lcol < 4) {
          const float bias = P_BIN(p)[2048 + lcol];
          IG[(size_t)(row0) * 4 + lcol] = v0 + bias; IG[(size_t)(row0 + 1) * 4 + lcol] = v1 + bias;
          IG[(size_t)(row0 + 2) * 4 + lcol] = v2 + bias; IG[(size_t)(row0 + 3) * 4 + lcol] = v3 + bias;
        } else if (lcol < 8) {
          const int hh = lcol - 4; const float bias = P_BIN(p)[2052 + hh] + P_FG(p)[hh];
          LF[(size_t)(row0) * 4 + hh] = logsigmoidf_(v0 + bias); LF[(size_t)(row0 + 1) * 4 + hh] = logsigmoidf_(v1 + bias);
          LF[(size_t)(row0 + 2) * 4 + hh] = logsigmoidf_(v2 + bias); LF[(size_t)(row0 + 3) * 4 + hh] = logsigmoidf_(v3 + bias);
        }
      })
    }
  }
}

__device__ __forceinline__ void d1_prompt_chunk(const Params& p, int item, unsigned char* smem) {
  TID_VARS
  const int bh = item >> 4, c = item & 15, b = bh >> 2, h = bh & 3;
  const int r0 = b * 2048 + c * 128;
  float* misc = (float*)(smem + SM_MISC);
  float* s_lf = misc, *s_ig = misc + 128, *s_b = misc + 256, *s_g = misc + 384, *s_d = misc + 512;
  const float* IG = (const float*)(p.ws + OFF_IG); const float* LF = (const float*)(p.ws + OFF_LF);
  __syncthreads();
  if (tid < 128) { s_lf[tid] = LF[(size_t)(r0 + tid) * 4 + h]; s_ig[tid] = IG[(size_t)(r0 + tid) * 4 + h]; }
  __syncthreads();
  if (tid < 128) { float a = 0.f; for (int j = 0; j <= tid; ++j) a += s_lf[j]; s_b[tid] = a; }
  __syncthreads();
  const float Btot = s_b[127];
  if (tid < 128) s_g[tid] = Btot - s_b[tid] + s_ig[tid];
  __syncthreads();
  float amax = -3.0e38f;
  for (int j = 0; j < 128; ++j) amax = fmaxf(amax, s_g[j]);
  if (tid < 128) s_d[tid] = __expf(s_g[tid] - amax);
  if (tid == 0) { ((float*)(p.ws + OFF_CHB))[item * 32] = Btot; ((float*)(p.ws + OFF_CHB))[item * 32 + 1] = amax; }
  __syncthreads();
  const bf16_t* KT = (const bf16_t*)(p.ws + OFF_KT) + (size_t)bh * 128 * 2048 + c * 128;
  const bf16_t* VT = (const bf16_t*)(p.ws + OFF_VT) + (size_t)bh * 128 * 2048 + c * 128;
  if (tid < 128) {
    const uint4* kr = (const uint4*)(KT + (size_t)tid * 2048);
    float a = 0.f;
#pragma unroll 4
    for (int j = 0; j < 16; ++j) {
      uint4 v = kr[j]; const float* d = s_d + j * 8;
      a += bflo(v.x) * d[0] + bfhi(v.x) * d[1] + bflo(v.y) * d[2] + bfhi(v.y) * d[3] + bflo(v.z) * d[4] + bfhi(v.z) * d[5] + bflo(v.w) * d[6] + bfhi(v.w) * d[7];
    }
    ((float*)(p.ws + OFF_NLOC))[(size_t)item * 128 + tid] = a;
  }
  f32x16 acc[2][2]; ZERO_ACC(acc)
  gemm_gg<true>(VT, 2048, KT, 2048, 128, smem, acc, s_d);
  float* SB = p.out + OUT_SBUF + (size_t)item * 16384;
  EPI_QUADS(acc, {
    SB[(size_t)(lrow0) * 128 + lcol] = v0; SB[(size_t)(lrow0 + 1) * 128 + lcol] = v1;
    SB[(size_t)(lrow0 + 2) * 128 + lcol] = v2; SB[(size_t)(lrow0 + 3) * 128 + lcol] = v3;
  })
}
__device__ __forceinline__ void d1_sample_step(const Params& p, int item, unsigned char* smem) {
  const int tid = threadIdx.x;
  const int s = item >> 2, h = item & 3, row = NP + s;
  float* misc = (float*)(smem + SM_MISC);
  float* s_q = misc, *s_k = misc + 128, *s_red = misc + 256, *s_num = misc + 512  , *s_h = misc + 768  ;
  bf16_t* Q = (bf16_t*)(p.ws + OFF_Q); const bf16_t* Kb = (const bf16_t*)(p.ws + OFF_K); const bf16_t* V = (const bf16_t*)(p.ws + OFF_V);
  const bf16_t* O = (const bf16_t*)(p.ws + OFF_O);
  __syncthreads();
  if (tid < 128) { s_q[tid] = bf2f(Q[(size_t)row * 512 + h * 128 + tid]); s_k[tid] = bf2f(Kb[(size_t)row * 512 + h * 128 + tid]); }
  else {
    const int c = tid - 128, g = h, wlen = 2 << g;
    const float ut = ((const float*)(p.ws + OFF_U))[(size_t)row * 512 + g * 128 + c];
    const float* __restrict__ pre = p.st_pool + (size_t)s * 15 * 512 + g * 128 + c;
    float sum = ut;
    for (int q = 1; q < wlen; ++q) sum += pre[(size_t)(15 - q) * 512];
    s_red[c] = sum / (float)wlen - ut;
    p.out[OUT_PS + ((size_t)s * 15 + 14) * 512 + g * 128 + c] = ut;
  }
  __syncthreads();
  {
    const int d = tid & 127, ch = tid >> 7, g = h;
    const float* __restrict__ wp = p.w_pool + (size_t)g * 16384 + (size_t)(ch * 64) * 128 + d;
    float a = 0.f;
#pragma unroll
    for (int cb = 0; cb < 64; cb += 16) {
      float wv[16];
#pragma unroll
      for (int j = 0; j < 16; ++j) wv[j] = wp[(size_t)(cb + j) * 128];
#pragma unroll
      for (int j = 0; j < 16; ++j) a += s_red[ch * 64 + cb + j] * wv[j];
    }
    s_num[tid] = a;
    __syncthreads();
    if (tid < 128) ((bf16_t*)(p.out + OUT_PB))[(size_t)row * 512 + g * 128 + tid] = f2bf((s_num[tid] + s_num[tid + 128]) * P_PS(p)[g * 128 + tid]);
    __syncthreads();
  }
  const float ig = ((const float*)(p.ws + OFF_IG))[(size_t)row * 4 + h];
  const float lf = ((const float*)(p.ws + OFF_LF))[(size_t)row * 4 + h];
  const float m0 = p.st_m[s * 4 + h];
  const float* n0 = p.st_n + (size_t)(s * 4 + h) * 128;
  float qk = 0.f, qn = 0.f;
#pragma unroll 4
  for (int j = 0; j < 128; ++j) { qk += s_q[j] * s_k[j]; qn += s_q[j] * n0[j]; }
  const float log_g = lf + m0;
  const float mt = fmaxf(log_g, ig);
  const float wq = __expf(ig - mt) * qk;
  const float wst = __expf(log_g - mt);
  const float dcs = __expf(ig - mt);
  const float dcc = __expf(lf + m0 - mt);
  const int dv = tid & 127, half = tid >> 7;
  const float vv = bf2f(V[(size_t)row * 512 + h * 128 + dv]);
  const float* __restrict__ C0 = p.st_C + (size_t)(s * 4 + h) * 16384;
  float* __restrict__ Cn = p.out + OUT_CS + (size_t)(s * 4 + h) * 16384;
  float part = 0.f;
#pragma unroll
  for (int jb = 0; jb < 64; jb += 16) {
    float c0v[16];
#pragma unroll
    for (int j = 0; j < 16; ++j) c0v[j] = C0[(half * 64 + jb + j) * 128 + dv];
#pragma unroll
    for (int j = 0; j < 16; ++j) {
      const int dk = half * 64 + jb + j;
      part += s_q[dk] * c0v[j];
      Cn[dk * 128 + dv] = dcc * c0v[j] + dcs * s_k[dk] * vv;
    }
  }
  s_num[tid] = part;
  if (tid < 128) p.out[OUT_NS + (size_t)(s * 4 + h) * 128 + tid] = dcc * n0[tid] + dcs * s_k[tid];
  if (tid == 0) p.out[OUT_MS + s * 4 + h] = mt;
  __syncthreads();
  if (tid < 128) {
    float num = wq * vv + wst * (s_num[tid] + s_num[tid + 128]);
    float den = wq + wst * qn;
    float hv = num / fmaxf(fabsf(den), __expf(-mt));
    s_h[tid] = hv;
  }
  __syncthreads();
  if (tid < 128) {
    float mu = 0.f;
#pragma unroll 4
    for (int j = 0; j < 128; ++j) mu += s_h[j];
    mu *= (1.f / 128.f);
    float var = 0.f;
#pragma unroll 4
    for (int j = 0; j < 128; ++j) { float d = s_h[j] - mu; var += d * d; }
    var *= (1.f / 128.f);
    float y = (s_h[tid] - mu) * rsqrtf(var + LN_EPS) * P_GN(p)[h * 128 + tid] * bf2f(O[(size_t)row * 512 + h * 128 + tid]);
    Q[(size_t)row * 512 + h * 128 + tid] = f2bf(y);
  }
}
template <int WLEN>
__device__ __forceinline__ void pool_rows(const Params& p, const float* __restrict__ U, int mt, int g, unsigned* sW32, int tid) {
  const int cp = tid & 63, qtr = tid >> 6;
  if (mt < 128) {
    const int b = mt >> 4, t0 = (mt & 15) * 128 + qtr * 32;
    const float* Ub = U + (size_t)b * 2048 * 512 + g * 128 + cp * 2;
    float2 u[31 + WLEN];
#pragma unroll
    for (int k = 0; k < 31 + WLEN; ++k) {
      const int t = t0 - (WLEN - 1) + k;
      u[k] = (t >= 0) ? *(const float2*)(Ub + (size_t)t * 512) : make_float2(0.f, 0.f);
    }
    float s0 = 0.f, s1 = 0.f;
#pragma unroll
    for (int k = 0; k < WLEN - 1; ++k) { s0 += u[k].x; s1 += u[k].y; }
#pragma unroll
    for (int j = 0; j < 32; ++j) {
      const float2 ut = u[WLEN - 1 + j];
      const int t = t0 + j;
      s0 += ut.x; s1 += ut.y;
      const float rc = 1.f / (float)min(WLEN, t + 1);
      sW32[(qtr * 32 + j) * (LW / 2) + cp] = pack2(s0 * rc - ut.x, s1 * rc - ut.y);
      s0 -= u[j].x; s1 -= u[j].y;
      if (t >= 2033) *(float2*)(p.out + OUT_PP + ((size_t)b * 15 + (t - 2033)) * 512 + g * 128 + cp * 2) = ut;
    }
  } else {
    const float rc = 1.f / (float)WLEN;
#pragma unroll 2
    for (int j = 0; j < 32; ++j) {
      const int sidx = qtr * 32 + j;
      const float2 ut = *(const float2*)(U + (size_t)(NP + sidx) * 512 + g * 128 + cp * 2);
      const float* __restrict__ pre = p.st_pool + (size_t)sidx * 15 * 512 + g * 128 + cp * 2;
      float2 pr[WLEN - 1];
#pragma unroll
      for (int q = 1; q < WLEN; ++q) pr[q - 1] = *(const float2*)(pre + (size_t)(15 - q) * 512);
      float s0 = ut.x, s1 = ut.y;
#pragma unroll
      for (int q = 0; q < WLEN - 1; ++q) { s0 += pr[q].x; s1 += pr[q].y; }
      sW32[sidx * (LW / 2) + cp] = pack2(s0 * rc - ut.x, s1 * rc - ut.y);
      *(float2*)(p.out + OUT_PS + ((size_t)sidx * 15 + 14) * 512 + g * 128 + cp * 2) = ut;
    }
  }
}
__device__ __forceinline__ void d1_pool(const Params& p, int item, unsigned char* smem) {
  TID_VARS
  const int mt = item >> 2, g = item & 3;
  const float* U = (const float*)(p.ws + OFF_U);
  bf16_t* sW = (bf16_t*)(smem + SM_W);
  __syncthreads();
  if (g == 0) pool_rows<2>(p, U, mt, g, (unsigned*)sW, tid);
  else if (g == 1) pool_rows<4>(p, U, mt, g, (unsigned*)sW, tid);
  else if (g == 2) pool_rows<8>(p, U, mt, g, (unsigned*)sW, tid);
  else pool_rows<16>(p, U, mt, g, (unsigned*)sW, tid);
  f32x16 acc[2][2]; ZERO_ACC(acc)
  gemm_sg(sW, (const bf16_t*)(p.ws + OFF_WPOOL) + g * 16384, 128, 128, smem, acc);
  bf16_t* PB = (bf16_t*)(p.out + OUT_PB);
  const int row_base = mt * 128;
  const int grp_col0 = g * 128;
  EPI_QUADS(acc, {
    const int col = grp_col0 + lcol; const float sc = P_PS(p)[col]; const int row0 = row_base + lrow0;
    PB[(size_t)(row0) * 512 + col] = f2bf(v0 * sc); PB[(size_t)(row0 + 1) * 512 + col] = f2bf(v1 * sc);
    PB[(size_t)(row0 + 2) * 512 + col] = f2bf(v2 * sc); PB[(size_t)(row0 + 3) * 512 + col] = f2bf(v3 * sc);
  })
}
__device__ __forceinline__ void phase_D1(const Params& p, unsigned char* smem) {
  for (int it = blockIdx.x; it < 512; it += gridDim.x) d1_prompt_chunk(p, it, smem);
  for (int it = blockIdx.x; it < 512; it += gridDim.x) d1_sample_step(p, it, smem);
  for (int it = blockIdx.x; it < 512; it += gridDim.x) d1_pool(p, it, smem);
}

__device__ __forceinline__ void phase_D2(const Params& p) {
  const int tid = threadIdx.x;
  const float* CHB = (const float*)(p.ws + OFF_CHB);
  const int n_items = 32 * 64 + 32;
  for (int it = blockIdx.x; it < n_items; it += gridDim.x) {
    if (it < 2048) {
      const int bh = it >> 6, e = (it & 63) * 256 + tid;
      const float* __restrict__ SB = p.out + OUT_SBUF + (size_t)bh * 16 * 16384 + e;
      bf16_t* __restrict__ CT = (bf16_t*)(p.ws + OFF_CT) + (size_t)bh * 16 * 16384 + e;
      float dcv[16], dsv[16], sb[16];
#pragma unroll
      for (int c = 0; c < 16; ++c) sb[c] = SB[(size_t)c * 16384];
      {
        float Bv[16], av[16];
#pragma unroll
        for (int c = 0; c < 16; ++c) { Bv[c] = CHB[(bh * 16 + c) * 32]; av[c] = CHB[(bh * 16 + c) * 32 + 1]; }
        float m = 0.f;
#pragma unroll
        for (int c = 0; c < 16; ++c) { float mn = fmaxf(Bv[c] + m, av[c]); dcv[c] = __expf(Bv[c] + m - mn); dsv[c] = __expf(av[c] - mn); m = mn; }
      }
      float C = 0.f;
#pragma unroll
      for (int c = 0; c < 16; ++c) { CT[(size_t)c * 16384] = f2bf(C); C = dcv[c] * C + dsv[c] * sb[c]; }
      const int dv = e >> 7, dk = e & 127;
      p.out[OUT_CP + (size_t)bh * 16384 + dk * 128 + dv] = C;
    } else {
      const int bh = it - 2048;
      if (tid < 128) {
        const float* NL = (const float*)(p.ws + OFF_NLOC) + (size_t)bh * 16 * 128 + tid;
        float* NPV = (float*)(p.ws + OFF_NPREV) + (size_t)bh * 16 * 128 + tid;
        float* MPV = (float*)(p.ws + OFF_MPREV) + bh * 16 * 32;
        float m = 0.f, n = 0.f;
        for (int c = 0; c < 16; ++c) {
          NPV[c * 128] = n;
          if (tid == 0) MPV[c * 32] = m;
          float B = CHB[(bh * 16 + c) * 32], a = CHB[(bh * 16 + c) * 32 + 1];
          float mn = fmaxf(B + m, a);
          n = __expf(B + m - mn) * n + __expf(a - mn) * NL[c * 128];
          m = mn;
        }
        p.out[OUT_NP + bh * 128 + tid] = n;
        if (tid == 0) p.out[OUT_MP + bh] = m;
      }
    }
  }
}

__device__ __forceinline__ void phase_D3(const Params& p, unsigned char* smem) {
  TID_VARS
  float* misc = (float*)(smem + SM_MISC);
  float* s_lf = misc, *s_ig = misc + 128, *s_b = misc + 256, *s_colf = misc + 384, *s_rowf = misc + 512, *s_wst = misc + 640, *s_inv = misc + 768;
  bf16_t* sW = (bf16_t*)(smem + SM_W);
  float* sH = (float*)smem;
  bf16_t* Q = (bf16_t*)(p.ws + OFF_Q); const bf16_t* Kb = (const bf16_t*)(p.ws + OFF_K); const bf16_t* O = (const bf16_t*)(p.ws + OFF_O);
  const float* IG = (const float*)(p.ws + OFF_IG); const float* LF = (const float*)(p.ws + OFF_LF);
  for (int item = blockIdx.x; item < 512; item += gridDim.x) {
    const int bh = item >> 4, c = item & 15, b = bh >> 2, h = bh & 3;
    const int r0 = b * 2048 + c * 128;
    const float m_prev = ((const float*)(p.ws + OFF_MPREV))[item * 32];
    __syncthreads();
    if (tid < 128) { s_lf[tid] = LF[(size_t)(r0 + tid) * 4 + h]; s_ig[tid] = IG[(size_t)(r0 + tid) * 4 + h];
                     misc[896 + tid] = ((const float*)(p.ws + OFF_NPREV))[(size_t)item * 128 + tid]; }
    __syncthreads();
    if (tid < 128) { float a = 0.f;
#pragma unroll 2
      for (int j = 0; j <= tid; ++j) a += s_lf[j];
      s_b[tid] = a; s_colf[tid] = s_ig[tid] - a; }
    __syncthreads();
    if (tid < 128) {
      float pm = -3.0e38f;
#pragma unroll 2
      for (int j = 0; j <= tid; ++j) pm = fmaxf(pm, s_colf[j]);
      float bt = s_b[tid];
      float mt = bt + fmaxf(m_prev, pm);
      s_rowf[tid] = bt - mt;
      s_wst[tid] = __expf(bt + m_prev - mt);
      s_inv[tid] = mt;
    }
    const bf16_t* Qp = Q + (size_t)r0 * 512 + h * 128;
    const bf16_t* Kp = Kb + (size_t)r0 * 512 + h * 128;
    f32x16 acc[2][2]; ZERO_ACC(acc)
    gemm_gg<false>(Qp, 512, Kp, 512, 128, smem, acc, nullptr);
    EPI_QUADS(acc, {
      const float cf = s_colf[lcol];
      float w0 = (lcol <= lrow0) ? __expf(s_rowf[lrow0] + cf) * v0 : 0.f;
      float w1 = (lcol <= lrow0 + 1) ? __expf(s_rowf[lrow0 + 1] + cf) * v1 : 0.f;
      float w2 = (lcol <= lrow0 + 2) ? __expf(s_rowf[lrow0 + 2] + cf) * v2 : 0.f;
      float w3 = (lcol <= lrow0 + 3) ? __expf(s_rowf[lrow0 + 3] + cf) * v3 : 0.f;
      sW[(lrow0) * LW + lcol] = f2bf(w0); sW[(lrow0 + 1) * LW + lcol] = f2bf(w1);
      sW[(lrow0 + 2) * LW + lcol] = f2bf(w2); sW[(lrow0 + 3) * LW + lcol] = f2bf(w3);
    })
    __syncthreads();
    if (tid < 128) {
      float d1 = 0.f;
      const unsigned* wr = (const unsigned*)(sW + tid * LW);
#pragma unroll 4
      for (int j = 0; j < 64; ++j) { unsigned u = wr[j]; d1 += bflo(u) + bfhi(u); }
      const float* npv = misc + 896;
      const uint4* qr = (const uint4*)(Qp + (size_t)tid * 512);
      float qn = 0.f;
#pragma unroll 2
      for (int j = 0; j < 16; ++j) {
        const uint4 v = qr[j]; const float* n = npv + j * 8;
        qn += bflo(v.x) * n[0] + bfhi(v.x) * n[1] + bflo(v.y) * n[2] + bfhi(v.y) * n[3] + bflo(v.z) * n[4] + bfhi(v.z) * n[5] + bflo(v.w) * n[6] + bfhi(v.w) * n[7];
      }
      float den = d1 + s_wst[tid] * qn;
      float mt = s_inv[tid];
      s_inv[tid] = 1.f / fmaxf(fabsf(den), __expf(-mt));
    }
    ZERO_ACC(acc)
    gemm_gg<false>(Qp, 512, (const bf16_t*)(p.ws + OFF_CT) + (size_t)item * 16384, 128, 128, smem, acc, nullptr);
    EPI_QUADS(acc, {
      acc[mi][ni][4 * g] = v0 * s_wst[lrow0]; acc[mi][ni][4 * g + 1] = v1 * s_wst[lrow0 + 1];
      acc[mi][ni][4 * g + 2] = v2 * s_wst[lrow0 + 2]; acc[mi][ni][4 * g + 3] = v3 * s_wst[lrow0 + 3];
    })
    gemm_sg(sW, (const bf16_t*)(p.ws + OFF_VT) + (size_t)bh * 128 * 2048 + c * 128, 2048, 128, smem, acc);
    __syncthreads();
    EPI_QUADS(acc, {
      sH[(lrow0) * 129 + lcol] = v0 * s_inv[lrow0]; sH[(lrow0 + 1) * 129 + lcol] = v1 * s_inv[lrow0 + 1];
      sH[(lrow0 + 2) * 129 + lcol] = v2 * s_inv[lrow0 + 2]; sH[(lrow0 + 3) * 129 + lcol] = v3 * s_inv[lrow0 + 3];
    })
    __syncthreads();
    {
      const int t = tid >> 1, half = tid & 1;
      const float* hr = sH + t * 129 + half * 64;
      float s = 0.f;
#pragma unroll 4
      for (int j = 0; j < 64; ++j) s += hr[j];
      s += __shfl_xor(s, 1);
      const float mu = s * (1.f / 128.f);
      float q = 0.f;
#pragma unroll 4
      for (int j = 0; j < 64; ++j) { float d = hr[j] - mu; q += d * d; }
      q += __shfl_xor(q, 1);
      const float rstd = rsqrtf(q * (1.f / 128.f) + LN_EPS);
      const size_t gofs = (size_t)(r0 + t) * 512 + h * 128 + half * 64;
      const float* __restrict__ gn = P_GN(p) + h * 128 + half * 64;
      uint4 ov[8];
#pragma unroll
      for (int k = 0; k < 8; ++k) ov[k] = *(const uint4*)(O + gofs + 8 * k);
#pragma unroll
      for (int k = 0; k < 8; ++k) {
        const float* hk = hr + 8 * k; const float* gk = gn + 8 * k;
        uint4 o;
        o.x = pack2((hk[0] - mu) * rstd * gk[0] * bflo(ov[k].x), (hk[1] - mu) * rstd * gk[1] * bfhi(ov[k].x));
        o.y = pack2((hk[2] - mu) * rstd * gk[2] * bflo(ov[k].y), (hk[3] - mu) * rstd * gk[3] * bfhi(ov[k].y));
        o.z = pack2((hk[4] - mu) * rstd * gk[4] * bflo(ov[k].z), (hk[5] - mu) * rstd * gk[5] * bfhi(ov[k].z));
        o.w = pack2((hk[6] - mu) * rstd * gk[6] * bflo(ov[k].w), (hk[7] - mu) * rstd * gk[7] * bfhi(ov[k].w));
        *(uint4*)(Q + gofs + 8 * k) = o;
      }
    }
  }
}

__device__ __forceinline__ void phase_E(const Params& p, unsigned char* smem) {
  TID_VARS
  const bf16_t* H = (const bf16_t*)(p.ws + OFF_H);
  const bf16_t* WT = (const bf16_t*)(p.ws + OFF_WIN);
  const bf16_t* HA = (const bf16_t*)(p.ws + OFF_Q);
  const bf16_t* PB = (const bf16_t*)(p.out + OUT_PB);
  bf16_t* MG = (bf16_t*)(p.ws + OFF_MERGED);
  for (int pc = blockIdx.x; pc < 256; pc += gridDim.x) {
    const int row0 = NP + (pc & 7) * 16, col0 = (pc >> 3) * 32;
    const f32x4 z4 = {0.f, 0.f, 0.f, 0.f};
    f32x4 a8[8] = {z4, z4, z4, z4, z4, z4, z4, z4};
    skinny16x32(H + (size_t)row0 * 1024 + w * 256, 1024, WT + (size_t)(2568 + col0) * 1024 + w * 256, 1024, 256, a8[0], a8[1], lane);
    skinny16x32(HA + (size_t)row0 * 512 + w * 128, 512, (const bf16_t*)(p.ws + OFF_WA) + (size_t)col0 * 512 + w * 128, 512, 128, a8[2], a8[3], lane);
    skinny16x32(H + (size_t)row0 * 1024 + w * 256, 1024, WT + (size_t)(3592 + col0) * 1024 + w * 256, 1024, 256, a8[4], a8[5], lane);
    skinny16x32(PB + (size_t)row0 * 512 + w * 128, 512, (const bf16_t*)(p.ws + OFF_WB) + (size_t)col0 * 512 + w * 128, 512, 128, a8[6], a8[7], lane);
    wave4_reduce<8>(a8, smem, w, lane);
    if (w == 0) {
      const int c = col0 + (lane & 15), rr = row0 + (lane >> 4) * 4;
      const float ba0 = P_BIN(p)[2568 + c], ba1 = P_BIN(p)[2568 + c + 16], bb0 = P_BIN(p)[3592 + c], bb1 = P_BIN(p)[3592 + c + 16];
#pragma unroll
      for (int j = 0; j < 4; ++j) {
        MG[(size_t)(rr + j) * 1024 + c] = f2bf(sigmoidf_(a8[0][j] + ba0) * a8[2][j] + sigmoidf_(a8[4][j] + bb0) * a8[6][j]);
        MG[(size_t)(rr + j) * 1024 + c + 16] = f2bf(sigmoidf_(a8[1][j] + ba1) * a8[3][j] + sigmoidf_(a8[5][j] + bb1) * a8[7][j]);
      }
    }
  }
  for (int q = blockIdx.x >> 3; q < 16 * 8; q += (gridDim.x >> 3)) {
    int mt, nt; xcd_tile(q, 8, mt, nt);
    const int row_base = mt * 128, col_base = nt * 128;
    unsigned gpk[32];
    unsigned* mlds = (unsigned*)(smem + SM_W) + tid;
    f32x16 acc[2][2];
    ZERO_ACC(acc)
    gemm_gg<false>(H + (size_t)row_base * 1024, 1024, WT + (size_t)(2568 + col_base) * 1024, 1024, 1024, smem, acc, nullptr);
    EPI_QUADS(acc, {
      const float bias = P_BIN(p)[2568 + col_base + lcol];
      gpk[(mi * 2 + ni) * 8 + g * 2] = pack2(sigmoidf_(v0 + bias), sigmoidf_(v1 + bias));
      gpk[(mi * 2 + ni) * 8 + g * 2 + 1] = pack2(sigmoidf_(v2 + bias), sigmoidf_(v3 + bias));
    })
    ZERO_ACC(acc)
    gemm_gg<false>(HA + (size_t)row_base * 512, 512, (const bf16_t*)(p.ws + OFF_WA) + (size_t)col_base * 512, 512, 512, smem, acc, nullptr);
    EPI_QUADS(acc, {
      unsigned g0 = gpk[(mi * 2 + ni) * 8 + g * 2], g1 = gpk[(mi * 2 + ni) * 8 + g * 2 + 1];
      mlds[((mi * 2 + ni) * 8 + g * 2) * 256] = pack2(bflo(g0) * v0, bfhi(g0) * v1);
      mlds[((mi * 2 + ni) * 8 + g * 2 + 1) * 256] = pack2(bflo(g1) * v2, bfhi(g1) * v3);
    })
    ZERO_ACC(acc)
    gemm_gg<false>(H + (size_t)row_base * 1024, 1024, WT + (size_t)(3592 + col_base) * 1024, 1024, 1024, smem, acc, nullptr);
    EPI_QUADS(acc, {
      const float bias = P_BIN(p)[3592 + col_base + lcol];
      gpk[(mi * 2 + ni) * 8 + g * 2] = pack2(sigmoidf_(v0 + bias), sigmoidf_(v1 + bias));
      gpk[(mi * 2 + ni) * 8 + g * 2 + 1] = pack2(sigmoidf_(v2 + bias), sigmoidf_(v3 + bias));
    })
    ZERO_ACC(acc)
    gemm_gg<false>(PB + (size_t)row_base * 512, 512, (const bf16_t*)(p.ws + OFF_WB) + (size_t)col_base * 512, 512, 512, smem, acc, nullptr);
    EPI_QUADS(acc, {
      unsigned g0 = gpk[(mi * 2 + ni) * 8 + g * 2], g1 = gpk[(mi * 2 + ni) * 8 + g * 2 + 1];
      unsigned m0 = mlds[((mi * 2 + ni) * 8 + g * 2) * 256], m1 = mlds[((mi * 2 + ni) * 8 + g * 2 + 1) * 256];
      const int col = col_base + lcol; const int row0 = row_base + lrow0;
      MG[(size_t)(row0) * 1024 + col] = f2bf(bflo(m0) + bflo(g0) * v0);
      MG[(size_t)(row0 + 1) * 1024 + col] = f2bf(bfhi(m0) + bfhi(g0) * v1);
      MG[(size_t)(row0 + 2) * 1024 + col] = f2bf(bflo(m1) + bflo(g1) * v2);
      MG[(size_t)(row0 + 3) * 1024 + col] = f2bf(bfhi(m1) + bfhi(g1) * v3);
    })
  }
}

__device__ __forceinline__ void phase_F(const Params& p, unsigned char* smem) {
  TID_VARS
  const bf16_t* MG = (const bf16_t*)(p.ws + OFF_MERGED);
  const bf16_t* WO = (const bf16_t*)(p.ws + OFF_WOUT);
  const float* MOD = (const float*)(p.ws + OFF_MOD);
  float* Y = p.out + OUT_Y;
  for (int pc = blockIdx.x; pc < 256; pc += gridDim.x) {
    const int row0 = NP + (pc & 7) * 16, col0 = (pc >> 3) * 32;
    const f32x4 z4 = {0.f, 0.f, 0.f, 0.f};
    f32x4 a2[2] = {z4, z4};
    skinny16x32(MG + (size_t)row0 * 1024 + w * 256, 1024, WO + (size_t)col0 * 1024 + w * 256, 1024, 256, a2[0], a2[1], lane);
    wave4_reduce<2>(a2, smem, w, lane);
    if (w == 0) {
      const int c = col0 + (lane & 15), rr = row0 + (lane >> 4) * 4;
#pragma unroll
      for (int j = 0; j < 4; ++j) {
        const int row = rr + j;
        const float* mg = MOD + (size_t)mod_row(row) * 6144 + 2048;
        const float* xr = x_row(p, row);
        Y[(size_t)row * 1024 + c] = ALPHA * xr[c] + mg[c] * a2[0][j];
        Y[(size_t)row * 1024 + c + 16] = ALPHA * xr[c + 16] + mg[c + 16] * a2[1][j];
      }
    }
  }
  for (int q = blockIdx.x >> 3; q < 16 * 8; q += (gridDim.x >> 3)) {
    int mt, nt; xcd_tile(q, 8, mt, nt);
    const int row_base = mt * 128, col_base = nt * 128;
    f32x16 acc[2][2]; ZERO_ACC(acc)
    gemm_gg128(MG + (size_t)row_base * 1024, 1024, WO + (size_t)col_base * 1024, 1024, 1024, smem, acc);
    EPI_QUADS(acc, {
      const int col = col_base + lcol; const int row0 = row_base + lrow0;
      const float* mg = MOD + (size_t)mod_row(row0) * 6144 + 2048 + col;
      const float g1 = *mg;
      Y[(size_t)(row0) * 1024 + col] = ALPHA * x_row(p, row0)[col] + g1 * v0;
      Y[(size_t)(row0 + 1) * 1024 + col] = ALPHA * x_row(p, row0 + 1)[col] + (row0 < NP ? g1 : mg[6144]) * v1;
      Y[(size_t)(row0 + 2) * 1024 + col] = ALPHA * x_row(p, row0 + 2)[col] + (row0 < NP ? g1 : mg[2 * 6144]) * v2;
      Y[(size_t)(row0 + 3) * 1024 + col] = ALPHA * x_row(p, row0 + 3)[col] + (row0 < NP ? g1 : mg[3 * 6144]) * v3;
    })
  }
}

__device__ __forceinline__ void phase_G(const Params& p) {
  const int tid = threadIdx.x, lane = tid & 63, w = tid >> 6;
  const float* MOD = (const float*)(p.ws + OFF_MOD);
  bf16_t* H = (bf16_t*)(p.ws + OFF_H);
  float* Y = p.out + OUT_Y;
  const int rstep = gridDim.x * 4;
  float4 nx[4];
  {
    const int row = blockIdx.x * 4 + w;
    if (row < NT) {
#pragma unroll
      for (int i = 0; i < 4; ++i) nx[i] = *(const float4*)(Y + (size_t)row * 1024 + i * 256 + lane * 4); }
  }
  for (int row = blockIdx.x * 4 + w; row < NT; row += rstep) {
    float* yr = Y + (size_t)row * 1024;
    float v[16];
#pragma unroll
    for (int i = 0; i < 4; ++i) { float4 t = nx[i]; v[4 * i] = t.x; v[4 * i + 1] = t.y; v[4 * i + 2] = t.z; v[4 * i + 3] = t.w; }
    if (row + rstep < NT) {
#pragma unroll
      for (int i = 0; i < 4; ++i) nx[i] = *(const float4*)(Y + (size_t)(row + rstep) * 1024 + i * 256 + lane * 4); }
    float s = 0.f;
#pragma unroll
    for (int i = 0; i < 16; ++i) s += v[i];
    float mu = wave_sum(s) * (1.f / 1024.f);
    float q = 0.f;
#pragma unroll
    for (int i = 0; i < 16; ++i) { float d = v[i] - mu; q += d * d; }
    float rstd = rsqrtf(wave_sum(q) * (1.f / 1024.f) + LN_EPS);
    s = 0.f;
#pragma unroll
    for (int i = 0; i < 4; ++i) {
      int c = i * 256 + lane * 4;
      float4 gg = *(const float4*)(P_L1G(p) + c), bb = *(const float4*)(P_L1B(p) + c);
      v[4 * i] = (v[4 * i] - mu) * rstd * gg.x + bb.x; v[4 * i + 1] = (v[4 * i + 1] - mu) * rstd * gg.y + bb.y;
      v[4 * i + 2] = (v[4 * i + 2] - mu) * rstd * gg.z + bb.z; v[4 * i + 3] = (v[4 * i + 3] - mu) * rstd * gg.w + bb.w;
      *(float4*)(yr + c) = make_float4(v[4 * i], v[4 * i + 1], v[4 * i + 2], v[4 * i + 3]);
      s += v[4 * i] + v[4 * i + 1] + v[4 * i + 2] + v[4 * i + 3];
    }
    mu = wave_sum(s) * (1.f / 1024.f);
    q = 0.f;
#pragma unroll
    for (int i = 0; i < 16; ++i) { float d = v[i] - mu; q += d * d; }
    rstd = rsqrtf(wave_sum(q) * (1.f / 1024.f) + LN_EPS);
    const float* mr = MOD + (size_t)mod_row(row) * 6144;
#pragma unroll
    for (int i = 0; i < 4; ++i) {
      int c = i * 256 + lane * 4;
      float4 sh = *(const float4*)(mr + 3072 + c), sc = *(const float4*)(mr + 4096 + c);
      uint2 o;
      o.x = pack2((v[4 * i] - mu) * rstd * (1.f + sc.x) + sh.x, (v[4 * i + 1] - mu) * rstd * (1.f + sc.y) + sh.y);
      o.y = pack2((v[4 * i + 2] - mu) * rstd * (1.f + sc.z) + sh.z, (v[4 * i + 3] - mu) * rstd * (1.f + sc.w) + sh.w);
      *(uint2*)(H + (size_t)row * 1024 + c) = o;
    }
  }
}

__device__ __forceinline__ void phase_H(const Params& p, unsigned char* smem) {
  TID_VARS
  const bf16_t* H = (const bf16_t*)(p.ws + OFF_H);
  const bf16_t* WQ = (const bf16_t*)(p.ws + OFF_WPQ);
  bf16_t* PQ = (bf16_t*)(p.ws + OFF_PQ);
  for (int pc = blockIdx.x; pc < 512; pc += gridDim.x) {
    const int row0 = NP + (pc & 7) * 16, col0 = (pc >> 3) * 32;
    const f32x4 z4 = {0.f, 0.f, 0.f, 0.f};
    f32x4 a2[2] = {z4, z4};
    skinny16x32(H + (size_t)row0 * 1024 + w * 256, 1024, WQ + (size_t)col0 * 1024 + w * 256, 1024, 256, a2[0], a2[1], lane);
    wave4_reduce<2>(a2, smem, w, lane);
    if (w == 0) {
      const int c = col0 + (lane & 15), rr = row0 + (lane >> 4) * 4;
#pragma unroll
      for (int j = 0; j < 4; ++j) {
        PQ[(size_t)(rr + j) * 2048 + c] = f2bf(a2[0][j]);
        PQ[(size_t)(rr + j) * 2048 + c + 16] = f2bf(a2[1][j]);
      }
    }
  }
  for (int q = blockIdx.x >> 3; q < 16 * 16; q += (gridDim.x >> 3)) {
    int mt, nt; xcd_tile(q, 16, mt, nt);
    const int row_base = mt * 128, col_base = nt * 128;
    f32x16 acc[2][2]; ZERO_ACC(acc)
    gemm_gg128(H + (size_t)row_base * 1024, 1024, WQ + (size_t)col_base * 1024, 1024, 1024, smem, acc);
    EPI_QUADS(acc, {
      const int col = col_base + lcol; const int row0 = row_base + lrow0;
      PQ[(size_t)(row0) * 2048 + col] = f2bf(v0); PQ[(size_t)(row0 + 1) * 2048 + col] = f2bf(v1);
      PQ[(size_t)(row0 + 2) * 2048 + col] = f2bf(v2); PQ[(size_t)(row0 + 3) * 2048 + col] = f2bf(v3);
    })
  }
}

__device__ __forceinline__ int f2key(float f) { int b = __float_as_int(f); return b ^ ((b >> 31) & 0x7FFFFFFF); }
__device__ __forceinline__ float key2f(int k) { return __int_as_float(k ^ ((k >> 31) & 0x7FFFFFFF)); }
#define CMPX(a, b) { const int _h = max(a, b), _l = min(a, b); a = _h; b = _l; }
#define SORT16(k, o) { CMPX(k[(o) + 0], k[(o) + 1]) CMPX(k[(o) + 2], k[(o) + 3]) CMPX(k[(o) + 0], k[(o) + 2]) CMPX(k[(o) + 1], k[(o) + 3]) CMPX(k[(o) + 1], k[(o) + 2]) CMPX(k[(o) + 4], k[(o) + 5]) CMPX(k[(o) + 6], k[(o) + 7]) CMPX(k[(o) + 4], k[(o) + 6]) CMPX(k[(o) + 5], k[(o) + 7]) CMPX(k[(o) + 5], k[(o) + 6]) CMPX(k[(o) + 0], k[(o) + 4]) CMPX(k[(o) + 2], k[(o) + 6]) CMPX(k[(o) + 2], k[(o) + 4]) CMPX(k[(o) + 1], k[(o) + 5]) CMPX(k[(o) + 3], k[(o) + 7]) CMPX(k[(o) + 3], k[(o) + 5]) CMPX(k[(o) + 1], k[(o) + 2]) CMPX(k[(o) + 3], k[(o) + 4]) CMPX(k[(o) + 5], k[(o) + 6]) CMPX(k[(o) + 8], k[(o) + 9]) CMPX(k[(o) + 10], k[(o) + 11]) CMPX(k[(o) + 8], k[(o) + 10]) CMPX(k[(o) + 9], k[(o) + 11]) CMPX(k[(o) + 9], k[(o) + 10]) CMPX(k[(o) + 12], k[(o) + 13]) CMPX(k[(o) + 14], k[(o) + 15]) CMPX(k[(o) + 12], k[(o) + 14]) CMPX(k[(o) + 13], k[(o) + 15]) CMPX(k[(o) + 13], k[(o) + 14]) CMPX(k[(o) + 8], k[(o) + 12]) CMPX(k[(o) + 10], k[(o) + 14]) CMPX(k[(o) + 10], k[(o) + 12]) CMPX(k[(o) + 9], k[(o) + 13]) CMPX(k[(o) + 11], k[(o) + 15]) CMPX(k[(o) + 11], k[(o) + 13]) CMPX(k[(o) + 9], k[(o) + 10]) CMPX(k[(o) + 11], k[(o) + 12]) CMPX(k[(o) + 13], k[(o) + 14]) CMPX(k[(o) + 0], k[(o) + 8]) CMPX(k[(o) + 4], k[(o) + 12]) CMPX(k[(o) + 4], k[(o) + 8]) CMPX(k[(o) + 2], k[(o) + 10]) CMPX(k[(o) + 6], k[(o) + 14]) CMPX(k[(o) + 6], k[(o) + 10]) CMPX(k[(o) + 2], k[(o) + 4]) CMPX(k[(o) + 6], k[(o) + 8]) CMPX(k[(o) + 10], k[(o) + 12]) CMPX(k[(o) + 1], k[(o) + 9]) CMPX(k[(o) + 5], k[(o) + 13]) CMPX(k[(o) + 5], k[(o) + 9]) CMPX(k[(o) + 3], k[(o) + 11]) CMPX(k[(o) + 7], k[(o) + 15]) CMPX(k[(o) + 7], k[(o) + 11]) CMPX(k[(o) + 3], k[(o) + 5]) CMPX(k[(o) + 7], k[(o) + 9]) CMPX(k[(o) + 11], k[(o) + 13]) CMPX(k[(o) + 1], k[(o) + 2]) CMPX(k[(o) + 3], k[(o) + 4]) CMPX(k[(o) + 5], k[(o) + 6]) CMPX(k[(o) + 7], k[(o) + 8]) CMPX(k[(o) + 9], k[(o) + 10]) CMPX(k[(o) + 11], k[(o) + 12]) CMPX(k[(o) + 13], k[(o) + 14]) }
#define MERGE16(k, a, b) { k[(a) + 0] = max(k[(a) + 0], k[(b) + 15]); k[(a) + 1] = max(k[(a) + 1], k[(b) + 14]); k[(a) + 2] = max(k[(a) + 2], k[(b) + 13]); k[(a) + 3] = max(k[(a) + 3], k[(b) + 12]); k[(a) + 4] = max(k[(a) + 4], k[(b) + 11]); k[(a) + 5] = max(k[(a) + 5], k[(b) + 10]); k[(a) + 6] = max(k[(a) + 6], k[(b) + 9]); k[(a) + 7] = max(k[(a) + 7], k[(b) + 8]); k[(a) + 8] = max(k[(a) + 8], k[(b) + 7]); k[(a) + 9] = max(k[(a) + 9], k[(b) + 6]); k[(a) + 10] = max(k[(a) + 10], k[(b) + 5]); k[(a) + 11] = max(k[(a) + 11], k[(b) + 4]); k[(a) + 12] = max(k[(a) + 12], k[(b) + 3]); k[(a) + 13] = max(k[(a) + 13], k[(b) + 2]); k[(a) + 14] = max(k[(a) + 14], k[(b) + 1]); k[(a) + 15] = max(k[(a) + 15], k[(b) + 0]); CMPX(k[(a) + 0], k[(a) + 8]) CMPX(k[(a) + 1], k[(a) + 9]) CMPX(k[(a) + 2], k[(a) + 10]) CMPX(k[(a) + 3], k[(a) + 11]) CMPX(k[(a) + 4], k[(a) + 12]) CMPX(k[(a) + 5], k[(a) + 13]) CMPX(k[(a) + 6], k[(a) + 14]) CMPX(k[(a) + 7], k[(a) + 15]) CMPX(k[(a) + 0], k[(a) + 4]) CMPX(k[(a) + 1], k[(a) + 5]) CMPX(k[(a) + 2], k[(a) + 6]) CMPX(k[(a) + 3], k[(a) + 7]) CMPX(k[(a) + 8], k[(a) + 12]) CMPX(k[(a) + 9], k[(a) + 13]) CMPX(k[(a) + 10], k[(a) + 14]) CMPX(k[(a) + 11], k[(a) + 15]) CMPX(k[(a) + 0], k[(a) + 2]) CMPX(k[(a) + 1], k[(a) + 3]) CMPX(k[(a) + 4], k[(a) + 6]) CMPX(k[(a) + 5], k[(a) + 7]) CMPX(k[(a) + 8], k[(a) + 10]) CMPX(k[(a) + 9], k[(a) + 11]) CMPX(k[(a) + 12], k[(a) + 14]) CMPX(k[(a) + 13], k[(a) + 15]) CMPX(k[(a) + 0], k[(a) + 1]) CMPX(k[(a) + 2], k[(a) + 3]) CMPX(k[(a) + 4], k[(a) + 5]) CMPX(k[(a) + 6], k[(a) + 7]) CMPX(k[(a) + 8], k[(a) + 9]) CMPX(k[(a) + 10], k[(a) + 11]) CMPX(k[(a) + 12], k[(a) + 13]) CMPX(k[(a) + 14], k[(a) + 15]) }
#define TOPK_INSERT(top, x) { int _x = (x); _Pragma("unroll") for (int _j = 0; _j < 16; ++_j) { int _hi = max(top[_j], _x); _x = min(top[_j], _x); top[_j] = _hi; } }

__device__ __forceinline__ void phase_I(const Params& p, unsigned char* smem) {
  TID_VARS
  const bf16_t* PQ = (const bf16_t*)(p.ws + OFF_PQ);
  const bf16_t* SK = (const bf16_t*)(p.ws + OFF_SUBK);
  int* IDS = (int*)(p.ws + OFF_IDS); float* GT = (float*)(p.ws + OFF_GATES);
  float* sS = (float*)smem;
  int* sM = (int*)(smem + 66048);
  int* sL = (int*)smem;
  const int n_items = 129 * 8;
  for (int it = blockIdx.x; it < n_items; it += gridDim.x) {
    const int mt = it >> 3, head = it & 7;
    const int row_base = mt * 128;
    const int t = tid & 127, half = tid >> 7;
    int top0[16], top1[16];
#pragma unroll
    for (int pp = 0; pp < 2; ++pp) {
      f32x16 acc[2][2]; ZERO_ACC(acc)
      gemm_gg<false>(PQ + (size_t)row_base * 2048 + head * 256 + pp * 128, 2048, SK + pp * 16384, 128, 128, smem, acc, nullptr);
      __syncthreads();
      EPI_QUADS(acc, {
        sS[(lrow0) * 129 + lcol] = v0; sS[(lrow0 + 1) * 129 + lcol] = v1; sS[(lrow0 + 2) * 129 + lcol] = v2; sS[(lrow0 + 3) * 129 + lcol] = v3;
      })
      __syncthreads();
      int k[64];
      const float* sr = sS + t * 129 + half * 64;
#pragma unroll
      for (int j = 0; j < 64; ++j) k[j] = (f2key(sr[j]) & ~127) | (half * 64 + j);
      SORT16(k, 0) SORT16(k, 16) SORT16(k, 32) SORT16(k, 48)
      MERGE16(k, 0, 16) MERGE16(k, 32, 48) MERGE16(k, 0, 32)
      if (half == 1) {
#pragma unroll
        for (int j = 0; j < 16; ++j) sM[t * 16 + j] = k[j];
      }
      __syncthreads();
      if (half == 0) {
#pragma unroll
        for (int j = 0; j < 16; ++j) k[16 + j] = sM[t * 16 + j];
        MERGE16(k, 0, 16)
      }
      int top[16];
#pragma unroll
      for (int j = 0; j < 16; ++j) top[j] = k[j];
      if (pp == 0) {
#pragma unroll
        for (int j = 0; j < 16; ++j) top0[j] = top[j];
      } else {
#pragma unroll
        for (int j = 0; j < 16; ++j) top1[j] = top[j];
      }
    }
    __syncthreads();
    if (half == 0) {
#pragma unroll
      for (int j = 0; j < 16; ++j) { sL[t * 33 + j] = top0[j] & 127; sL[t * 33 + 16 + j] = top1[j] & 127; }
      float va[16], vb[16];
#pragma unroll
      for (int j = 0; j < 16; ++j) { va[j] = key2f(top0[j] & ~127); vb[j] = key2f(top1[j] & ~127); }
      int k[32];
#define CKEY(i, j) ((f2key(va[i] + vb[j]) & ~255) | ((i) * 16 + (j)))
#pragma unroll
      for (int j = 0; j < 16; ++j) k[j] = CKEY(0, j);
#pragma unroll
      for (int j = 0; j < 16; ++j) k[16 + j] = (j < 8) ? CKEY(1, (j < 8 ? j : 0)) : (int)0x80000000;
      MERGE16(k, 0, 16)
#pragma unroll
      for (int j = 0; j < 16; ++j) k[16 + j] = (j < 5) ? CKEY(2, (j < 5 ? j : 0)) : (int)0x80000000;
      MERGE16(k, 0, 16)
#pragma unroll
      for (int j = 0; j < 16; ++j) k[16 + j] = (j < 4) ? CKEY(3, (j < 4 ? j : 0)) : (int)0x80000000;
      MERGE16(k, 0, 16)
#pragma unroll
      for (int j = 0; j < 16; ++j) k[16 + j] = (j < 3) ? CKEY(4, (j < 3 ? j : 0)) : (int)0x80000000;
      MERGE16(k, 0, 16)
#pragma unroll
      for (int j = 0; j < 16; ++j) k[16 + j] = (j < 2) ? CKEY(5, (j < 2 ? j : 0)) : (int)0x80000000;
      MERGE16(k, 0, 16)
#pragma unroll
      for (int j = 0; j < 16; ++j) k[16 + j] = (j < 2) ? CKEY(6, (j < 2 ? j : 0)) : (int)0x80000000;
      MERGE16(k, 0, 16)
#pragma unroll
      for (int j = 0; j < 16; ++j) k[16 + j] = (j < 2) ? CKEY(7, (j < 2 ? j : 0)) : (int)0x80000000;
      MERGE16(k, 0, 16)
#pragma unroll
      for (int j = 0; j < 16; ++j) k[16 + j] = (j < 8) ? CKEY((j < 8 ? 8 + j : 8), 0) : (int)0x80000000;
      MERGE16(k, 0, 16)
      int best[16];
#pragma unroll
      for (int j = 0; j < 16; ++j) best[j] = k[j];
      float ev[16]; float mx = key2f(best[0] & ~255); float sum = 0.f;
#pragma unroll
      for (int j = 0; j < 16; ++j) { ev[j] = __expf(key2f(best[j] & ~255) - mx); sum += ev[j]; }
      const float inv = 1.f / sum;
      const size_t ob = ((size_t)head * NT + (row_base + t)) * 16;
#pragma unroll
      for (int j = 0; j < 16; ++j) {
        int pr = best[j] & 255;
        int id = sL[t * 33 + (pr >> 4)] * 128 + sL[t * 33 + 16 + (pr & 15)];
        IDS[ob + j] = id; GT[ob + j] = ev[j] * inv;
      }
    }
  }
}

template <int CTRL> __device__ __forceinline__ float dppf(float v) {
  return __int_as_float(__builtin_amdgcn_update_dpp(0, __float_as_int(v), CTRL, 0xF, 0xF, false));
}
__device__ __forceinline__ float reduce16(float v) {
  v += dppf<0xB1>(v);
  v += dppf<0x4E>(v);
  v += dppf<0x141>(v);
  v += dppf<0x140>(v);
  return v;
}
__device__ __forceinline__ unsigned u4c(const uint4& v, int k) { return k == 0 ? v.x : (k == 1 ? v.y : (k == 2 ? v.z : v.w)); }
__device__ __forceinline__ float f4c(const float4& v, int k) { return k == 0 ? v.x : (k == 1 ? v.y : (k == 2 ? v.z : v.w)); }
__device__ __forceinline__ float dot8(const uint4& a, const uint4& h, float s) {
  s = dot2bf(a.x, h.x, s); s = dot2bf(a.y, h.y, s); s = dot2bf(a.z, h.z, s); s = dot2bf(a.w, h.w, s); return s;
}
__device__ __forceinline__ float dot4_fp8(unsigned w, float h0, float h1, float h2, float h3, float s) {
  const f32x2_t lo = __builtin_amdgcn_cvt_pk_f32_fp8((int)w, false), hi = __builtin_amdgcn_cvt_pk_f32_fp8((int)w, true);
  s = fmaf(lo.x, h0, s); s = fmaf(lo.y, h1, s); s = fmaf(hi.x, h2, s); s = fmaf(hi.y, h3, s);
  return s;
}
template <bool COOP>
__device__ __forceinline__ void peer_token(const Params& p, unsigned char* smem, int row, int w, int lane) {
  const int es = lane >> 4, sl = lane & 15;
  const bf16_t* H = (const bf16_t*)(p.ws + OFF_H);
  const unsigned char* PU = p.ws + OFF_PU; const unsigned char* PV = p.ws + OFF_PV;
  const int* IDS = (const int*)(p.ws + OFF_IDS); const float* GT = (const float*)(p.ws + OFF_GATES);
  const float* MOD = (const float*)(p.ws + OFF_MOD);
  float* Y = p.out + OUT_Y;
  int* s_id = (int*)smem + w * 256;
  float* s_cf = (float*)smem + w * 256 + 128;
  float* s_part = (float*)(smem + 8192);
  const int gi_lo = COOP ? 8 * w : 0, gi_n = COOP ? 8 : 32;
  const size_t ia0 = ((size_t)(lane >> 4) * NT + row) * 16 + (lane & 15), ia1 = ((size_t)(4 + (lane >> 4)) * NT + row) * 16 + (lane & 15);
  s_id[lane] = IDS[ia0]; s_id[64 + lane] = IDS[ia1];
  const float g0 = GT[ia0], g1 = GT[ia1];
  float hf[64];
  {
    const uint4* hp = (const uint4*)(H + (size_t)row * 1024);
#pragma unroll
    for (int i = 0; i < 4; ++i) {
#pragma unroll
      for (int k = 0; k < 2; ++k) {
        const uint4 v = hp[(sl + 16 * i) * 2 + k];
        float* f = hf + i * 16 + k * 8;
        f[0] = bflo(v.x); f[1] = bfhi(v.x); f[2] = bflo(v.y); f[3] = bfhi(v.y); f[4] = bflo(v.z); f[5] = bfhi(v.z); f[6] = bflo(v.w); f[7] = bfhi(v.w);
      }
    }
  }
  asm volatile("s_waitcnt lgkmcnt(0)" ::: "memory");
#pragma unroll 4
  for (int q = 0; q < gi_n; ++q) {
    const int gi = gi_lo + q;
    const int id = s_id[32 * es + gi];
    const uint4* up = (const uint4*)(PU + (size_t)id * 1024);
    float s0 = 0.f, s1 = 0.f;
#pragma unroll
    for (int i = 0; i < 4; ++i) {
      const uint4 a = up[sl + 16 * i];
      const float* f = hf + i * 16;
      s0 = dot4_fp8(a.x, f[0], f[1], f[2], f[3], s0); s1 = dot4_fp8(a.y, f[4], f[5], f[6], f[7], s1);
      s0 = dot4_fp8(a.z, f[8], f[9], f[10], f[11], s0); s1 = dot4_fp8(a.w, f[12], f[13], f[14], f[15], s1);
    }
    const float d = reduce16(s0 + s1) * (1.f / 512.f);
    if (sl == 0) s_cf[32 * es + gi] = d;
  }
  asm volatile("s_waitcnt lgkmcnt(0)" ::: "memory");
  {
    const float d0 = s_cf[lane], d1 = s_cf[64 + lane];
    asm volatile("s_waitcnt lgkmcnt(0)" ::: "memory");
    s_cf[lane] = g0 * (0.5f / 64.f) * d0 * (1.f + erff(d0 * 0.7071067811865476f));
    s_cf[64 + lane] = g1 * (0.5f / 64.f) * d1 * (1.f + erff(d1 * 0.7071067811865476f));
    asm volatile("s_waitcnt lgkmcnt(0)" ::: "memory");
  }
  float y[16];
#pragma unroll
  for (int i = 0; i < 16; ++i) y[i] = 0.f;
#pragma unroll 8
  for (int q = 0; q < 4 * gi_n; ++q) {
    const int e = COOP ? (32 * (q & 3) + gi_lo + (q >> 2)) : q;
    const int id = __builtin_amdgcn_readfirstlane(s_id[e]);
    const float ce = __int_as_float(__builtin_amdgcn_readfirstlane(__float_as_int(s_cf[e])));
    const uint4 a = ((const uint4*)(PV + (size_t)id * 1024))[lane];
    const f32x2_t l0 = __builtin_amdgcn_cvt_pk_f32_fp8((int)a.x, false), h0 = __builtin_amdgcn_cvt_pk_f32_fp8((int)a.x, true);
    const f32x2_t l1 = __builtin_amdgcn_cvt_pk_f32_fp8((int)a.y, false), h1 = __builtin_amdgcn_cvt_pk_f32_fp8((int)a.y, true);
    const f32x2_t l2 = __builtin_amdgcn_cvt_pk_f32_fp8((int)a.z, false), h2 = __builtin_amdgcn_cvt_pk_f32_fp8((int)a.z, true);
    const f32x2_t l3 = __builtin_amdgcn_cvt_pk_f32_fp8((int)a.w, false), h3 = __builtin_amdgcn_cvt_pk_f32_fp8((int)a.w, true);
    y[0] += ce * l0.x; y[1] += ce * l0.y; y[2] += ce * h0.x; y[3] += ce * h0.y;
    y[4] += ce * l1.x; y[5] += ce * l1.y; y[6] += ce * h1.x; y[7] += ce * h1.y;
    y[8] += ce * l2.x; y[9] += ce * l2.y; y[10] += ce * h2.x; y[11] += ce * h2.y;
    y[12] += ce * l3.x; y[13] += ce * l3.y; y[14] += ce * h3.x; y[15] += ce * h3.y;
  }
  asm volatile("s_waitcnt lgkmcnt(0)" ::: "memory");
  if (COOP) {
    __syncthreads();
#pragma unroll
    for (int k = 0; k < 4; ++k) *(float4*)(s_part + w * 1024 + lane * 16 + k * 4) = make_float4(y[4 * k], y[4 * k + 1], y[4 * k + 2], y[4 * k + 3]);
    __syncthreads();
    if (w != 0) return;
#pragma unroll
    for (int k = 0; k < 4; ++k) {
      const float4 b1 = *(const float4*)(s_part + 1024 + lane * 16 + k * 4), b2 = *(const float4*)(s_part + 2048 + lane * 16 + k * 4),
                   b3 = *(const float4*)(s_part + 3072 + lane * 16 + k * 4);
      y[4 * k] += b1.x + b2.x + b3.x; y[4 * k + 1] += b1.y + b2.y + b3.y; y[4 * k + 2] += b1.z + b2.z + b3.z; y[4 * k + 3] += b1.w + b2.w + b3.w;
    }
  }
  float* yr = Y + (size_t)row * 1024;
  const float* mr = MOD + (size_t)mod_row(row) * 6144 + 5120;
  float v[16];
  float s = 0.f;
#pragma unroll
  for (int k = 0; k < 4; ++k) {
    const int c = lane * 16 + k * 4;
    const float4 x1 = *(const float4*)(yr + c), g2 = *(const float4*)(mr + c);
    const int o = k * 4;
    v[o] = ALPHA * x1.x + g2.x * y[o]; v[o + 1] = ALPHA * x1.y + g2.y * y[o + 1];
    v[o + 2] = ALPHA * x1.z + g2.z * y[o + 2]; v[o + 3] = ALPHA * x1.w + g2.w * y[o + 3];
    s += v[o] + v[o + 1] + v[o + 2] + v[o + 3];
  }
  const float mu = wave_sum(s) * (1.f / 1024.f);
  float q2 = 0.f;
#pragma unroll
  for (int i = 0; i < 16; ++i) { float d = v[i] - mu; q2 += d * d; }
  const float rstd = rsqrtf(wave_sum(q2) * (1.f / 1024.f) + LN_EPS);
#pragma unroll
  for (int k = 0; k < 4; ++k) {
    const int c = lane * 16 + k * 4;
    const float4 gg = *(const float4*)(P_L2G(p) + c), bb = *(const float4*)(P_L2B(p) + c);
    const int o = k * 4;
    *(float4*)(yr + c) = make_float4((v[o] - mu) * rstd * gg.x + bb.x, (v[o + 1] - mu) * rstd * gg.y + bb.y,
                                     (v[o + 2] - mu) * rstd * gg.z + bb.z, (v[o + 3] - mu) * rstd * gg.w + bb.w);
  }
}
__device__ __forceinline__ void phase_J(const Params& p, unsigned char* smem) {
  const int tid = threadIdx.x, lane = tid & 63, w = tid >> 6;
  const int nw = gridDim.x * 4;
  const int main_rows = (NT / nw) * nw;
  for (int row = blockIdx.x * 4 + w; row < main_rows; row += nw) peer_token<false>(p, smem, row, w, lane);
  __syncthreads();
  for (int row = main_rows + blockIdx.x; row < NT; row += gridDim.x) peer_token<true>(p, smem, row, w, lane);
}

#define XB_TMO      128
#define XB_XCNT(j)  (256  + 64 * (j))
#define XB_XSUB(j)  (1280 + 64 * (j))
#define XB_XGEN(j)  (2304 + 64 * (j))
#define XB_TOP      3328
#define XB_TOPGEN   3392
#define XCD_BAR_WORDS 3456
#define XB_SPIN_CAP (1u << 22)
#define LAS __attribute__((address_space(3)))
__device__ __forceinline__ unsigned xb_ld(unsigned* p)              { return __hip_atomic_load(p, __ATOMIC_RELAXED, __HIP_MEMORY_SCOPE_AGENT); }
__device__ __forceinline__ unsigned xb_add(unsigned* p, unsigned v) { return __hip_atomic_fetch_add(p, v, __ATOMIC_RELAXED, __HIP_MEMORY_SCOPE_AGENT); }
__device__ __forceinline__ unsigned xb_xcc_id() { return (unsigned)__builtin_amdgcn_s_getreg((3 << 11) | 20) & 0xFu; }
#define XB_SPIN(cond, bar) do { unsigned _sp = 0; while (cond) { __builtin_amdgcn_s_sleep(1); \
    if ((++_sp & 255u) == 0u) { if (xb_ld(&(bar)[XB_TMO])) break; if (_sp > XB_SPIN_CAP) { atomicAdd(&(bar)[XB_TMO], 1u); break; } } } } while (0)
struct XcdBarrier { unsigned* bar; unsigned x; volatile LAS unsigned* st; };
__device__ __forceinline__ XcdBarrier xcd_barrier_post(unsigned* bar, volatile LAS unsigned* st) {
    XcdBarrier b; b.bar = bar; b.x = xb_xcc_id(); b.st = st;
    if (threadIdx.x == 0) (void)xb_add(&bar[XB_XCNT(b.x)], 1u);
    return b;
}
__device__ __forceinline__ void xcd_barrier_complete(unsigned* bar, unsigned x, unsigned& nloc, unsigned& nx) {
    const unsigned G = gridDim.x * gridDim.y * gridDim.z;
    unsigned sum, cnt, mine, sp = 0u;
    for (;;) {
        sum = 0u; cnt = 0u; mine = 0u;
#pragma unroll
        for (unsigned j = 0; j < 16; ++j) { const unsigned c = xb_ld(&bar[XB_XCNT(j)]); sum += c; cnt += (c > 0u) ? 1u : 0u; mine = (j == x) ? c : mine; }
        if (sum == G) break;
        __builtin_amdgcn_s_sleep(1);
        if ((++sp & 255u) == 0u) { if (xb_ld(&bar[XB_TMO])) break; if (sp > XB_SPIN_CAP) { atomicAdd(&bar[XB_TMO], 1u); break; } }
    }
    nloc = mine > 0u ? mine : 1u; nx = cnt > 0u ? cnt : 1u;
}
__device__ __forceinline__ void xcd_barrier(const XcdBarrier& b) {
    asm volatile("s_waitcnt vmcnt(0)" ::: "memory");
    __syncthreads();
    if (threadIdx.x == 0) {
        unsigned* bar = b.bar;
        __builtin_amdgcn_s_waitcnt(0);
        unsigned nloc = b.st[0], nx = b.st[1];
        if (nloc == 0u) { xcd_barrier_complete(bar, b.x, nloc, nx); b.st[0] = nloc; b.st[1] = nx; }
        const unsigned old = xb_add(&bar[XB_XSUB(b.x)], 1u);
        const unsigned gen = old / nloc;
        if (old + 1u == (gen + 1u) * nloc) {
            __builtin_amdgcn_fence(__ATOMIC_RELEASE, "agent");
            asm volatile("s_waitcnt vmcnt(0)" ::: "memory");
            const unsigned og = xb_add(&bar[XB_TOP], 1u);
            const unsigned tg = og / nx;
            if (og + 1u == (tg + 1u) * nx) xb_add(&bar[XB_TOPGEN], 1u);
            else XB_SPIN(xb_ld(&bar[XB_TOPGEN]) == tg, bar);
            __builtin_amdgcn_fence(__ATOMIC_ACQUIRE, "agent");
            xb_add(&bar[XB_XGEN(b.x)], 1u);
            asm volatile("s_waitcnt vmcnt(0)" ::: "memory");
        } else {
            XB_SPIN(xb_ld(&bar[XB_XGEN(b.x)]) == gen, bar);
            __builtin_amdgcn_fence(__ATOMIC_ACQUIRE, "agent");
            asm volatile("s_waitcnt vmcnt(0)" ::: "memory");
        }
    }
    __syncthreads();
}
#define gsync(grid) xcd_barrier(xb)
__global__ void __launch_bounds__(256, 2) fwd_megakernel(Params p) {
  cg::grid_group grid = cg::this_grid();
  __shared__ __attribute__((aligned(16))) unsigned char smem[SM_TOTAL];
  __shared__ uint4 xb_words;
  if (threadIdx.x == 0) xb_words = make_uint4(0u, 0u, 0u, 0u);
  __syncthreads();
  XcdBarrier xb = xcd_barrier_post((unsigned*)(p.ws + OFF_BAR), (volatile LAS unsigned*)&xb_words);
  grid.sync();
#ifndef ONLY
#define ONLY 0xFFF
#endif
  if (ONLY & 1) phase_A(p, smem);  gsync(grid);
  if (ONLY & 2) phase_B(p);        gsync(grid);
  if (ONLY & 4) phase_C(p, smem);  gsync(grid);
  if (ONLY & 8) phase_D1(p, smem); gsync(grid);
  if (ONLY & 16) phase_D2(p);       gsync(grid);
  if (ONLY & 32) phase_D3(p, smem); gsync(grid);
  if (ONLY & 64) phase_E(p, smem);  gsync(grid);
  if (ONLY & 128) phase_F(p, smem);  gsync(grid);
  if (ONLY & 256) phase_G(p);        gsync(grid);
  if (ONLY & 512) phase_H(p, smem);  gsync(grid);
  if (ONLY & 1024) phase_I(p, smem);  gsync(grid);
  if (ONLY & 2048) phase_J(p, smem);
}

extern "C" void kernel_launch(void* const* d_in, const int* in_sizes, int n_in, void* d_out,
                              int out_size, void* d_ws, size_t ws_size, hipStream_t stream) {
  static int grid_blocks = 0;
  if (!grid_blocks) {
    int dev = 0, cus = 0, per_cu = 0;
    hipGetDevice(&dev);
    hipDeviceGetAttribute(&cus, hipDeviceAttributeMultiprocessorCount, dev);
    hipOccupancyMaxActiveBlocksPerMultiprocessor(&per_cu, fwd_megakernel, 256, 0);
    if (per_cu > 2) per_cu = 2;
    if (per_cu < 1) per_cu = 1;
    grid_blocks = cus * per_cu;
  }
  if (ws_size < WS_TOTAL) fprintf(stderr, "workspace too small: %zu < %zu\n", ws_size, (size_t)WS_TOTAL);
  Params p{};
  const float* const* in = (const float* const*)d_in;
  p.x_prompt = in[0]; p.x_sample = in[1]; p.c_prompt = in[2]; p.c_sample = in[3];
  p.st_C = in[4]; p.st_n = in[5]; p.st_m = in[6]; p.st_pool = in[7];
  p.w_mod = in[8]; p.b_mod = in[9]; p.w_in = in[10]; p.b_in = in[11]; p.b_fgate = in[12]; p.gn_gain = in[13];
  p.w_pool = in[14]; p.pool_scale = in[15]; p.w_a = in[16]; p.w_b = in[17]; p.w_out = in[18];
  p.ln1_g = in[19]; p.ln1_b = in[20]; p.w_pq = in[21]; p.subkeys = in[22]; p.peer_u = in[23]; p.peer_v = in[24];
  p.ln2_g = in[25]; p.ln2_b = in[26];
  p.out = (float*)d_out; p.ws = (unsigned char*)d_ws;
  hipMemsetAsync((unsigned char*)d_ws + OFF_BAR, 0, 16384, stream);
  void* args[] = {&p};
  hipError_t e = hipLaunchCooperativeKernel((void*)fwd_megakernel, dim3(grid_blocks), dim3(256), args, 0, stream);
  if (e != hipSuccess) fprintf(stderr, "cooperative launch failed: %s (grid %d)\n", hipGetErrorString(e), grid_blocks);
}
```

```cpp
#include <hip/hip_runtime.h>
#include <hip/hip_cooperative_groups.h>
#include <cstdio>
namespace cg = cooperative_groups;

typedef unsigned short bf16_t;
typedef __attribute__((ext_vector_type(8))) short bf16x8;
typedef __attribute__((ext_vector_type(16))) float f32x16;
typedef __attribute__((ext_vector_type(4))) float f32x4;
typedef __attribute__((ext_vector_type(2))) __bf16 bf16x2_t;

#define NT 16512
#define NP 16384
#define DM 1024
#define NIN 4616
#define ALPHA 1.189207115002721f
#define LN_EPS 1e-5f

constexpr size_t OFF_WIN   = 0;
constexpr size_t OFF_WA    = OFF_WIN + 9453568;
constexpr size_t OFF_WB    = OFF_WA + 1048576;
constexpr size_t OFF_WOUT  = OFF_WB + 1048576;
constexpr size_t OFF_WPQ   = OFF_WOUT + 2097152;
constexpr size_t OFF_WPOOL = OFF_WPQ + 4194304;
constexpr size_t OFF_SUBK  = OFF_WPOOL + 131072;
constexpr size_t OFF_PU    = OFF_SUBK + 65536;
constexpr size_t OFF_PV    = OFF_PU + 33554432;
constexpr size_t OFF_MOD   = OFF_PV + 33554432;
constexpr size_t OFF_H     = OFF_MOD + 3342336;
constexpr size_t OFF_Q     = OFF_H + 33816576;
constexpr size_t OFF_K     = OFF_Q + 16908288;
constexpr size_t OFF_V     = OFF_K + 16908288;
constexpr size_t OFF_O     = OFF_V + 16908288;
constexpr size_t OFF_PQ    = OFF_Q;
constexpr size_t OFF_KT    = OFF_O + 16908288;
constexpr size_t OFF_VT    = OFF_KT + 16777216;
constexpr size_t OFF_IDS   = OFF_KT;
constexpr size_t OFF_GATES = OFF_KT + 8454144;
constexpr size_t OFF_IG    = OFF_VT + 16777216;
constexpr size_t OFF_LF    = OFF_IG + 264192;
constexpr size_t OFF_U     = OFF_LF + 264192;
constexpr size_t OFF_CT    = OFF_U;
constexpr size_t OFF_MERGED= OFF_U;
constexpr size_t OFF_CHB   = OFF_U + 33816576;
constexpr size_t OFF_MPREV = OFF_CHB + 65536;
constexpr size_t OFF_NLOC  = OFF_MPREV + 65536;
constexpr size_t OFF_NPREV = OFF_NLOC + 262144;
constexpr size_t OFF_BAR   = OFF_NPREV + 262144;
constexpr size_t OFF_CB    = OFF_BAR + 16384;
constexpr size_t WS_TOTAL  = OFF_CB + 40960;
#define CB_(p) ((const float*)((p).ws + OFF_CB))
#define P_BIN(p) (CB_(p) + 0)
#define P_FG(p)  (CB_(p) + 4624)
#define P_GN(p)  (CB_(p) + 4632)
#define P_PS(p)  (CB_(p) + 5144)
#define P_L1G(p) (CB_(p) + 5656)
#define P_L1B(p) (CB_(p) + 6680)
#define P_L2G(p) (CB_(p) + 7704)
#define P_L2B(p) (CB_(p) + 8728)

constexpr size_t OUT_Y   = 0;
constexpr size_t OUT_CP  = 16908288;
constexpr size_t OUT_NP  = 17432576;
constexpr size_t OUT_MP  = 17436672;
constexpr size_t OUT_PP  = 17436704;
constexpr size_t OUT_CS  = 17498144;
constexpr size_t OUT_NS  = 25886752;
constexpr size_t OUT_MS  = 25952288;
constexpr size_t OUT_PS  = 25952800;
constexpr size_t OUT_SBUF = 0;
constexpr size_t OUT_PB   = 9000000;

#define LS 72
#define LW 136
#define SM_A 0
#define SM_B 18432
#define SM_W 36864
#define SM_MISC 71680
#define SM_TOTAL 75776

struct Params {
  const float *x_prompt, *x_sample, *c_prompt, *c_sample, *st_C, *st_n, *st_m, *st_pool;
  const float *w_mod, *b_mod, *w_in, *b_in, *b_fgate, *gn_gain, *w_pool, *pool_scale, *w_a, *w_b, *w_out;
  const float *ln1_g, *ln1_b, *w_pq, *subkeys, *peer_u, *peer_v, *ln2_g, *ln2_b;
  float* out;
  unsigned char* ws;
};

__device__ __forceinline__ bf16_t f2bf(float f) {
  unsigned u = __float_as_uint(f);
  u += 0x7FFFu + ((u >> 16) & 1u);
  return (bf16_t)(u >> 16);
}
__device__ __forceinline__ float bf2f(bf16_t h) { return __uint_as_float(((unsigned)h) << 16); }
__device__ __forceinline__ unsigned pack2(float a, float b) { return (unsigned)f2bf(a) | ((unsigned)f2bf(b) << 16); }
__device__ __forceinline__ float bflo(unsigned u) { return __uint_as_float(u << 16); }
__device__ __forceinline__ float bfhi(unsigned u) { return __uint_as_float(u & 0xFFFF0000u); }
__device__ __forceinline__ float sigmoidf_(float x) { return 1.f / (1.f + __expf(-x)); }
__device__ __forceinline__ float logsigmoidf_(float x) { return fminf(x, 0.f) - log1pf(__expf(-fabsf(x))); }
__device__ __forceinline__ float wave_sum(float v) {
#pragma unroll
  for (int o = 32; o > 0; o >>= 1) v += __shfl_xor(v, o);
  return v;
}
__device__ __forceinline__ float dot2bf(unsigned a, unsigned b, float acc) {
  return __builtin_amdgcn_fdot2_f32_bf16(__builtin_bit_cast(bf16x2_t, a), __builtin_bit_cast(bf16x2_t, b), acc, false);
}
__device__ __forceinline__ int mod_row(int row) { return row < NP ? (row >> 11) : (8 + row - NP); }
__device__ __forceinline__ const float* x_row(const Params& p, int row) {
  return row < NP ? p.x_prompt + (size_t)row * DM : p.x_sample + (size_t)(row - NP) * DM;
}

typedef __attribute__((ext_vector_type(4))) unsigned u32x4;
struct Stage4 { u32x4 v0, v1, v2, v3; };
__device__ __forceinline__ Stage4 g_load4(const bf16_t* __restrict__ A, int lda, int k0, int tid) {
  const int row = tid >> 3, kc = tid & 7;
  const bf16_t* b = A + (size_t)row * lda + k0 + kc * 8;
  Stage4 r;
  r.v0 = *(const u32x4*)(b);
  r.v1 = *(const u32x4*)(b + (size_t)32 * lda);
  r.v2 = *(const u32x4*)(b + (size_t)64 * lda);
  r.v3 = *(const u32x4*)(b + (size_t)96 * lda);
  return r;
}
__device__ __forceinline__ void s_store4(bf16_t* s, const Stage4& r, int tid) {
  const int row = tid >> 3, kc = tid & 7;
  bf16_t* b = s + row * LS + kc * 8;
  *(u32x4*)(b) = r.v0;
  *(u32x4*)(b + 32 * LS) = r.v1;
  *(u32x4*)(b + 64 * LS) = r.v2;
  *(u32x4*)(b + 96 * LS) = r.v3;
}
__device__ __forceinline__ u32x4 scale8(u32x4 v, const float* f) {
  u32x4 o;
  o.x = pack2(bflo(v.x) * f[0], bfhi(v.x) * f[1]);
  o.y = pack2(bflo(v.y) * f[2], bfhi(v.y) * f[3]);
  o.z = pack2(bflo(v.z) * f[4], bfhi(v.z) * f[5]);
  o.w = pack2(bflo(v.w) * f[6], bfhi(v.w) * f[7]);
  return o;
}
__device__ __forceinline__ void s_store4_scaled(bf16_t* s, const Stage4& r, int tid, const float* ksc) {
  const int row = tid >> 3, kc = tid & 7;
  bf16_t* b = s + row * LS + kc * 8;
  const float* f = ksc + kc * 8;
  *(u32x4*)(b) = scale8(r.v0, f);
  *(u32x4*)(b + 32 * LS) = scale8(r.v1, f);
  *(u32x4*)(b + 64 * LS) = scale8(r.v2, f);
  *(u32x4*)(b + 96 * LS) = scale8(r.v3, f);
}
__device__ __forceinline__ void mma_ktile(const bf16_t* As, int a_stride, const bf16_t* Bs, int b_stride, int nk16,
                                          f32x16 (&acc)[2][2], int wm, int wn, int lane) {
  const int r = lane & 31, h = lane >> 5;
  const bf16_t* ap = As + (wm * 64 + r) * a_stride + h * 8;
  const bf16_t* bp = Bs + (wn * 64 + r) * b_stride + h * 8;
#pragma unroll
  for (int ks = 0; ks < nk16; ++ks) {
    bf16x8 a0 = *(const bf16x8*)(ap + ks * 16);
    bf16x8 a1 = *(const bf16x8*)(ap + 32 * a_stride + ks * 16);
    bf16x8 b0 = *(const bf16x8*)(bp + ks * 16);
    bf16x8 b1 = *(const bf16x8*)(bp + 32 * b_stride + ks * 16);
    acc[0][0] = __builtin_amdgcn_mfma_f32_32x32x16_bf16(a0, b0, acc[0][0], 0, 0, 0);
    acc[0][1] = __builtin_amdgcn_mfma_f32_32x32x16_bf16(a0, b1, acc[0][1], 0, 0, 0);
    acc[1][0] = __builtin_amdgcn_mfma_f32_32x32x16_bf16(a1, b0, acc[1][0], 0, 0, 0);
    acc[1][1] = __builtin_amdgcn_mfma_f32_32x32x16_bf16(a1, b1, acc[1][1], 0, 0, 0);
  }
  __builtin_amdgcn_sched_group_barrier(0x100, 4, 0);
#pragma unroll
  for (int ks = 0; ks + 1 < nk16; ++ks) {
    __builtin_amdgcn_sched_group_barrier(0x008, 1, 0); __builtin_amdgcn_sched_group_barrier(0x100, 1, 0);
    __builtin_amdgcn_sched_group_barrier(0x008, 1, 0); __builtin_amdgcn_sched_group_barrier(0x100, 1, 0);
    __builtin_amdgcn_sched_group_barrier(0x008, 1, 0); __builtin_amdgcn_sched_group_barrier(0x100, 1, 0);
    __builtin_amdgcn_sched_group_barrier(0x008, 1, 0); __builtin_amdgcn_sched_group_barrier(0x100, 1, 0);
  }
  __builtin_amdgcn_sched_group_barrier(0x008, 4, 0);
}
template <bool SCALE_A>
__device__ __forceinline__ void gemm_gg(const bf16_t* __restrict__ A, int lda, const bf16_t* __restrict__ Bt, int ldb, int K,
                                        unsigned char* smem, f32x16 (&acc)[2][2], const float* ksc) {
  const int tid = threadIdx.x, lane = tid & 63, w = tid >> 6, wm = w >> 1, wn = w & 1;
  bf16_t* sA = (bf16_t*)(smem + SM_A);
  bf16_t* sB = (bf16_t*)(smem + SM_B);
  Stage4 ra = g_load4(A, lda, 0, tid);
  Stage4 rb = g_load4(Bt, ldb, 0, tid);
  for (int k0 = 0; k0 < K; k0 += 64) {
    __syncthreads();
    if (SCALE_A) s_store4_scaled(sA, ra, tid, ksc + k0); else s_store4(sA, ra, tid);
    s_store4(sB, rb, tid);
    __syncthreads();
    if (k0 + 64 < K) { ra = g_load4(A, lda, k0 + 64, tid); rb = g_load4(Bt, ldb, k0 + 64, tid); }
    mma_ktile(sA, LS, sB, LS, 4, acc, wm, wn, lane);
  }
}
#define SM_B128 34816
struct Stage8 { u32x4 v0, v1, v2, v3, v4, v5, v6, v7; };
__device__ __forceinline__ Stage8 g_load8(const bf16_t* __restrict__ A, int lda, int k0, int tid) {
  const int row = tid >> 4, kc = tid & 15;
  const bf16_t* b = A + (size_t)row * lda + k0 + kc * 8;
  Stage8 r;
  r.v0 = *(const u32x4*)(b);
  r.v1 = *(const u32x4*)(b + (size_t)16 * lda);
  r.v2 = *(const u32x4*)(b + (size_t)32 * lda);
  r.v3 = *(const u32x4*)(b + (size_t)48 * lda);
  r.v4 = *(const u32x4*)(b + (size_t)64 * lda);
  r.v5 = *(const u32x4*)(b + (size_t)80 * lda);
  r.v6 = *(const u32x4*)(b + (size_t)96 * lda);
  r.v7 = *(const u32x4*)(b + (size_t)112 * lda);
  return r;
}
__device__ __forceinline__ void s_store8(bf16_t* s, const Stage8& r, int tid) {
  const int row = tid >> 4, kc = tid & 15;
  bf16_t* b = s + row * LW + kc * 8;
  *(u32x4*)(b) = r.v0;
  *(u32x4*)(b + 16 * LW) = r.v1;
  *(u32x4*)(b + 32 * LW) = r.v2;
  *(u32x4*)(b + 48 * LW) = r.v3;
  *(u32x4*)(b + 64 * LW) = r.v4;
  *(u32x4*)(b + 80 * LW) = r.v5;
  *(u32x4*)(b + 96 * LW) = r.v6;
  *(u32x4*)(b + 112 * LW) = r.v7;
}
__device__ __forceinline__ void gemm_gg128(const bf16_t* __restrict__ A, int lda, const bf16_t* __restrict__ Bt, int ldb, int K,
                                           unsigned char* smem, f32x16 (&acc)[2][2]) {
  const int tid = threadIdx.x, lane = tid & 63, w = tid >> 6, wm = w >> 1, wn = w & 1;
  bf16_t* sA = (bf16_t*)(smem);
  bf16_t* sB = (bf16_t*)(smem + SM_B128);
  Stage8 ra = g_load8(A, lda, 0, tid);
  Stage8 rb = g_load8(Bt, ldb, 0, tid);
  for (int k0 = 0; k0 < K; k0 += 128) {
    __syncthreads();
    s_store8(sA, ra, tid);
    s_store8(sB, rb, tid);
    __syncthreads();
    if (k0 + 128 < K) { ra = g_load8(A, lda, k0 + 128, tid); rb = g_load8(Bt, ldb, k0 + 128, tid); }
    mma_ktile(sA, LW, sB, LW, 8, acc, wm, wn, lane);
  }
}
__device__ __forceinline__ void gemm_sg(const bf16_t* sW, const bf16_t* __restrict__ Bt, int ldb, int K,
                                        unsigned char* smem, f32x16 (&acc)[2][2]) {
  const int tid = threadIdx.x, lane = tid & 63, w = tid >> 6, wm = w >> 1, wn = w & 1;
  bf16_t* sB = (bf16_t*)(smem + SM_B);
  Stage4 rb = g_load4(Bt, ldb, 0, tid);
  for (int k0 = 0; k0 < K; k0 += 64) {
    __syncthreads();
    s_store4(sB, rb, tid);
    __syncthreads();
    if (k0 + 64 < K) rb = g_load4(Bt, ldb, k0 + 64, tid);
    mma_ktile(sW + k0, LW, sB, LS, 4, acc, wm, wn, lane);
  }
}
#define ZERO_ACC(acc) _Pragma("unroll") for (int _i = 0; _i < 2; ++_i) _Pragma("unroll") for (int _j = 0; _j < 2; ++_j) _Pragma("unroll") for (int _r = 0; _r < 16; ++_r) acc[_i][_j][_r] = 0.f;

#define EPI_QUADS(acc, ...)                                                       \
  _Pragma("unroll") for (int mi = 0; mi < 2; ++mi)                                \
  _Pragma("unroll") for (int ni = 0; ni < 2; ++ni)                                \
  _Pragma("unroll") for (int g = 0; g < 4; ++g) {                                 \
    const int lrow0 = wm * 64 + mi * 32 + 8 * g + 4 * (lane >> 5);                \
    const int lcol = wn * 64 + ni * 32 + (lane & 31);                             \
    const float v0 = acc[mi][ni][4 * g], v1 = acc[mi][ni][4 * g + 1];             \
    const float v2 = acc[mi][ni][4 * g + 2], v3 = acc[mi][ni][4 * g + 3];         \
    (void)v0; (void)v1; (void)v2; (void)v3; (void)lrow0; (void)lcol;              \
    __VA_ARGS__ }

__device__ __forceinline__ void skinny16x32(const bf16_t* __restrict__ A, int lda, const bf16_t* __restrict__ Bt, int ldb, int K,
                                            f32x4& c0, f32x4& c1, int lane) {
  const int r = lane & 15, q = lane >> 4;
  const bf16_t* ap = A + (size_t)r * lda + q * 8;
  const bf16_t* bp0 = Bt + (size_t)r * ldb + q * 8;
  const bf16_t* bp1 = Bt + (size_t)(16 + r) * ldb + q * 8;
#pragma unroll 8
  for (int k0 = 0; k0 < K; k0 += 32) {
    const bf16x8 a = *(const bf16x8*)(ap + k0);
    const bf16x8 b0 = *(const bf16x8*)(bp0 + k0);
    const bf16x8 b1 = *(const bf16x8*)(bp1 + k0);
    c0 = __builtin_amdgcn_mfma_f32_16x16x32_bf16(a, b0, c0, 0, 0, 0);
    c1 = __builtin_amdgcn_mfma_f32_16x16x32_bf16(a, b1, c1, 0, 0, 0);
  }
}

template <int NACC>
__device__ __forceinline__ void wave4_reduce(f32x4 (&a)[NACC], unsigned char* smem, int w, int lane) {
  float* red = (float*)smem;
  __syncthreads();
#pragma unroll
  for (int i = 0; i < NACC; ++i)
#pragma unroll
    for (int j = 0; j < 4; ++j) red[((w * NACC + i) * 4 + j) * 64 + lane] = a[i][j];
  __syncthreads();
  if (w == 0) {
#pragma unroll
    for (int i = 0; i < NACC; ++i)
#pragma unroll
      for (int j = 0; j < 4; ++j)
        a[i][j] = red[((0 * NACC + i) * 4 + j) * 64 + lane] + red[((1 * NACC + i) * 4 + j) * 64 + lane] +
                  red[((2 * NACC + i) * 4 + j) * 64 + lane] + red[((3 * NACC + i) * 4 + j) * 64 + lane];
  }
}

__device__ __forceinline__ void xcd_tile(int q, int NN, int& mt, int& nt) {
  const int x = blockIdx.x & 7, npan = NN >> 3, p = q >> 6, wi = q & 63;
  mt = x * 16 + (p / npan) * 8 + (wi >> 3);
  nt = (p % npan) * 8 + (wi & 7);
}

#define TID_VARS const int tid = threadIdx.x, lane = tid & 63, w = tid >> 6, wm = w >> 1, wn = w & 1; (void)lane; (void)wm; (void)wn;

template <bool REMAP>
__device__ __forceinline__ void transpose_tile(const float* __restrict__ src, int K, int N, bf16_t* __restrict__ dst,
                                               int kt, int nt, unsigned char* smem) {
  float* sm = (float*)smem;
  const int tid = threadIdx.x; const int k0 = kt * 64, n0 = nt * 64;
  __syncthreads();
#pragma unroll
  for (int ib = 0; ib < 16; ib += 8) {
    float tv[8];
#pragma unroll
    for (int i = 0; i < 8; ++i) {
      int idx = tid + 256 * (ib + i); int r = idx >> 6, c = idx & 63; int n = n0 + c;
      tv[i] = (n < N) ? src[(size_t)(k0 + r) * N + n] : 0.f;
    }
#pragma unroll
    for (int i = 0; i < 8; ++i) {
      int idx = tid + 256 * (ib + i); int r = idx >> 6, c = idx & 63;
      sm[r * 65 + c] = tv[i];
    }
  }
  __syncthreads();
#pragma unroll 4
  for (int i = 0; i < 8; ++i) {
    int idx = tid + 256 * i; int r = idx >> 5, cp = idx & 31; int n = n0 + r;
    int nd = n;
    if (REMAP) { if (n >= 2048 && n < 2056) nd = n + 512; else if (n >= 2056 && n < 2568) nd = n - 8; }
    if (n < N) *(unsigned*)(dst + (size_t)nd * K + k0 + 2 * cp) = pack2(sm[(2 * cp) * 65 + r], sm[(2 * cp + 1) * 65 + r]);
  }
}
__device__ __forceinline__ void convert_chunk(const float* __restrict__ src, bf16_t* __restrict__ dst, size_t base) {
  const int tid = threadIdx.x;
#pragma unroll
  for (int i = 0; i < 8; ++i) {
    size_t e = base + (size_t)(tid + 256 * i) * 8;
    float4 a = *(const float4*)(src + e), b = *(const float4*)(src + e + 4);
    uint4 o; o.x = pack2(a.x, a.y); o.y = pack2(a.z, a.w); o.z = pack2(b.x, b.y); o.w = pack2(b.z, b.w);
    *(uint4*)(dst + e) = o;
  }
}
typedef __attribute__((ext_vector_type(2))) float f32x2_t;
__device__ __forceinline__ unsigned pack4_fp8(float a, float b, float c, float d) {
  int r = __builtin_amdgcn_cvt_pk_fp8_f32(a, b, 0, false);
  r = __builtin_amdgcn_cvt_pk_fp8_f32(c, d, r, true);
  return (unsigned)r;
}
__device__ __forceinline__ void convert_chunk_fp8(const float* __restrict__ src, unsigned char* __restrict__ dst, size_t base, float scale) {
  const int tid = threadIdx.x;
#pragma unroll
  for (int i = 0; i < 4; ++i) {
    size_t e = base + (size_t)(tid + 256 * i) * 16;
    float4 a = *(const float4*)(src + e), b = *(const float4*)(src + e + 4), c = *(const float4*)(src + e + 8), d = *(const float4*)(src + e + 12);
    uint4 o;
    o.x = pack4_fp8(a.x * scale, a.y * scale, a.z * scale, a.w * scale);
    o.y = pack4_fp8(b.x * scale, b.y * scale, b.z * scale, b.w * scale);
    o.z = pack4_fp8(c.x * scale, c.y * scale, c.z * scale, c.w * scale);
    o.w = pack4_fp8(d.x * scale, d.y * scale, d.z * scale, d.w * scale);
    *(uint4*)(dst + e) = o;
  }
}
__device__ __forceinline__ void mod_slab(const Params& p, int item, unsigned char* smem) {
  const int tid = threadIdx.x, lane = tid & 63, w = tid >> 6;
  const int n0 = item * 16, nl = lane & 15, kq = lane >> 4;
  f32x4 acc[9];
#pragma unroll
  for (int i = 0; i < 9; ++i) acc[i] = (f32x4){0.f, 0.f, 0.f, 0.f};
  for (int ks = 0; ks < 8; ++ks) {
    const int kb = w * 256 + ks * 32 + kq * 8;
    bf16x8 b;
#pragma unroll
    for (int j = 0; j < 8; ++j) b[j] = (short)f2bf(p.w_mod[(size_t)(kb + j) * 6144 + n0 + nl]);
#pragma unroll
    for (int mi = 0; mi < 9; ++mi) {
      int row = mi * 16 + nl; if (row > 135) row = 135;
      const float* cp = (row < 8) ? p.c_prompt + row * 1024 : p.c_sample + (row - 8) * 1024;
      float4 x0 = *(const float4*)(cp + kb), x1 = *(const float4*)(cp + kb + 4);
      bf16x8 a;
      a[0] = (short)f2bf(x0.x * sigmoidf_(x0.x)); a[1] = (short)f2bf(x0.y * sigmoidf_(x0.y));
      a[2] = (short)f2bf(x0.z * sigmoidf_(x0.z)); a[3] = (short)f2bf(x0.w * sigmoidf_(x0.w));
      a[4] = (short)f2bf(x1.x * sigmoidf_(x1.x)); a[5] = (short)f2bf(x1.y * sigmoidf_(x1.y));
      a[6] = (short)f2bf(x1.z * sigmoidf_(x1.z)); a[7] = (short)f2bf(x1.w * sigmoidf_(x1.w));
      acc[mi] = __builtin_amdgcn_mfma_f32_16x16x32_bf16(a, b, acc[mi], 0, 0, 0);
    }
  }
  float* red = (float*)smem;
  __syncthreads();
#pragma unroll
  for (int mi = 0; mi < 9; ++mi)
#pragma unroll
    for (int r = 0; r < 4; ++r) red[(w * 36 + mi * 4 + r) * 64 + lane] = acc[mi][r];
  __syncthreads();
  float* MOD = (float*)(p.ws + OFF_MOD);
  for (int i = 0; i < 9; ++i) {
    int idx = tid + 256 * i; int e = idx >> 6, l = idx & 63;
    float s = red[(0 * 36 + e) * 64 + l] + red[(1 * 36 + e) * 64 + l] + red[(2 * 36 + e) * 64 + l] + red[(3 * 36 + e) * 64 + l];
    int mi = e >> 2, r = e & 3; int row = mi * 16 + (l >> 4) * 4 + r; int col = n0 + (l & 15);
    if (row < 136) MOD[(size_t)row * 6144 + col] = s + p.b_mod[col];
  }
}
__device__ __forceinline__ void phase_A(const Params& p, unsigned char* smem) {
  const int n_items = 384 + 1168 + 128 + 128 + 256 + 512 + 16 + 1024 + 1024 + 2 + 128 + 1;
  for (int it = blockIdx.x; it < n_items; it += gridDim.x) {
    int i = it;
    if (i == n_items - 1) {
      float* cb = (float*)(p.ws + OFF_CB);
      const int tid = threadIdx.x;
      for (int k = tid; k < 4616; k += 256) cb[k] = p.b_in[k];
      if (tid < 4) cb[4624 + tid] = p.b_fgate[tid];
      for (int k = tid; k < 512; k += 256) { cb[4632 + k] = p.gn_gain[k]; cb[5144 + k] = p.pool_scale[k]; }
      for (int k = tid; k < 1024; k += 256) { cb[5656 + k] = p.ln1_g[k]; cb[6680 + k] = p.ln1_b[k]; cb[7704 + k] = p.ln2_g[k]; cb[8728 + k] = p.ln2_b[k]; }
      continue;
    }
    if (i < 384) { mod_slab(p, i, smem); continue; } i -= 384;
    if (i < 1168) { transpose_tile<true>(p.w_in, 1024, NIN, (bf16_t*)(p.ws + OFF_WIN), i / 73, i % 73, smem); continue; } i -= 1168;
    if (i < 128) { transpose_tile<false>(p.w_a, 512, 1024, (bf16_t*)(p.ws + OFF_WA), i / 16, i % 16, smem); continue; } i -= 128;
    if (i < 128) { transpose_tile<false>(p.w_b, 512, 1024, (bf16_t*)(p.ws + OFF_WB), i / 16, i % 16, smem); continue; } i -= 128;
    if (i < 256) { transpose_tile<false>(p.w_out, 1024, 1024, (bf16_t*)(p.ws + OFF_WOUT), i / 16, i % 16, smem); continue; } i -= 256;
    if (i < 512) { transpose_tile<false>(p.w_pq, 1024, 2048, (bf16_t*)(p.ws + OFF_WPQ), i / 32, i % 32, smem); continue; } i -= 512;
    if (i < 16) { int g = i >> 2, r = i & 3;
      transpose_tile<false>(p.w_pool + g * 16384, 128, 128, (bf16_t*)(p.ws + OFF_WPOOL) + g * 16384, r >> 1, r & 1, smem); continue; } i -= 16;
    if (i < 1024) { convert_chunk_fp8(p.peer_u, p.ws + OFF_PU, (size_t)i * 16384, 512.f); continue; } i -= 1024;
    if (i < 1024) { convert_chunk_fp8(p.peer_v, p.ws + OFF_PV, (size_t)i * 16384, 64.f); continue; } i -= 1024;
    if (i < 2) { convert_chunk(p.subkeys, (bf16_t*)(p.ws + OFF_SUBK), (size_t)i * 16384); continue; } i -= 2;
    {
      const float4* src = (const float4*)(p.st_pool + (size_t)i * 7680 + 512);
      float4* dst = (float4*)(p.out + OUT_PS + (size_t)i * 7680);
#pragma unroll
      for (int k = 0; k < 7; ++k) dst[threadIdx.x + 256 * k] = src[threadIdx.x + 256 * k];
    }
  }
}

__device__ __forceinline__ void phase_B(const Params& p) {
  const int tid = threadIdx.x, lane = tid & 63, w = tid >> 6;
  const float* MOD = (const float*)(p.ws + OFF_MOD);
  bf16_t* H = (bf16_t*)(p.ws + OFF_H);
  for (int row = blockIdx.x * 4 + w; row < NT; row += gridDim.x * 4) {
    const float* xr = x_row(p, row);
    float4 v[4];
#pragma unroll
    for (int i = 0; i < 4; ++i) v[i] = *(const float4*)(xr + i * 256 + lane * 4);
    float s = 0.f;
#pragma unroll
    for (int i = 0; i < 4; ++i) s += v[i].x + v[i].y + v[i].z + v[i].w;
    float mu = wave_sum(s) * (1.f / 1024.f);
    float q = 0.f;
#pragma unroll
    for (int i = 0; i < 4; ++i) { float a = v[i].x - mu, b = v[i].y - mu, c = v[i].z - mu, d = v[i].w - mu; q += a * a + b * b + c * c + d * d; }
    float rstd = rsqrtf(wave_sum(q) * (1.f / 1024.f) + LN_EPS);
    const float* mr = MOD + (size_t)mod_row(row) * 6144;
#pragma unroll
    for (int i = 0; i < 4; ++i) {
      int c = i * 256 + lane * 4;
      float4 sh = *(const float4*)(mr + c), sc = *(const float4*)(mr + 1024 + c);
      uint2 o;
      o.x = pack2((v[i].x - mu) * rstd * (1.f + sc.x) + sh.x, (v[i].y - mu) * rstd * (1.f + sc.y) + sh.y);
      o.y = pack2((v[i].z - mu) * rstd * (1.f + sc.z) + sh.z, (v[i].w - mu) * rstd * (1.f + sc.w) + sh.w);
      *(uint2*)(H + (size_t)row * 1024 + c) = o;
    }
  }
}

__device__ __forceinline__ void phase_C(const Params& p, unsigned char* smem) {
  TID_VARS
  const bf16_t* H = (const bf16_t*)(p.ws + OFF_H);
  const bf16_t* WT = (const bf16_t*)(p.ws + OFF_WIN);
  bf16_t* Q = (bf16_t*)(p.ws + OFF_Q); bf16_t* Kb = (bf16_t*)(p.ws + OFF_K); bf16_t* V = (bf16_t*)(p.ws + OFF_V);
  bf16_t* O = (bf16_t*)(p.ws + OFF_O); bf16_t* KT = (bf16_t*)(p.ws + OFF_KT); bf16_t* VT = (bf16_t*)(p.ws + OFF_VT);
  float* IG = (float*)(p.ws + OFF_IG); float* LF = (float*)(p.ws + OFF_LF); float* U = (float*)(p.ws + OFF_U);
  const int n_items = 129 * 21;
  for (int it = blockIdx.x; it < n_items; it += gridDim.x) {
    const int mt = it / 21, nt = it % 21;
    f32x16 acc[2][2]; ZERO_ACC(acc)
    gemm_gg128(H + (size_t)mt * 128 * 1024, 1024, WT + (size_t)nt * 128 * 1024, 1024, 1024, smem, acc);
    const int row_base = mt * 128, col_base = nt * 128;
    if (nt < 16) {
      const int sect = nt >> 2;
      const int hh = nt & 3;
      EPI_QUADS(acc, {
        const int col = col_base + lcol; const float bias = P_BIN(p)[col];
        const int c512 = col & 511; const int row0 = row_base + lrow0;
        float a0 = v0 + bias, a1 = v1 + bias, a2 = v2 + bias, a3 = v3 + bias;
        if (sect == 0) {
          Q[(size_t)(row0) * 512 + c512] = f2bf(a0); Q[(size_t)(row0 + 1) * 512 + c512] = f2bf(a1);
          Q[(size_t)(row0 + 2) * 512 + c512] = f2bf(a2); Q[(size_t)(row0 + 3) * 512 + c512] = f2bf(a3);
        } else if (sect == 1) {
          const float sc = 0.08838834764831845f;
          a0 *= sc; a1 *= sc; a2 *= sc; a3 *= sc;
          Kb[(size_t)(row0) * 512 + c512] = f2bf(a0); Kb[(size_t)(row0 + 1) * 512 + c512] = f2bf(a1);
          Kb[(size_t)(row0 + 2) * 512 + c512] = f2bf(a2); Kb[(size_t)(row0 + 3) * 512 + c512] = f2bf(a3);
          if (mt < 128) {
            const int b = mt >> 4, t = (mt & 15) * 128 + lrow0;
            uint2 o; o.x = pack2(a0, a1); o.y = pack2(a2, a3);
            *(uint2*)(KT + ((size_t)((b * 4 + hh) * 128 + (c512 & 127))) * 2048 + t) = o;
          }
        } else if (sect == 2) {
          if (mt >= 128) {
            V[(size_t)(row0) * 512 + c512] = f2bf(a0); V[(size_t)(row0 + 1) * 512 + c512] = f2bf(a1);
            V[(size_t)(row0 + 2) * 512 + c512] = f2bf(a2); V[(size_t)(row0 + 3) * 512 + c512] = f2bf(a3);
          }
          if (mt < 128) {
            const int b = mt >> 4, t = (mt & 15) * 128 + lrow0;
            uint2 o; o.x = pack2(a0, a1); o.y = pack2(a2, a3);
            *(uint2*)(VT + ((size_t)((b * 4 + hh) * 128 + (c512 & 127))) * 2048 + t) = o;
          }
        } else {
          O[(size_t)(row0) * 512 + c512] = f2bf(sigmoidf_(a0)); O[(size_t)(row0 + 1) * 512 + c512] = f2bf(sigmoidf_(a1));
          O[(size_t)(row0 + 2) * 512 + c512] = f2bf(sigmoidf_(a2)); O[(size_t)(row0 + 3) * 512 + c512] = f2bf(sigmoidf_(a3));
        }
      })
    } else if (nt < 20) {
      EPI_QUADS(acc, {
        const int uc = (nt - 16) * 128 + lcol; const int row0 = row_base + lrow0;
        const float bias = P_BIN(p)[2056 + uc];
        U[(size_t)(row0) * 512 + uc] = v0 + bias; U[(size_t)(row0 + 1) * 512 + uc] = v1 + bias;
        U[(size_t)(row0 + 2) * 512 + uc] = v2 + bias; U[(size_t)(row0 + 3) * 512 + uc] = v3 + bias;
      })
    } else {
      EPI_QUADS(acc, {
        const int row0 = row_base + lrow0;
        if (lcol < 4) {
          const float bias = P_BIN(p)[2048 + lcol];
          IG[(size_t)(row0) * 4 + lcol] = v0 + bias; IG[(size_t)(row0 + 1) * 4 + lcol] = v1 + bias;
          IG[(size_t)(row0 + 2) * 4 + lcol] = v2 + bias; IG[(size_t)(row0 + 3) * 4 + lcol] = v3 + bias;
        } else if (lcol < 8) {
          const int hh = lcol - 4; const float bias = P_BIN(p)[2052 + hh] + P_FG(p)[hh];
          LF[(size_t)(row0) * 4 + hh] = logsigmoidf_(v0 + bias); LF[(size_t)(row0 + 1) * 4 + hh] = logsigmoidf_(v1 + bias);
          LF[(size_t)(row0 + 2) * 4 + hh] = logsigmoidf_(v2 + bias); LF[(size_t)(row0 + 3) * 4 + hh] = logsigmoidf_(v3 + bias);
        }
      })
    }
  }
}

__device__ __forceinline__ void d1_prompt_chunk(const Params& p, int item, unsigned char* smem) {
  TID_VARS
  const int bh = item >> 4, c = item & 15, b = bh >> 2, h = bh & 3;
  const int r0 = b * 2048 + c * 128;
  float* misc = (float*)(smem + SM_MISC);
  float* s_lf = misc, *s_ig = misc + 128, *s_b = misc + 256, *s_g = misc + 384, *s_d = misc + 512;
  const float* IG = (const float*)(p.ws + OFF_IG); const float* LF = (const float*)(p.ws + OFF_LF);
  __syncthreads();
  if (tid < 128) { s_lf[tid] = LF[(size_t)(r0 + tid) * 4 + h]; s_ig[tid] = IG[(size_t)(r0 + tid) * 4 + h]; }
  __syncthreads();
  if (tid < 128) { float a = 0.f; for (int j = 0; j <= tid; ++j) a += s_lf[j]; s_b[tid] = a; }
  __syncthreads();
  const float Btot = s_b[127];
  if (tid < 128) s_g[tid] = Btot - s_b[tid] + s_ig[tid];
  __syncthreads();
  float amax = -3.0e38f;
  for (int j = 0; j < 128; ++j) amax = fmaxf(amax, s_g[j]);
  if (tid < 128) s_d[tid] = __expf(s_g[tid] - amax);
  if (tid == 0) { ((float*)(p.ws + OFF_CHB))[item * 32] = Btot; ((float*)(p.ws + OFF_CHB))[item * 32 + 1] = amax; }
  __syncthreads();
  const bf16_t* KT = (const bf16_t*)(p.ws + OFF_KT) + (size_t)bh * 128 * 2048 + c * 128;
  const bf16_t* VT = (const bf16_t*)(p.ws + OFF_VT) + (size_t)bh * 128 * 2048 + c * 128;
  if (tid < 128) {
    const uint4* kr = (const uint4*)(KT + (size_t)tid * 2048);
    float a = 0.f;
#pragma unroll 4
    for (int j = 0; j < 16; ++j) {
      uint4 v = kr[j]; const float* d = s_d + j * 8;
      a += bflo(v.x) * d[0] + bfhi(v.x) * d[1] + bflo(v.y) * d[2] + bfhi(v.y) * d[3] + bflo(v.z) * d[4] + bfhi(v.z) * d[5] + bflo(v.w) * d[6] + bfhi(v.w) * d[7];
    }
    ((float*)(p.ws + OFF_NLOC))[(size_t)item * 128 + tid] = a;
  }
  f32x16 acc[2][2]; ZERO_ACC(acc)
  gemm_gg<true>(VT, 2048, KT, 2048, 128, smem, acc, s_d);
  float* SB = p.out + OUT_SBUF + (size_t)item * 16384;
  EPI_QUADS(acc, {
    SB[(size_t)(lrow0) * 128 + lcol] = v0; SB[(size_t)(lrow0 + 1) * 128 + lcol] = v1;
    SB[(size_t)(lrow0 + 2) * 128 + lcol] = v2; SB[(size_t)(lrow0 + 3) * 128 + lcol] = v3;
  })
}
__device__ __forceinline__ void d1_sample_step(const Params& p, int item, unsigned char* smem) {
  const int tid = threadIdx.x;
  const int s = item >> 2, h = item & 3, row = NP + s;
  float* misc = (float*)(smem + SM_MISC);
  float* s_q = misc, *s_k = misc + 128, *s_red = misc + 256, *s_num = misc + 512  , *s_h = misc + 768  ;
  bf16_t* Q = (bf16_t*)(p.ws + OFF_Q); const bf16_t* Kb = (const bf16_t*)(p.ws + OFF_K); const bf16_t* V = (const bf16_t*)(p.ws + OFF_V);
  const bf16_t* O = (const bf16_t*)(p.ws + OFF_O);
  __syncthreads();
  if (tid < 128) { s_q[tid] = bf2f(Q[(size_t)row * 512 + h * 128 + tid]); s_k[tid] = bf2f(Kb[(size_t)row * 512 + h * 128 + tid]); }
  else {
    const int c = tid - 128, g = h, wlen = 2 << g;
    const float ut = ((const float*)(p.ws + OFF_U))[(size_t)row * 512 + g * 128 + c];
    const float* __restrict__ pre = p.st_pool + (size_t)s * 15 * 512 + g * 128 + c;
    float sum = ut;
    for (int q = 1; q < wlen; ++q) sum += pre[(size_t)(15 - q) * 512];
    s_red[c] = sum / (float)wlen - ut;
    p.out[OUT_PS + ((size_t)s * 15 + 14) * 512 + g * 128 + c] = ut;
  }
  __syncthreads();
  {
    const int d = tid & 127, ch = tid >> 7, g = h;
    const float* __restrict__ wp = p.w_pool + (size_t)g * 16384 + (size_t)(ch * 64) * 128 + d;
    float a = 0.f;
#pragma unroll
    for (int cb = 0; cb < 64; cb += 16) {
      float wv[16];
#pragma unroll
      for (int j = 0; j < 16; ++j) wv[j] = wp[(size_t)(cb + j) * 128];
#pragma unroll
      for (int j = 0; j < 16; ++j) a += s_red[ch * 64 + cb + j] * wv[j];
    }
    s_num[tid] = a;
    __syncthreads();
    if (tid < 128) ((bf16_t*)(p.out + OUT_PB))[(size_t)row * 512 + g * 128 + tid] = f2bf((s_num[tid] + s_num[tid + 128]) * P_PS(p)[g * 128 + tid]);
    __syncthreads();
  }
  const float ig = ((const float*)(p.ws + OFF_IG))[(size_t)row * 4 + h];
  const float lf = ((const float*)(p.ws + OFF_LF))[(size_t)row * 4 + h];
  const float m0 = p.st_m[s * 4 + h];
  const float* n0 = p.st_n + (size_t)(s * 4 + h) * 128;
  float qk = 0.f, qn = 0.f;
#pragma unroll 4
  for (int j = 0; j < 128; ++j) { qk += s_q[j] * s_k[j]; qn += s_q[j] * n0[j]; }
  const float log_g = lf + m0;
  const float mt = fmaxf(log_g, ig);
  const float wq = __expf(ig - mt) * qk;
  const float wst = __expf(log_g - mt);
  const float dcs = __expf(ig - mt);
  const float dcc = __expf(lf + m0 - mt);
  const int dv = tid & 127, half = tid >> 7;
  const float vv = bf2f(V[(size_t)row * 512 + h * 128 + dv]);
  const float* __restrict__ C0 = p.st_C + (size_t)(s * 4 + h) * 16384;
  float* __restrict__ Cn = p.out + OUT_CS + (size_t)(s * 4 + h) * 16384;
  float part = 0.f;
#pragma unroll
  for (int jb = 0; jb < 64; jb += 16) {
    float c0v[16];
#pragma unroll
    for (int j = 0; j < 16; ++j) c0v[j] = C0[(half * 64 + jb + j) * 128 + dv];
#pragma unroll
    for (int j = 0; j < 16; ++j) {
      const int dk = half * 64 + jb + j;
      part += s_q[dk] * c0v[j];
      Cn[dk * 128 + dv] = dcc * c0v[j] + dcs * s_k[dk] * vv;
    }
  }
  s_num[tid] = part;
  if (tid < 128) p.out[OUT_NS + (size_t)(s * 4 + h) * 128 + tid] = dcc * n0[tid] + dcs * s_k[tid];
  if (tid == 0) p.out[OUT_MS + s * 4 + h] = mt;
  __syncthreads();
  if (tid < 128) {
    float num = wq * vv + wst * (s_num[tid] + s_num[tid + 128]);
    float den = wq + wst * qn;
    float hv = num / fmaxf(fabsf(den), __expf(-mt));
    s_h[tid] = hv;
  }
  __syncthreads();
  if (tid < 128) {
    float mu = 0.f;
#pragma unroll 4
    for (int j = 0; j < 128; ++j) mu += s_h[j];
    mu *= (1.f / 128.f);
    float var = 0.f;
#pragma unroll 4
    for (int j = 0; j < 128; ++j) { float d = s_h[j] - mu; var += d * d; }
    var *= (1.f / 128.f);
    float y = (s_h[tid] - mu) * rsqrtf(var + LN_EPS) * P_GN(p)[h * 128 + tid] * bf2f(O[(size_t)row * 512 + h * 128 + tid]);
    Q[(size_t)row * 512 + h * 128 + tid] = f2bf(y);
  }
}
template <int WLEN>
__device__ __forceinline__ void pool_rows(const Params& p, const float* __restrict__ U, int mt, int g, unsigned* sW32, int tid) {
  const int cp = tid & 63, qtr = tid >> 6;
  if (mt < 128) {
    const int b = mt >> 4, t0 = (mt & 15) * 128 + qtr * 32;
    const float* Ub = U + (size_t)b * 2048 * 512 + g * 128 + cp * 2;
    float2 u[31 + WLEN];
#pragma unroll
    for (int k = 0; k < 31 + WLEN; ++k) {
      const int t = t0 - (WLEN - 1) + k;
      u[k] = (t >= 0) ? *(const float2*)(Ub + (size_t)t * 512) : make_float2(0.f, 0.f);
    }
    float s0 = 0.f, s1 = 0.f;
#pragma unroll
    for (int k = 0; k < WLEN - 1; ++k) { s0 += u[k].x; s1 += u[k].y; }
#pragma unroll
    for (int j = 0; j < 32; ++j) {
      const float2 ut = u[WLEN - 1 + j];
      const int t = t0 + j;
      s0 += ut.x; s1 += ut.y;
      const float rc = 1.f / (float)min(WLEN, t + 1);
      sW32[(qtr * 32 + j) * (LW / 2) + cp] = pack2(s0 * rc - ut.x, s1 * rc - ut.y);
      s0 -= u[j].x; s1 -= u[j].y;
      if (t >= 2033) *(float2*)(p.out + OUT_PP + ((size_t)b * 15 + (t - 2033)) * 512 + g * 128 + cp * 2) = ut;
    }
  } else {
    const float rc = 1.f / (float)WLEN;
#pragma unroll 2
    for (int j = 0; j < 32; ++j) {
      const int sidx = qtr * 32 + j;
      const float2 ut = *(const float2*)(U + (size_t)(NP + sidx) * 512 + g * 128 + cp * 2);
      const float* __restrict__ pre = p.st_pool + (size_t)sidx * 15 * 512 + g * 128 + cp * 2;
      float2 pr[WLEN - 1];
#pragma unroll
      for (int q = 1; q < WLEN; ++q) pr[q - 1] = *(const float2*)(pre + (size_t)(15 - q) * 512);
      float s0 = ut.x, s1 = ut.y;
#pragma unroll
      for (int q = 0; q < WLEN - 1; ++q) { s0 += pr[q].x; s1 += pr[q].y; }
      sW32[sidx * (LW / 2) + cp] = pack2(s0 * rc - ut.x, s1 * rc - ut.y);
      *(float2*)(p.out + OUT_PS + ((size_t)sidx * 15 + 14) * 512 + g * 128 + cp * 2) = ut;
    }
  }
}
__device__ __forceinline__ void d1_pool(const Params& p, int item, unsigned char* smem) {
  TID_VARS
  const int mt = item >> 2, g = item & 3;
  const float* U = (const float*)(p.ws + OFF_U);
  bf16_t* sW = (bf16_t*)(smem + SM_W);
  __syncthreads();
  if (g == 0) pool_rows<2>(p, U, mt, g, (unsigned*)sW, tid);
  else if (g == 1) pool_rows<4>(p, U, mt, g, (unsigned*)sW, tid);
  else if (g == 2) pool_rows<8>(p, U, mt, g, (unsigned*)sW, tid);
  else pool_rows<16>(p, U, mt, g, (unsigned*)sW, tid);
  f32x16 acc[2][2]; ZERO_ACC(acc)
  gemm_sg(sW, (const bf16_t*)(p.ws + OFF_WPOOL) + g * 16384, 128, 128, smem, acc);
  bf16_t* PB = (bf16_t*)(p.out + OUT_PB);
  const int row_base = mt * 128;
  const int grp_col0 = g * 128;
  EPI_QUADS(acc, {
    const int col = grp_col0 + lcol; const float sc = P_PS(p)[col]; const int row0 = row_base + lrow0;
    PB[(size_t)(row0) * 512 + col] = f2bf(v0 * sc); PB[(size_t)(row0 + 1) * 512 + col] = f2bf(v1 * sc);
    PB[(size_t)(row0 + 2) * 512 + col] = f2bf(v2 * sc); PB[(size_t)(row0 + 3) * 512 + col] = f2bf(v3 * sc);
  })
}
__device__ __forceinline__ void phase_D1(const Params& p, unsigned char* smem) {
  for (int it = blockIdx.x; it < 512; it += gridDim.x) d1_prompt_chunk(p, it, smem);
  for (int it = blockIdx.x; it < 512; it += gridDim.x) d1_sample_step(p, it, smem);
  for (int it = blockIdx.x; it < 512; it += gridDim.x) d1_pool(p, it, smem);
}

__device__ __forceinline__ void phase_D2(const Params& p) {
  const int tid = threadIdx.x;
  const float* CHB = (const float*)(p.ws + OFF_CHB);
  const int n_items = 32 * 64 + 32;
  for (int it = blockIdx.x; it < n_items; it += gridDim.x) {
    if (it < 2048) {
      const int bh = it >> 6, e = (it & 63) * 256 + tid;
      const float* __restrict__ SB = p.out + OUT_SBUF + (size_t)bh * 16 * 16384 + e;
      bf16_t* __restrict__ CT = (bf16_t*)(p.ws + OFF_CT) + (size_t)bh * 16 * 16384 + e;
      float dcv[16], dsv[16], sb[16];
#pragma unroll
      for (int c = 0; c < 16; ++c) sb[c] = SB[(size_t)c * 16384];
      {
        float Bv[16], av[16];
#pragma unroll
        for (int c = 0; c < 16; ++c) { Bv[c] = CHB[(bh * 16 + c) * 32]; av[c] = CHB[(bh * 16 + c) * 32 + 1]; }
        float m = 0.f;
#pragma unroll
        for (int c = 0; c < 16; ++c) { float mn = fmaxf(Bv[c] + m, av[c]); dcv[c] = __expf(Bv[c] + m - mn); dsv[c] = __expf(av[c] - mn); m = mn; }
      }
      float C = 0.f;
#pragma unroll
      for (int c = 0; c < 16; ++c) { CT[(size_t)c * 16384] = f2bf(C); C = dcv[c] * C + dsv[c] * sb[c]; }
      const int dv = e >> 7, dk = e & 127;
      p.out[OUT_CP + (size_t)bh * 16384 + dk * 128 + dv] = C;
    } else {
      const int bh = it - 2048;
      if (tid < 128) {
        const float* NL = (const float*)(p.ws + OFF_NLOC) + (size_t)bh * 16 * 128 + tid;
        float* NPV = (float*)(p.ws + OFF_NPREV) + (size_t)bh * 16 * 128 + tid;
        float* MPV = (float*)(p.ws + OFF_MPREV) + bh * 16 * 32;
        float m = 0.f, n = 0.f;
        for (int c = 0; c < 16; ++c) {
          NPV[c * 128] = n;
          if (tid == 0) MPV[c * 32] = m;
          float B = CHB[(bh * 16 + c) * 32], a = CHB[(bh * 16 + c) * 32 + 1];
          float mn = fmaxf(B + m, a);
          n = __expf(B + m - mn) * n + __expf(a - mn) * NL[c * 128];
          m = mn;
        }
        p.out[OUT_NP + bh * 128 + tid] = n;
        if (tid == 0) p.out[OUT_MP + bh] = m;
      }
    }
  }
}

__device__ __forceinline__ void phase_D3(const Params& p, unsigned char* smem) {
  TID_VARS
  float* misc = (float*)(smem + SM_MISC);
  float* s_lf = misc, *s_ig = misc + 128, *s_b = misc + 256, *s_colf = misc + 384, *s_rowf = misc + 512, *s_wst = misc + 640, *s_inv = misc + 768;
  bf16_t* sW = (bf16_t*)(smem + SM_W);
  float* sH = (float*)smem;
  bf16_t* Q = (bf16_t*)(p.ws + OFF_Q); const bf16_t* Kb = (const bf16_t*)(p.ws + OFF_K); const bf16_t* O = (const bf16_t*)(p.ws + OFF_O);
  const float* IG = (const float*)(p.ws + OFF_IG); const float* LF = (const float*)(p.ws + OFF_LF);
  for (int item = blockIdx.x; item < 512; item += gridDim.x) {
    const int bh = item >> 4, c = item & 15, b = bh >> 2, h = bh & 3;
    const int r0 = b * 2048 + c * 128;
    const float m_prev = ((const float*)(p.ws + OFF_MPREV))[item * 32];
    __syncthreads();
    if (tid < 128) { s_lf[tid] = LF[(size_t)(r0 + tid) * 4 + h]; s_ig[tid] = IG[(size_t)(r0 + tid) * 4 + h];
                     misc[896 + tid] = ((const float*)(p.ws + OFF_NPREV))[(size_t)item * 128 + tid]; }
    __syncthreads();
    if (tid < 128) { float a = 0.f;
#pragma unroll 2
      for (int j = 0; j <= tid; ++j) a += s_lf[j];
      s_b[tid] = a; s_colf[tid] = s_ig[tid] - a; }
    __syncthreads();
    if (tid < 128) {
      float pm = -3.0e38f;
#pragma unroll 2
      for (int j = 0; j <= tid; ++j) pm = fmaxf(pm, s_colf[j]);
      float bt = s_b[tid];
      float mt = bt + fmaxf(m_prev, pm);
      s_rowf[tid] = bt - mt;
      s_wst[tid] = __expf(bt + m_prev - mt);
      s_inv[tid] = mt;
    }
    const bf16_t* Qp = Q + (size_t)r0 * 512 + h * 128;
    const bf16_t* Kp = Kb + (size_t)r0 * 512 + h * 128;
    f32x16 acc[2][2]; ZERO_ACC(acc)
    gemm_gg<false>(Qp, 512, Kp, 512, 128, smem, acc, nullptr);
    EPI_QUADS(acc, {
      const float cf = s_colf[lcol];
      float w0 = (lcol <= lrow0) ? __expf(s_rowf[lrow0] + cf) * v0 : 0.f;
      float w1 = (lcol <= lrow0 + 1) ? __expf(s_rowf[lrow0 + 1] + cf) * v1 : 0.f;
      float w2 = (lcol <= lrow0 + 2) ? __expf(s_rowf[lrow0 + 2] + cf) * v2 : 0.f;
      float w3 = (lcol <= lrow0 + 3) ? __expf(s_rowf[lrow0 + 3] + cf) * v3 : 0.f;
      sW[(lrow0) * LW + lcol] = f2bf(w0); sW[(lrow0 + 1) * LW + lcol] = f2bf(w1);
      sW[(lrow0 + 2) * LW + lcol] = f2bf(w2); sW[(lrow0 + 3) * LW + lcol] = f2bf(w3);
    })
    __syncthreads();
    if (tid < 128) {
      float d1 = 0.f;
      const unsigned* wr = (const unsigned*)(sW + tid * LW);
#pragma unroll 4
      for (int j = 0; j < 64; ++j) { unsigned u = wr[j]; d1 += bflo(u) + bfhi(u); }
      const float* npv = misc + 896;
      const uint4* qr = (const uint4*)(Qp + (size_t)tid * 512);
      float qn = 0.f;
#pragma unroll 2
      for (int j = 0; j < 16; ++j) {
        const uint4 v = qr[j]; const float* n = npv + j * 8;
        qn += bflo(v.x) * n[0] + bfhi(v.x) * n[1] + bflo(v.y) * n[2] + bfhi(v.y) * n[3] + bflo(v.z) * n[4] + bfhi(v.z) * n[5] + bflo(v.w) * n[6] + bfhi(v.w) * n[7];
      }
      float den = d1 + s_wst[tid] * qn;
      float mt = s_inv[tid];
      s_inv[tid] = 1.f / fmaxf(fabsf(den), __expf(-mt));
    }
    ZERO_ACC(acc)
    gemm_gg<false>(Qp, 512, (const bf16_t*)(p.ws + OFF_CT) + (size_t)item * 16384, 128, 128, smem, acc, nullptr);
    EPI_QUADS(acc, {
      acc[mi][ni][4 * g] = v0 * s_wst[lrow0]; acc[mi][ni][4 * g + 1] = v1 * s_wst[lrow0 + 1];
      acc[mi][ni][4 * g + 2] = v2 * s_wst[lrow0 + 2]; acc[mi][ni][4 * g + 3] = v3 * s_wst[lrow0 + 3];
    })
    gemm_sg(sW, (const bf16_t*)(p.ws + OFF_VT) + (size_t)bh * 128 * 2048 + c * 128, 2048, 128, smem, acc);
    __syncthreads();
    EPI_QUADS(acc, {
      sH[(lrow0) * 129 + lcol] = v0 * s_inv[lrow0]; sH[(lrow0 + 1) * 129 + lcol] = v1 * s_inv[lrow0 + 1];
      sH[(lrow0 + 2) * 129 + lcol] = v2 * s_inv[lrow0 + 2]; sH[(lrow0 + 3) * 129 + lcol] = v3 * s_inv[lrow0 + 3];
    })
    __syncthreads();
    {
      const int t = tid >> 1, half = tid & 1;
      const float* hr = sH + t * 129 + half * 64;
      float s = 0.f;
#pragma unroll 4
      for (int j = 0; j < 64; ++j) s += hr[j];
      s += __shfl_xor(s, 1);
      const float mu = s * (1.f / 128.f);
      float q = 0.f;
#pragma unroll 4
      for (int j = 0; j < 64; ++j) { float d = hr[j] - mu; q += d * d; }
      q += __shfl_xor(q, 1);
      const float rstd = rsqrtf(q * (1.f / 128.f) + LN_EPS);
      const size_t gofs = (size_t)(r0 + t) * 512 + h * 128 + half * 64;
      const float* __restrict__ gn = P_GN(p) + h * 128 + half * 64;
      uint4 ov[8];
#pragma unroll
      for (int k = 0; k < 8; ++k) ov[k] = *(const uint4*)(O + gofs + 8 * k);
#pragma unroll
      for (int k = 0; k < 8; ++k) {
        const float* hk = hr + 8 * k; const float* gk = gn + 8 * k;
        uint4 o;
        o.x = pack2((hk[0] - mu) * rstd * gk[0] * bflo(ov[k].x), (hk[1] - mu) * rstd * gk[1] * bfhi(ov[k].x));
        o.y = pack2((hk[2] - mu) * rstd * gk[2] * bflo(ov[k].y), (hk[3] - mu) * rstd * gk[3] * bfhi(ov[k].y));
        o.z = pack2((hk[4] - mu) * rstd * gk[4] * bflo(ov[k].z), (hk[5] - mu) * rstd * gk[5] * bfhi(ov[k].z));
        o.w = pack2((hk[6] - mu) * rstd * gk[6] * bflo(ov[k].w), (hk[7] - mu) * rstd * gk[7] * bfhi(ov[k].w));
        *(uint4*)(Q + gofs + 8 * k) = o;
      }
    }
  }
}

__device__ __forceinline__ void phase_E(const Params& p, unsigned char* smem) {
  TID_VARS
  const bf16_t* H = (const bf16_t*)(p.ws + OFF_H);
  const bf16_t* WT = (const bf16_t*)(p.ws + OFF_WIN);
  const bf16_t* HA = (const bf16_t*)(p.ws + OFF_Q);
  const bf16_t* PB = (const bf16_t*)(p.out + OUT_PB);
  bf16_t* MG = (bf16_t*)(p.ws + OFF_MERGED);
  for (int pc = blockIdx.x; pc < 256; pc += gridDim.x) {
    const int row0 = NP + (pc & 7) * 16, col0 = (pc >> 3) * 32;
    const f32x4 z4 = {0.f, 0.f, 0.f, 0.f};
    f32x4 a8[8] = {z4, z4, z4, z4, z4, z4, z4, z4};
    skinny16x32(H + (size_t)row0 * 1024 + w * 256, 1024, WT + (size_t)(2568 + col0) * 1024 + w * 256, 1024, 256, a8[0], a8[1], lane);
    skinny16x32(HA + (size_t)row0 * 512 + w * 128, 512, (const bf16_t*)(p.ws + OFF_WA) + (size_t)col0 * 512 + w * 128, 512, 128, a8[2], a8[3], lane);
    skinny16x32(H + (size_t)row0 * 1024 + w * 256, 1024, WT + (size_t)(3592 + col0) * 1024 + w * 256, 1024, 256, a8[4], a8[5], lane);
    skinny16x32(PB + (size_t)row0 * 512 + w * 128, 512, (const bf16_t*)(p.ws + OFF_WB) + (size_t)col0 * 512 + w * 128, 512, 128, a8[6], a8[7], lane);
    wave4_reduce<8>(a8, smem, w, lane);
    if (w == 0) {
      const int c = col0 + (lane & 15), rr = row0 + (lane >> 4) * 4;
      const float ba0 = P_BIN(p)[2568 + c], ba1 = P_BIN(p)[2568 + c + 16], bb0 = P_BIN(p)[3592 + c], bb1 = P_BIN(p)[3592 + c + 16];
#pragma unroll
      for (int j = 0; j < 4; ++j) {
        MG[(size_t)(rr + j) * 1024 + c] = f2bf(sigmoidf_(a8[0][j] + ba0) * a8[2][j] + sigmoidf_(a8[4][j] + bb0) * a8[6][j]);
        MG[(size_t)(rr + j) * 1024 + c + 16] = f2bf(sigmoidf_(a8[1][j] + ba1) * a8[3][j] + sigmoidf_(a8[5][j] + bb1) * a8[7][j]);
      }
    }
  }
  for (int q = blockIdx.x >> 3; q < 16 * 8; q += (gridDim.x >> 3)) {
    int mt, nt; xcd_tile(q, 8, mt, nt);
    const int row_base = mt * 128, col_base = nt * 128;
    unsigned gpk[32];
    unsigned* mlds = (unsigned*)(smem + SM_W) + tid;
    f32x16 acc[2][2];
    ZERO_ACC(acc)
    gemm_gg<false>(H + (size_t)row_base * 1024, 1024, WT + (size_t)(2568 + col_base) * 1024, 1024, 1024, smem, acc, nullptr);
    EPI_QUADS(acc, {
      const float bias = P_BIN(p)[2568 + col_base + lcol];
      gpk[(mi * 2 + ni) * 8 + g * 2] = pack2(sigmoidf_(v0 + bias), sigmoidf_(v1 + bias));
      gpk[(mi * 2 + ni) * 8 + g * 2 + 1] = pack2(sigmoidf_(v2 + bias), sigmoidf_(v3 + bias));
    })
    ZERO_ACC(acc)
    gemm_gg<false>(HA + (size_t)row_base * 512, 512, (const bf16_t*)(p.ws + OFF_WA) + (size_t)col_base * 512, 512, 512, smem, acc, nullptr);
    EPI_QUADS(acc, {
      unsigned g0 = gpk[(mi * 2 + ni) * 8 + g * 2], g1 = gpk[(mi * 2 + ni) * 8 + g * 2 + 1];
      mlds[((mi * 2 + ni) * 8 + g * 2) * 256] = pack2(bflo(g0) * v0, bfhi(g0) * v1);
      mlds[((mi * 2 + ni) * 8 + g * 2 + 1) * 256] = pack2(bflo(g1) * v2, bfhi(g1) * v3);
    })
    ZERO_ACC(acc)
    gemm_gg<false>(H + (size_t)row_base * 1024, 1024, WT + (size_t)(3592 + col_base) * 1024, 1024, 1024, smem, acc, nullptr);
    EPI_QUADS(acc, {
      const float bias = P_BIN(p)[3592 + col_base + lcol];
      gpk[(mi * 2 + ni) * 8 + g * 2] = pack2(sigmoidf_(v0 + bias), sigmoidf_(v1 + bias));
      gpk[(mi * 2 + ni) * 8 + g * 2 + 1] = pack2(sigmoidf_(v2 + bias), sigmoidf_(v3 + bias));
    })
    ZERO_ACC(acc)
    gemm_gg<false>(PB + (size_t)row_base * 512, 512, (const bf16_t*)(p.ws + OFF_WB) + (size_t)col_base * 512, 512, 512, smem, acc, nullptr);
    EPI_QUADS(acc, {
      unsigned g0 = gpk[(mi * 2 + ni) * 8 + g * 2], g1 = gpk[(mi * 2 + ni) * 8 + g * 2 + 1];
      unsigned m0 = mlds[((mi * 2 + ni) * 8 + g * 2) * 256], m1 = mlds[((mi * 2 + ni) * 8 + g * 2 + 1) * 256];
      const int col = col_base + lcol; const int row0 = row_base + lrow0;
      MG[(size_t)(row0) * 1024 + col] = f2bf(bflo(m0) + bflo(g0) * v0);
      MG[(size_t)(row0 + 1) * 1024 + col] = f2bf(bfhi(m0) + bfhi(g0) * v1);
      MG[(size_t)(row0 + 2) * 1024 + col] = f2bf(bflo(m1) + bflo(g1) * v2);
      MG[(size_t)(row0 + 3) * 1024 + col] = f2bf(bfhi(m1) + bfhi(g1) * v3);
    })
  }
}

__device__ __forceinline__ void phase_F(const Params& p, unsigned char* smem) {
  TID_VARS
  const bf16_t* MG = (const bf16_t*)(p.ws + OFF_MERGED);
  const bf16_t* WO = (const bf16_t*)(p.ws + OFF_WOUT);
  const float* MOD = (const float*)(p.ws + OFF_MOD);
  float* Y = p.out + OUT_Y;
  for (int pc = blockIdx.x; pc < 256; pc += gridDim.x) {
    const int row0 = NP + (pc & 7) * 16, col0 = (pc >> 3) * 32;
    const f32x4 z4 = {0.f, 0.f, 0.f, 0.f};
    f32x4 a2[2] = {z4, z4};
    skinny16x32(MG + (size_t)row0 * 1024 + w * 256, 1024, WO + (size_t)col0 * 1024 + w * 256, 1024, 256, a2[0], a2[1], lane);
    wave4_reduce<2>(a2, smem, w, lane);
    if (w == 0) {
      const int c = col0 + (lane & 15), rr = row0 + (lane >> 4) * 4;
#pragma unroll
      for (int j = 0; j < 4; ++j) {
        const int row = rr + j;
        const float* mg = MOD + (size_t)mod_row(row) * 6144 + 2048;
        const float* xr = x_row(p, row);
        Y[(size_t)row * 1024 + c] = ALPHA * xr[c] + mg[c] * a2[0][j];
        Y[(size_t)row * 1024 + c + 16] = ALPHA * xr[c + 16] + mg[c + 16] * a2[1][j];
      }
    }
  }
  for (int q = blockIdx.x >> 3; q < 16 * 8; q += (gridDim.x >> 3)) {
    int mt, nt; xcd_tile(q, 8, mt, nt);
    const int row_base = mt * 128, col_base = nt * 128;
    f32x16 acc[2][2]; ZERO_ACC(acc)
    gemm_gg128(MG + (size_t)row_base * 1024, 1024, WO + (size_t)col_base * 1024, 1024, 1024, smem, acc);
    EPI_QUADS(acc, {
      const int col = col_base + lcol; const int row0 = row_base + lrow0;
      const float* mg = MOD + (size_t)mod_row(row0) * 6144 + 2048 + col;
      const float g1 = *mg;
      Y[(size_t)(row0) * 1024 + col] = ALPHA * x_row(p, row0)[col] + g1 * v0;
      Y[(size_t)(row0 + 1) * 1024 + col] = ALPHA * x_row(p, row0 + 1)[col] + (row0 < NP ? g1 : mg[6144]) * v1;
      Y[(size_t)(row0 + 2) * 1024 + col] = ALPHA * x_row(p, row0 + 2)[col] + (row0 < NP ? g1 : mg[2 * 6144]) * v2;
      Y[(size_t)(row0 + 3) * 1024 + col] = ALPHA * x_row(p, row0 + 3)[col] + (row0 < NP ? g1 : mg[3 * 6144]) * v3;
    })
  }
}

__device__ __forceinline__ void phase_G(const Params& p) {
  const int tid = threadIdx.x, lane = tid & 63, w = tid >> 6;
  const float* MOD = (const float*)(p.ws + OFF_MOD);
  bf16_t* H = (bf16_t*)(p.ws + OFF_H);
  float* Y = p.out + OUT_Y;
  const int rstep = gridDim.x * 4;
  float4 nx[4];
  {
    const int row = blockIdx.x * 4 + w;
    if (row < NT) {
#pragma unroll
      for (int i = 0; i < 4; ++i) nx[i] = *(const float4*)(Y + (size_t)row * 1024 + i * 256 + lane * 4); }
  }
  for (int row = blockIdx.x * 4 + w; row < NT; row += rstep) {
    float* yr = Y + (size_t)row * 1024;
    float v[16];
#pragma unroll
    for (int i = 0; i < 4; ++i) { float4 t = nx[i]; v[4 * i] = t.x; v[4 * i + 1] = t.y; v[4 * i + 2] = t.z; v[4 * i + 3] = t.w; }
    if (row + rstep < NT) {
#pragma unroll
      for (int i = 0; i < 4; ++i) nx[i] = *(const float4*)(Y + (size_t)(row + rstep) * 1024 + i * 256 + lane * 4); }
    float s = 0.f;
#pragma unroll
    for (int i = 0; i < 16; ++i) s += v[i];
    float mu = wave_sum(s) * (1.f / 1024.f);
    float q = 0.f;
#pragma unroll
    for (int i = 0; i < 16; ++i) { float d = v[i] - mu; q += d * d; }
    float rstd = rsqrtf(wave_sum(q) * (1.f / 1024.f) + LN_EPS);
    s = 0.f;
#pragma unroll
    for (int i = 0; i < 4; ++i) {
      int c = i * 256 + lane * 4;
      float4 gg = *(const float4*)(P_L1G(p) + c), bb = *(const float4*)(P_L1B(p) + c);
      v[4 * i] = (v[4 * i] - mu) * rstd * gg.x + bb.x; v[4 * i + 1] = (v[4 * i + 1] - mu) * rstd * gg.y + bb.y;
      v[4 * i + 2] = (v[4 * i + 2] - mu) * rstd * gg.z + bb.z; v[4 * i + 3] = (v[4 * i + 3] - mu) * rstd * gg.w + bb.w;
      *(float4*)(yr + c) = make_float4(v[4 * i], v[4 * i + 1], v[4 * i + 2], v[4 * i + 3]);
      s += v[4 * i] + v[4 * i + 1] + v[4 * i + 2] + v[4 * i + 3];
    }
    mu = wave_sum(s) * (1.f / 1024.f);
    q = 0.f;
#pragma unroll
    for (int i = 0; i < 16; ++i) { float d = v[i] - mu; q += d * d; }
    rstd = rsqrtf(wave_sum(q) * (1.f / 1024.f) + LN_EPS);
    const float* mr = MOD + (size_t)mod_row(row) * 6144;
#pragma unroll
    for (int i = 0; i < 4; ++i) {
      int c = i * 256 + lane * 4;
      float4 sh = *(const float4*)(mr + 3072 + c), sc = *(const float4*)(mr + 4096 + c);
      uint2 o;
      o.x = pack2((v[4 * i] - mu) * rstd * (1.f + sc.x) + sh.x, (v[4 * i + 1] - mu) * rstd * (1.f + sc.y) + sh.y);
      o.y = pack2((v[4 * i + 2] - mu) * rstd * (1.f + sc.z) + sh.z, (v[4 * i + 3] - mu) * rstd * (1.f + sc.w) + sh.w);
      *(uint2*)(H + (size_t)row * 1024 + c) = o;
    }
  }
}

__device__ __forceinline__ void phase_H(const Params& p, unsigned char* smem) {
  TID_VARS
  const bf16_t* H = (const bf16_t*)(p.ws + OFF_H);
  const bf16_t* WQ = (const bf16_t*)(p.ws + OFF_WPQ);
  bf16_t* PQ = (bf16_t*)(p.ws + OFF_PQ);
  for (int pc = blockIdx.x; pc < 512; pc += gridDim.x) {
    const int row0 = NP + (pc & 7) * 16, col0 = (pc >> 3) * 32;
    const f32x4 z4 = {0.f, 0.f, 0.f, 0.f};
    f32x4 a2[2] = {z4, z4};
    skinny16x32(H + (size_t)row0 * 1024 + w * 256, 1024, WQ + (size_t)col0 * 1024 + w * 256, 1024, 256, a2[0], a2[1], lane);
    wave4_reduce<2>(a2, smem, w, lane);
    if (w == 0) {
      const int c = col0 + (lane & 15), rr = row0 + (lane >> 4) * 4;
#pragma unroll
      for (int j = 0; j < 4; ++j) {
        PQ[(size_t)(rr + j) * 2048 + c] = f2bf(a2[0][j]);
        PQ[(size_t)(rr + j) * 2048 + c + 16] = f2bf(a2[1][j]);
      }
    }
  }
  for (int q = blockIdx.x >> 3; q < 16 * 16; q += (gridDim.x >> 3)) {
    int mt, nt; xcd_tile(q, 16, mt, nt);
    const int row_base = mt * 128, col_base = nt * 128;
    f32x16 acc[2][2]; ZERO_ACC(acc)
    gemm_gg128(H + (size_t)row_base * 1024, 1024, WQ + (size_t)col_base * 1024, 1024, 1024, smem, acc);
    EPI_QUADS(acc, {
      const int col = col_base + lcol; const int row0 = row_base + lrow0;
      PQ[(size_t)(row0) * 2048 + col] = f2bf(v0); PQ[(size_t)(row0 + 1) * 2048 + col] = f2bf(v1);
      PQ[(size_t)(row0 + 2) * 2048 + col] = f2bf(v2); PQ[(size_t)(row0 + 3) * 2048 + col] = f2bf(v3);
    })
  }
}

__device__ __forceinline__ int f2key(float f) { int b = __float_as_int(f); return b ^ ((b >> 31) & 0x7FFFFFFF); }
__device__ __forceinline__ float key2f(int k) { return __int_as_float(k ^ ((k >> 31) & 0x7FFFFFFF)); }
#define CMPX(a, b) { const int _h = max(a, b), _l = min(a, b); a = _h; b = _l; }
#define SORT16(k, o) { CMPX(k[(o) + 0], k[(o) + 1]) CMPX(k[(o) + 2], k[(o) + 3]) CMPX(k[(o) + 0], k[(o) + 2]) CMPX(k[(o) + 1], k[(o) + 3]) CMPX(k[(o) + 1], k[(o) + 2]) CMPX(k[(o) + 4], k[(o) + 5]) CMPX(k[(o) + 6], k[(o) + 7]) CMPX(k[(o) + 4], k[(o) + 6]) CMPX(k[(o) + 5], k[(o) + 7]) CMPX(k[(o) + 5], k[(o) + 6]) CMPX(k[(o) + 0], k[(o) + 4]) CMPX(k[(o) + 2], k[(o) + 6]) CMPX(k[(o) + 2], k[(o) + 4]) CMPX(k[(o) + 1], k[(o) + 5]) CMPX(k[(o) + 3], k[(o) + 7]) CMPX(k[(o) + 3], k[(o) + 5]) CMPX(k[(o) + 1], k[(o) + 2]) CMPX(k[(o) + 3], k[(o) + 4]) CMPX(k[(o) + 5], k[(o) + 6]) CMPX(k[(o) + 8], k[(o) + 9]) CMPX(k[(o) + 10], k[(o) + 11]) CMPX(k[(o) + 8], k[(o) + 10]) CMPX(k[(o) + 9], k[(o) + 11]) CMPX(k[(o) + 9], k[(o) + 10]) CMPX(k[(o) + 12], k[(o) + 13]) CMPX(k[(o) + 14], k[(o) + 15]) CMPX(k[(o) + 12], k[(o) + 14]) CMPX(k[(o) + 13], k[(o) + 15]) CMPX(k[(o) + 13], k[(o) + 14]) CMPX(k[(o) + 8], k[(o) + 12]) CMPX(k[(o) + 10], k[(o) + 14]) CMPX(k[(o) + 10], k[(o) + 12]) CMPX(k[(o) + 9], k[(o) + 13]) CMPX(k[(o) + 11], k[(o) + 15]) CMPX(k[(o) + 11], k[(o) + 13]) CMPX(k[(o) + 9], k[(o) + 10]) CMPX(k[(o) + 11], k[(o) + 12]) CMPX(k[(o) + 13], k[(o) + 14]) CMPX(k[(o) + 0], k[(o) + 8]) CMPX(k[(o) + 4], k[(o) + 12]) CMPX(k[(o) + 4], k[(o) + 8]) CMPX(k[(o) + 2], k[(o) + 10]) CMPX(k[(o) + 6], k[(o) + 14]) CMPX(k[(o) + 6], k[(o) + 10]) CMPX(k[(o) + 2], k[(o) + 4]) CMPX(k[(o) + 6], k[(o) + 8]) CMPX(k[(o) + 10], k[(o) + 12]) CMPX(k[(o) + 1], k[(o) + 9]) CMPX(k[(o) + 5], k[(o) + 13]) CMPX(k[(o) + 5], k[(o) + 9]) CMPX(k[(o) + 3], k[(o) + 11]) CMPX(k[(o) + 7], k[(o) + 15]) CMPX(k[(o) + 7], k[(o) + 11]) CMPX(k[(o) + 3], k[(o) + 5]) CMPX(k[(o) + 7], k[(o) + 9]) CMPX(k[(o) + 11], k[(o) + 13]) CMPX(k[(o) + 1], k[(o) + 2]) CMPX(k[(o) + 3], k[(o) + 4]) CMPX(k[(o) + 5], k[(o) + 6]) CMPX(k[(o) + 7], k[(o) + 8]) CMPX(k[(o) + 9], k[(o) + 10]) CMPX(k[(o) + 11], k[(o) + 12]) CMPX(k[(o) + 13], k[(o) + 14]) }
#define MERGE16(k, a, b) { k[(a) + 0] = max(k[(a) + 0], k[(b) + 15]); k[(a) + 1] = max(k[(a) + 1], k[(b) + 14]); k[(a) + 2] = max(k[(a) + 2], k[(b) + 13]); k[(a) + 3] = max(k[(a) + 3], k[(b) + 12]); k[(a) + 4] = max(k[(a) + 4], k[(b) + 11]); k[(a) + 5] = max(k[(a) + 5], k[(b) + 10]); k[(a) + 6] = max(k[(a) + 6], k[(b) + 9]); k[(a) + 7] = max(k[(a) + 7], k[(b) + 8]); k[(a) + 8] = max(k[(a) + 8], k[(b) + 7]); k[(a) + 9] = max(k[(a) + 9], k[(b) + 6]); k[(a) + 10] = max(k[(a) + 10], k[(b) + 5]); k[(a) + 11] = max(k[(a) + 11], k[(b) + 4]); k[(a) + 12] = max(k[(a) + 12], k[(b) + 3]); k[(a) + 13] = max(k[(a) + 13], k[(b) + 2]); k[(a) + 14] = max(k[(a) + 14], k[(b) + 1]); k[(a) + 15] = max(k[(a) + 15], k[(b) + 0]); CMPX(k[(a) + 0], k[(a) + 8]) CMPX(k[(a) + 1], k[(a) + 9]) CMPX(k[(a) + 2], k[(a) + 10]) CMPX(k[(a) + 3], k[(a) + 11]) CMPX(k[(a) + 4], k[(a) + 12]) CMPX(k[(a) + 5], k[(a) + 13]) CMPX(k[(a) + 6], k[(a) + 14]) CMPX(k[(a) + 7], k[(a) + 15]) CMPX(k[(a) + 0], k[(a) + 4]) CMPX(k[(a) + 1], k[(a) + 5]) CMPX(k[(a) + 2], k[(a) + 6]) CMPX(k[(a) + 3], k[(a) + 7]) CMPX(k[(a) + 8], k[(a) + 12]) CMPX(k[(a) + 9], k[(a) + 13]) CMPX(k[(a) + 10], k[(a) + 14]) CMPX(k[(a) + 11], k[(a) + 15]) CMPX(k[(a) + 0], k[(a) + 2]) CMPX(k[(a) + 1], k[(a) + 3]) CMPX(k[(a) + 4], k[(a) + 6]) CMPX(k[(a) + 5], k[(a) + 7]) CMPX(k[(a) + 8], k[(a) + 10]) CMPX(k[(a) + 9], k[(a) + 11]) CMPX(k[(a) + 12], k[(a) + 14]) CMPX(k[(a) + 13], k[(a) + 15]) CMPX(k[(a) + 0], k[(a) + 1]) CMPX(k[(a) + 2], k[(a) + 3]) CMPX(k[(a) + 4], k[(a) + 5]) CMPX(k[(a) + 6], k[(a) + 7]) CMPX(k[(a) + 8], k[(a) + 9]) CMPX(k[(a) + 10], k[(a) + 11]) CMPX(k[(a) + 12], k[(a) + 13]) CMPX(k[(a) + 14], k[(a) + 15]) }
#define TOPK_INSERT(top, x) { int _x = (x); _Pragma("unroll") for (int _j = 0; _j < 16; ++_j) { int _hi = max(top[_j], _x); _x = min(top[_j], _x); top[_j] = _hi; } }

__device__ __forceinline__ void phase_I(const Params& p, unsigned char* smem) {
  TID_VARS
  const bf16_t* PQ = (const bf16_t*)(p.ws + OFF_PQ);
  const bf16_t* SK = (const bf16_t*)(p.ws + OFF_SUBK);
  int* IDS = (int*)(p.ws + OFF_IDS); float* GT = (float*)(p.ws + OFF_GATES);
  float* sS = (float*)smem;
  int* sM = (int*)(smem + 66048);
  int* sL = (int*)smem;
  const int n_items = 129 * 8;
  for (int it = blockIdx.x; it < n_items; it += gridDim.x) {
    const int mt = it >> 3, head = it & 7;
    const int row_base = mt * 128;
    const int t = tid & 127, half = tid >> 7;
    int top0[16], top1[16];
#pragma unroll
    for (int pp = 0; pp < 2; ++pp) {
      f32x16 acc[2][2]; ZERO_ACC(acc)
      gemm_gg<false>(PQ + (size_t)row_base * 2048 + head * 256 + pp * 128, 2048, SK + pp * 16384, 128, 128, smem, acc, nullptr);
      __syncthreads();
      EPI_QUADS(acc, {
        sS[(lrow0) * 129 + lcol] = v0; sS[(lrow0 + 1) * 129 + lcol] = v1; sS[(lrow0 + 2) * 129 + lcol] = v2; sS[(lrow0 + 3) * 129 + lcol] = v3;
      })
      __syncthreads();
      int k[64];
      const float* sr = sS + t * 129 + half * 64;
#pragma unroll
      for (int j = 0; j < 64; ++j) k[j] = (f2key(sr[j]) & ~127) | (half * 64 + j);
      SORT16(k, 0) SORT16(k, 16) SORT16(k, 32) SORT16(k, 48)
      MERGE16(k, 0, 16) MERGE16(k, 32, 48) MERGE16(k, 0, 32)
      if (half == 1) {
#pragma unroll
        for (int j = 0; j < 16; ++j) sM[t * 16 + j] = k[j];
      }
      __syncthreads();
      if (half == 0) {
#pragma unroll
        for (int j = 0; j < 16; ++j) k[16 + j] = sM[t * 16 + j];
        MERGE16(k, 0, 16)
      }
      int top[16];
#pragma unroll
      for (int j = 0; j < 16; ++j) top[j] = k[j];
      if (pp == 0) {
#pragma unroll
        for (int j = 0; j < 16; ++j) top0[j] = top[j];
      } else {
#pragma unroll
        for (int j = 0; j < 16; ++j) top1[j] = top[j];
      }
    }
    __syncthreads();
    if (half == 0) {
#pragma unroll
      for (int j = 0; j < 16; ++j) { sL[t * 33 + j] = top0[j] & 127; sL[t * 33 + 16 + j] = top1[j] & 127; }
      float va[16], vb[16];
#pragma unroll
      for (int j = 0; j < 16; ++j) { va[j] = key2f(top0[j] & ~127); vb[j] = key2f(top1[j] & ~127); }
      int k[32];
#define CKEY(i, j) ((f2key(va[i] + vb[j]) & ~255) | ((i) * 16 + (j)))
#pragma unroll
      for (int j = 0; j < 16; ++j) k[j] = CKEY(0, j);
#pragma unroll
      for (int j = 0; j < 16; ++j) k[16 + j] = (j < 8) ? CKEY(1, (j < 8 ? j : 0)) : (int)0x80000000;
      MERGE16(k, 0, 16)
#pragma unroll
      for (int j = 0; j < 16; ++j) k[16 + j] = (j < 5) ? CKEY(2, (j < 5 ? j : 0)) : (int)0x80000000;
      MERGE16(k, 0, 16)
#pragma unroll
      for (int j = 0; j < 16; ++j) k[16 + j] = (j < 4) ? CKEY(3, (j < 4 ? j : 0)) : (int)0x80000000;
      MERGE16(k, 0, 16)
#pragma unroll
      for (int j = 0; j < 16; ++j) k[16 + j] = (j < 3) ? CKEY(4, (j < 3 ? j : 0)) : (int)0x80000000;
      MERGE16(k, 0, 16)
#pragma unroll
      for (int j = 0; j < 16; ++j) k[16 + j] = (j < 2) ? CKEY(5, (j < 2 ? j : 0)) : (int)0x80000000;
      MERGE16(k, 0, 16)
#pragma unroll
      for (int j = 0; j < 16; ++j) k[16 + j] = (j < 2) ? CKEY(6, (j < 2 ? j : 0)) : (int)0x80000000;
      MERGE16(k, 0, 16)
#pragma unroll
      for (int j = 0; j < 16; ++j) k[16 + j] = (j < 2) ? CKEY(7, (j < 2 ? j : 0)) : (int)0x80000000;
      MERGE16(k, 0, 16)
#pragma unroll
      for (int j = 0; j < 16; ++j) k[16 + j] = (j < 8) ? CKEY((j < 8 ? 8 + j : 8), 0) : (int)0x80000000;
      MERGE16(k, 0, 16)
      int best[16];
#pragma unroll
      for (int j = 0; j < 16; ++j) best[j] = k[j];
      float ev[16]; float mx = key2f(best[0] & ~255); float sum = 0.f;
#pragma unroll
      for (int j = 0; j < 16; ++j) { ev[j] = __expf(key2f(best[j] & ~255) - mx); sum += ev[j]; }
      const float inv = 1.f / sum;
      const size_t ob = ((size_t)head * NT + (row_base + t)) * 16;
#pragma unroll
      for (int j = 0; j < 16; ++j) {
        int pr = best[j] & 255;
        int id = sL[t * 33 + (pr >> 4)] * 128 + sL[t * 33 + 16 + (pr & 15)];
        IDS[ob + j] = id; GT[ob + j] = ev[j] * inv;
      }
    }
  }
}

template <int CTRL> __device__ __forceinline__ float dppf(float v) {
  return __int_as_float(__builtin_amdgcn_update_dpp(0, __float_as_int(v), CTRL, 0xF, 0xF, false));
}
__device__ __forceinline__ float reduce16(float v) {
  v += dppf<0xB1>(v);
  v += dppf<0x4E>(v);
  v += dppf<0x141>(v);
  v += dppf<0x140>(v);
  return v;
}
__device__ __forceinline__ unsigned u4c(const uint4& v, int k) { return k == 0 ? v.x : (k == 1 ? v.y : (k == 2 ? v.z : v.w)); }
__device__ __forceinline__ float f4c(const float4& v, int k) { return k == 0 ? v.x : (k == 1 ? v.y : (k == 2 ? v.z : v.w)); }
__device__ __forceinline__ float dot8(const uint4& a, const uint4& h, float s) {
  s = dot2bf(a.x, h.x, s); s = dot2bf(a.y, h.y, s); s = dot2bf(a.z, h.z, s); s = dot2bf(a.w, h.w, s); return s;
}
__device__ __forceinline__ float dot4_fp8(unsigned w, float h0, float h1, float h2, float h3, float s) {
  const f32x2_t lo = __builtin_amdgcn_cvt_pk_f32_fp8((int)w, false), hi = __builtin_amdgcn_cvt_pk_f32_fp8((int)w, true);
  s = fmaf(lo.x, h0, s); s = fmaf(lo.y, h1, s); s = fmaf(hi.x, h2, s); s = fmaf(hi.y, h3, s);
  return s;
}
template <bool COOP>
__device__ __forceinline__ void peer_token(const Params& p, unsigned char* smem, int row, int w, int lane) {
  const int es = lane >> 4, sl = lane & 15;
  const bf16_t* H = (const bf16_t*)(p.ws + OFF_H);
  const unsigned char* PU = p.ws + OFF_PU; const unsigned char* PV = p.ws + OFF_PV;
  const int* IDS = (const int*)(p.ws + OFF_IDS); const float* GT = (const float*)(p.ws + OFF_GATES);
  const float* MOD = (const float*)(p.ws + OFF_MOD);
  float* Y = p.out + OUT_Y;
  int* s_id = (int*)smem + w * 256;
  float* s_cf = (float*)smem + w * 256 + 128;
  float* s_part = (float*)(smem + 8192);
  const int gi_lo = COOP ? 8 * w : 0, gi_n = COOP ? 8 : 32;
  const size_t ia0 = ((size_t)(lane >> 4) * NT + row) * 16 + (lane & 15), ia1 = ((size_t)(4 + (lane >> 4)) * NT + row) * 16 + (lane & 15);
  s_id[lane] = IDS[ia0]; s_id[64 + lane] = IDS[ia1];
  const float g0 = GT[ia0], g1 = GT[ia1];
  float hf[64];
  {
    const uint4* hp = (const uint4*)(H + (size_t)row * 1024);
#pragma unroll
    for (int i = 0; i < 4; ++i) {
#pragma unroll
      for (int k = 0; k < 2; ++k) {
        const uint4 v = hp[(sl + 16 * i) * 2 + k];
        float* f = hf + i * 16 + k * 8;
        f[0] = bflo(v.x); f[1] = bfhi(v.x); f[2] = bflo(v.y); f[3] = bfhi(v.y); f[4] = bflo(v.z); f[5] = bfhi(v.z); f[6] = bflo(v.w); f[7] = bfhi(v.w);
      }
    }
  }
  asm volatile("s_waitcnt lgkmcnt(0)" ::: "memory");
#pragma unroll 4
  for (int q = 0; q < gi_n; ++q) {
    const int gi = gi_lo + q;
    const int id = s_id[32 * es + gi];
    const uint4* up = (const uint4*)(PU + (size_t)id * 1024);
    float s0 = 0.f, s1 = 0.f;
#pragma unroll
    for (int i = 0; i < 4; ++i) {
      const uint4 a = up[sl + 16 * i];
      const float* f = hf + i * 16;
      s0 = dot4_fp8(a.x, f[0], f[1], f[2], f[3], s0); s1 = dot4_fp8(a.y, f[4], f[5], f[6], f[7], s1);
      s0 = dot4_fp8(a.z, f[8], f[9], f[10], f[11], s0); s1 = dot4_fp8(a.w, f[12], f[13], f[14], f[15], s1);
    }
    const float d = reduce16(s0 + s1) * (1.f / 512.f);
    if (sl == 0) s_cf[32 * es + gi] = d;
  }
  asm volatile("s_waitcnt lgkmcnt(0)" ::: "memory");
  {
    const float d0 = s_cf[lane], d1 = s_cf[64 + lane];
    asm volatile("s_waitcnt lgkmcnt(0)" ::: "memory");
    s_cf[lane] = g0 * (0.5f / 64.f) * d0 * (1.f + erff(d0 * 0.7071067811865476f));
    s_cf[64 + lane] = g1 * (0.5f / 64.f) * d1 * (1.f + erff(d1 * 0.7071067811865476f));
    asm volatile("s_waitcnt lgkmcnt(0)" ::: "memory");
  }
  float y[16];
#pragma unroll
  for (int i = 0; i < 16; ++i) y[i] = 0.f;
#pragma unroll 8
  for (int q = 0; q < 4 * gi_n; ++q) {
    const int e = COOP ? (32 * (q & 3) + gi_lo + (q >> 2)) : q;
    const int id = __builtin_amdgcn_readfirstlane(s_id[e]);
    const float ce = __int_as_float(__builtin_amdgcn_readfirstlane(__float_as_int(s_cf[e])));
    const uint4 a = ((const uint4*)(PV + (size_t)id * 1024))[lane];
    const f32x2_t l0 = __builtin_amdgcn_cvt_pk_f32_fp8((int)a.x, false), h0 = __builtin_amdgcn_cvt_pk_f32_fp8((int)a.x, true);
    const f32x2_t l1 = __builtin_amdgcn_cvt_pk_f32_fp8((int)a.y, false), h1 = __builtin_amdgcn_cvt_pk_f32_fp8((int)a.y, true);
    const f32x2_t l2 = __builtin_amdgcn_cvt_pk_f32_fp8((int)a.z, false), h2 = __builtin_amdgcn_cvt_pk_f32_fp8((int)a.z, true);
    const f32x2_t l3 = __builtin_amdgcn_cvt_pk_f32_fp8((int)a.w, false), h3 = __builtin_amdgcn_cvt_pk_f32_fp8((int)a.w, true);
    y[0] += ce * l0.x; y[1] += ce * l0.y; y[2] += ce * h0.x; y[3] += ce * h0.y;
    y[4] += ce * l1.x; y[5] += ce * l1.y; y[6] += ce * h1.x; y[7] += ce * h1.y;
    y[8] += ce * l2.x; y[9] += ce * l2.y; y[10] += ce * h2.x; y[11] += ce * h2.y;
    y[12] += ce * l3.x; y[13] += ce * l3.y; y[14] += ce * h3.x; y[15] += ce * h3.y;
  }
  asm volatile("s_waitcnt lgkmcnt(0)" ::: "memory");
  if (COOP) {
    __syncthreads();
#pragma unroll
    for (int k = 0; k < 4; ++k) *(float4*)(s_part + w * 1024 + lane * 16 + k * 4) = make_float4(y[4 * k], y[4 * k + 1], y[4 * k + 2], y[4 * k + 3]);
    __syncthreads();
    if (w != 0) return;
#pragma unroll
    for (int k = 0; k < 4; ++k) {
      const float4 b1 = *(const float4*)(s_part + 1024 + lane * 16 + k * 4), b2 = *(const float4*)(s_part + 2048 + lane * 16 + k * 4),
                   b3 = *(const float4*)(s_part + 3072 + lane * 16 + k * 4);
      y[4 * k] += b1.x + b2.x + b3.x; y[4 * k + 1] += b1.y + b2.y + b3.y; y[4 * k + 2] += b1.z + b2.z + b3.z; y[4 * k + 3] += b1.w + b2.w + b3.w;
    }
  }
  float* yr = Y + (size_t)row * 1024;
  const float* mr = MOD + (size_t)mod_row(row) * 6144 + 5120;
  float v[16];
  float s = 0.f;
#pragma unroll
  for (int k = 0; k < 4; ++k) {
    const int c = lane * 16 + k * 4;
    const float4 x1 = *(const float4*)(yr + c), g2 = *(const float4*)(mr + c);
    const int o = k * 4;
    v[o] = ALPHA * x1.x + g2.x * y[o]; v[o + 1] = ALPHA * x1.y + g2.y * y[o + 1];
    v[o + 2] = ALPHA * x1.z + g2.z * y[o + 2]; v[o + 3] = ALPHA * x1.w + g2.w * y[o + 3];
    s += v[o] + v[o + 1] + v[o + 2] + v[o + 3];
  }
  const float mu = wave_sum(s) * (1.f / 1024.f);
  float q2 = 0.f;
#pragma unroll
  for (int i = 0; i < 16; ++i) { float d = v[i] - mu; q2 += d * d; }
  const float rstd = rsqrtf(wave_sum(q2) * (1.f / 1024.f) + LN_EPS);
#pragma unroll
  for (int k = 0; k < 4; ++k) {
    const int c = lane * 16 + k * 4;
    const float4 gg = *(const float4*)(P_L2G(p) + c), bb = *(const float4*)(P_L2B(p) + c);
    const int o = k * 4;
    *(float4*)(yr + c) = make_float4((v[o] - mu) * rstd * gg.x + bb.x, (v[o + 1] - mu) * rstd * gg.y + bb.y,
                                     (v[o + 2] - mu) * rstd * gg.z + bb.z, (v[o + 3] - mu) * rstd * gg.w + bb.w);
  }
}
__device__ __forceinline__ void phase_J(const Params& p, unsigned char* smem) {
  const int tid = threadIdx.x, lane = tid & 63, w = tid >> 6;
  const int nw = gridDim.x * 4;
  const int main_rows = (NT / nw) * nw;
  for (int row = blockIdx.x * 4 + w; row < main_rows; row += nw) peer_token<false>(p, smem, row, w, lane);
  __syncthreads();
  for (int row = main_rows + blockIdx.x; row < NT; row += gridDim.x) peer_token<true>(p, smem, row, w, lane);
}

#define XB_TMO      128
#define XB_XCNT(j)  (256  + 64 * (j))
#define XB_XSUB(j)  (1280 + 64 * (j))
#define XB_XGEN(j)  (2304 + 64 * (j))
#define XB_TOP      3328
#define XB_TOPGEN   3392
#define XCD_BAR_WORDS 3456
#define XB_SPIN_CAP (1u << 22)
#define LAS __attribute__((address_space(3)))
__device__ __forceinline__ unsigned xb_ld(unsigned* p)              { return __hip_atomic_load(p, __ATOMIC_RELAXED, __HIP_MEMORY_SCOPE_AGENT); }
__device__ __forceinline__ unsigned xb_add(unsigned* p, unsigned v) { return __hip_atomic_fetch_add(p, v, __ATOMIC_RELAXED, __HIP_MEMORY_SCOPE_AGENT); }
__device__ __forceinline__ unsigned xb_xcc_id() { return (unsigned)__builtin_amdgcn_s_getreg((3 << 11) | 20) & 0xFu; }
#define XB_SPIN(cond, bar) do { unsigned _sp = 0; while (cond) { __builtin_amdgcn_s_sleep(1); \
    if ((++_sp & 255u) == 0u) { if (xb_ld(&(bar)[XB_TMO])) break; if (_sp > XB_SPIN_CAP) { atomicAdd(&(bar)[XB_TMO], 1u); break; } } } } while (0)
struct XcdBarrier { unsigned* bar; unsigned x; volatile LAS unsigned* st; };
__device__ __forceinline__ XcdBarrier xcd_barrier_post(unsigned* bar, volatile LAS unsigned* st) {
    XcdBarrier b; b.bar = bar; b.x = xb_xcc_id(); b.st = st;
    if (threadIdx.x == 0) (void)xb_add(&bar[XB_XCNT(b.x)], 1u);
    return b;
}
__device__ __forceinline__ void xcd_barrier_complete(unsigned* bar, unsigned x, unsigned& nloc, unsigned& nx) {
    const unsigned G = gridDim.x * gridDim.y * gridDim.z;
    unsigned sum, cnt, mine, sp = 0u;
    for (;;) {
        sum = 0u; cnt = 0u; mine = 0u;
#pragma unroll
        for (unsigned j = 0; j < 16; ++j) { const unsigned c = xb_ld(&bar[XB_XCNT(j)]); sum += c; cnt += (c > 0u) ? 1u : 0u; mine = (j == x) ? c : mine; }
        if (sum == G) break;
        __builtin_amdgcn_s_sleep(1);
        if ((++sp & 255u) == 0u) { if (xb_ld(&bar[XB_TMO])) break; if (sp > XB_SPIN_CAP) { atomicAdd(&bar[XB_TMO], 1u); break; } }
    }
    nloc = mine > 0u ? mine : 1u; nx = cnt > 0u ? cnt : 1u;
}
__device__ __forceinline__ void xcd_barrier(const XcdBarrier& b) {
    asm volatile("s_waitcnt vmcnt(0)" ::: "memory");
    __syncthreads();
    if (threadIdx.x == 0) {
        unsigned* bar = b.bar;
        __builtin_amdgcn_s_waitcnt(0);
        unsigned nloc = b.st[0], nx = b.st[1];
        if (nloc == 0u) { xcd_barrier_complete(bar, b.x, nloc, nx); b.st[0] = nloc; b.st[1] = nx; }
        const unsigned old = xb_add(&bar[XB_XSUB(b.x)], 1u);
        const unsigned gen = old / nloc;
        if (old + 1u == (gen + 1u) * nloc) {
            __builtin_amdgcn_fence(__ATOMIC_RELEASE, "agent");
            asm volatile("s_waitcnt vmcnt(0)" ::: "memory");
            const unsigned og = xb_add(&bar[XB_TOP], 1u);
            const unsigned tg = og / nx;
            if (og + 1u == (tg + 1u) * nx) xb_add(&bar[XB_TOPGEN], 1u);
            else XB_SPIN(xb_ld(&bar[XB_TOPGEN]) == tg, bar);
            __builtin_amdgcn_fence(__ATOMIC_ACQUIRE, "agent");
            xb_add(&bar[XB_XGEN(b.x)], 1u);
            asm volatile("s_waitcnt vmcnt(0)" ::: "memory");
        } else {
            XB_SPIN(xb_ld(&bar[XB_XGEN(b.x)]) == gen, bar);
            __builtin_amdgcn_fence(__ATOMIC_ACQUIRE, "agent");
            asm volatile("s_waitcnt vmcnt(0)" ::: "memory");
        }
    }
    __syncthreads();
}
#define gsync(grid) xcd_barrier(xb)
__global__ void __launch_bounds__(256, 2) fwd_megakernel(Params p) {
  cg::grid_group grid = cg::this_grid();
  __shared__ __attribute__((aligned(16))) unsigned char smem[SM_TOTAL];
  __shared__ uint4 xb_words;
  if (threadIdx.x == 0) xb_words = make_uint4(0u, 0u, 0u, 0u);
  __syncthreads();
  XcdBarrier xb = xcd_barrier_post((unsigned*)(p.ws + OFF_BAR), (volatile LAS unsigned*)&xb_words);
  if (p.ws == nullptr) grid.sync();
#ifndef ONLY
#define ONLY 0xFFF
#endif
  if (ONLY & 1) phase_A(p, smem);  gsync(grid);
  if (ONLY & 2) phase_B(p);        gsync(grid);
  if (ONLY & 4) phase_C(p, smem);  gsync(grid);
  if (ONLY & 8) phase_D1(p, smem); gsync(grid);
  if (ONLY & 16) phase_D2(p);       gsync(grid);
  if (ONLY & 32) phase_D3(p, smem); gsync(grid);
  if (ONLY & 64) phase_E(p, smem);  gsync(grid);
  if (ONLY & 128) phase_F(p, smem);  gsync(grid);
  if (ONLY & 256) phase_G(p);        gsync(grid);
  if (ONLY & 512) phase_H(p, smem);  gsync(grid);
  if (ONLY & 1024) phase_I(p, smem);  gsync(grid);
  if (ONLY & 2048) phase_J(p, smem);
}

extern "C" void kernel_launch(void* const* d_in, const int* in_sizes, int n_in, void* d_out,
                              int out_size, void* d_ws, size_t ws_size, hipStream_t stream) {
  static int grid_blocks = 0;
  if (!grid_blocks) {
    int dev = 0, cus = 0, per_cu = 0;
    hipGetDevice(&dev);
    hipDeviceGetAttribute(&cus, hipDeviceAttributeMultiprocessorCount, dev);
    hipOccupancyMaxActiveBlocksPerMultiprocessor(&per_cu, fwd_megakernel, 256, 0);
    if (per_cu > 2) per_cu = 2;
    if (per_cu < 1) per_cu = 1;
    grid_blocks = cus * per_cu;
  }
  if (ws_size < WS_TOTAL) fprintf(stderr, "workspace too small: %zu < %zu\n", ws_size, (size_t)WS_TOTAL);
  Params p{};
  const float* const* in = (const float* const*)d_in;
  p.x_prompt = in[0]; p.x_sample = in[1]; p.c_prompt = in[2]; p.c_sample = in[3];
  p.st_C = in[4]; p.st_n = in[5]; p.st_m = in[6]; p.st_pool = in[7];
  p.w_mod = in[8]; p.b_mod = in[9]; p.w_in = in[10]; p.b_in = in[11]; p.b_fgate = in[12]; p.gn_gain = in[13];
  p.w_pool = in[14]; p.pool_scale = in[15]; p.w_a = in[16]; p.w_b = in[17]; p.w_out = in[18];
  p.ln1_g = in[19]; p.ln1_b = in[20]; p.w_pq = in[21]; p.subkeys = in[22]; p.peer_u = in[23]; p.peer_v = in[24];
  p.ln2_g = in[25]; p.ln2_b = in[26];
  p.out = (float*)d_out; p.ws = (unsigned char*)d_ws;
  hipMemsetAsync((unsigned char*)d_ws + OFF_BAR, 0, 16384, stream);
  void* args[] = {&p};
  hipError_t e = hipLaunchCooperativeKernel((void*)fwd_megakernel, dim3(grid_blocks), dim3(256), args, 0, stream);
  if (e != hipSuccess) fprintf(stderr, "cooperative launch failed: %s (grid %d)\n", hipGetErrorString(e), grid_blocks);
}
```
